# Optimizing an MI355X kernel written in HIP

```python
import math
import jax
import jax.numpy as jnp
from jax import lax
import numpy as np


D_MODEL = 1024
BATCH = 8
SEQ = 4096
DEPTH = 2

CHUNK = 64
Q_BLOCK = 128
HEAD_DIM = 64
DIFF_HEADS = 4
DIFF_V_DIM = 2 * HEAD_DIM
FOX_HEADS = 8
D_DIFF = DIFF_HEADS * DIFF_V_DIM
D_FOX = FOX_HEADS * HEAD_DIM
D_MIX = D_DIFF + D_FOX
DQK_DIFF = DIFF_HEADS * 2 * HEAD_DIM
IN_COLS = 2 * DQK_DIFF + D_DIFF + 3 * D_FOX + FOX_HEADS
ROPE_THETA = 500000.0
ROPE_DIM = HEAD_DIM // 4
N_EXPERTS = 32
TOP_K = 4
D_FF = D_MODEL
SWIGLU_LIMIT = 7.0
SWIGLU_ALPHA = 1.702
EXPERT_BLOCK = 256
NORM_EPS = 1e-6
MAX_POS_OFFSET = 1024

kernel_name = 'hybrid_diffattn_fox_moe_adaln'


def rmsnorm(x, g):
    xf = x.astype(jnp.float32)
    y = xf * lax.rsqrt(jnp.mean(xf * xf, axis=-1, keepdims=True) + NORM_EPS)
    return (y * g.astype(jnp.float32)).astype(x.dtype)


def rope_tables(positions, dtype):
    inv_freq = ROPE_THETA ** (-jnp.arange(0, ROPE_DIM, 2, dtype=jnp.float32) / ROPE_DIM)
    ang = positions.astype(jnp.float32)[..., None] * inv_freq
    cos = jnp.cos(ang)[:, :, None, None, :].astype(dtype)
    sin = jnp.sin(ang)[:, :, None, None, :].astype(dtype)
    return cos, sin


def apply_partial_rope(x, cos, sin):
    half = ROPE_DIM // 2
    x1, x2, xp = x[..., :half], x[..., half:ROPE_DIM], x[..., ROPE_DIM:]
    return jnp.concatenate([x1 * cos - x2 * sin, x2 * cos + x1 * sin, xp], axis=-1)


def diff_attention(q, k, v, lam):
    B, H, _, S, _ = q.shape
    scale = HEAD_DIM ** -0.5
    k_chunk = jnp.arange(S) // CHUNK

    def one_block(blk):
        start = blk * Q_BLOCK
        qb = lax.dynamic_slice_in_dim(q, start, Q_BLOCK, axis=3)
        s = jnp.einsum('bhmqd,bhmkd->bhmqk', qb, k).astype(jnp.float32) * scale
        q_chunk = (start + jnp.arange(Q_BLOCK)) // CHUNK
        mask = k_chunk[None, :] <= q_chunk[:, None]
        p = jax.nn.softmax(jnp.where(mask, s, -jnp.inf), axis=-1)
        a = p[:, :, 0] - lam * p[:, :, 1]
        return jnp.einsum('bhqk,bhkd->bhqd', a.astype(v.dtype), v)

    out = lax.map(one_block, jnp.arange(S // Q_BLOCK))
    return out.transpose(1, 2, 0, 3, 4).reshape(B, H, S, v.shape[-1])


def forgetting_attention(q, k, v, log_f):
    B, H, S, _ = q.shape
    scale = HEAD_DIM ** -0.5
    cum = jnp.cumsum(log_f, axis=-1)
    k_pos = jnp.arange(S)

    def one_block(blk):
        start = blk * Q_BLOCK
        qb = lax.dynamic_slice_in_dim(q, start, Q_BLOCK, axis=2)
        cq = lax.dynamic_slice_in_dim(cum, start, Q_BLOCK, axis=2)
        s = jnp.einsum('bhqd,bhkd->bhqk', qb, k).astype(jnp.float32) * scale
        s = s + cq[..., :, None] - cum[..., None, :]
        q_pos = start + jnp.arange(Q_BLOCK)
        mask = k_pos[None, :] <= q_pos[:, None]
        p = jax.nn.softmax(jnp.where(mask, s, -jnp.inf), axis=-1)
        return jnp.einsum('bhqk,bhkd->bhqd', p.astype(v.dtype), v)

    out = lax.map(one_block, jnp.arange(S // Q_BLOCK))
    return out.transpose(1, 2, 0, 3, 4).reshape(B, H, S, HEAD_DIM)


def hybrid_mixer(h, cos, sin, w_in_l, b_forget_l, lq1, lk1, lq2, lk2, subln_g, w_out_l, lam_init):
    B, S, _ = h.shape
    proj = h @ w_in_l
    splits = list(np.cumsum([DQK_DIFF, DQK_DIFF, D_DIFF, D_FOX, D_FOX, D_FOX]))
    dq, dk, dv, fq, fk, fv, ff = jnp.split(proj, splits, axis=-1)

    dq = apply_partial_rope(dq.reshape(B, S, DIFF_HEADS, 2, HEAD_DIM), cos, sin)
    dk = apply_partial_rope(dk.reshape(B, S, DIFF_HEADS, 2, HEAD_DIM), cos, sin)
    dq = dq.transpose(0, 2, 3, 1, 4)
    dk = dk.transpose(0, 2, 3, 1, 4)
    dv = dv.reshape(B, S, DIFF_HEADS, DIFF_V_DIM).transpose(0, 2, 1, 3)
    f32 = jnp.float32
    lam = (jnp.exp(jnp.sum(lq1.astype(f32) * lk1.astype(f32)))
           - jnp.exp(jnp.sum(lq2.astype(f32) * lk2.astype(f32))) + lam_init)
    a_out = diff_attention(dq, dk, dv, lam)
    a_out = rmsnorm(a_out, subln_g) * (1.0 - lam_init)
    a_out = a_out.transpose(0, 2, 1, 3).reshape(B, S, D_DIFF)

    fq = fq.reshape(B, S, FOX_HEADS, HEAD_DIM).transpose(0, 2, 1, 3)
    fk = fk.reshape(B, S, FOX_HEADS, HEAD_DIM).transpose(0, 2, 1, 3)
    fv = fv.reshape(B, S, FOX_HEADS, HEAD_DIM).transpose(0, 2, 1, 3)
    log_f = jax.nn.log_sigmoid((ff + b_forget_l).astype(f32)).transpose(0, 2, 1)
    b_out = forgetting_attention(fq, fk, fv, log_f)
    b_out = b_out.transpose(0, 2, 1, 3).reshape(B, S, D_FOX)

    return jnp.concatenate([a_out, b_out], axis=-1) @ w_out_l


def moe_ffn(h, router_w, router_b, w1, b1, w2, b2):
    B, S, D = h.shape
    N = B * S
    NA = N * TOP_K
    xt = h.reshape(N, D)
    logits = (xt @ router_w + router_b).astype(jnp.float32)
    top_vals, top_idx = lax.top_k(logits, TOP_K)
    gates = jax.nn.softmax(top_vals, axis=-1)

    e_flat = top_idx.reshape(NA)
    tok = jnp.arange(NA) // TOP_K
    order = jnp.argsort(e_flat)
    e_sorted = e_flat[order]
    counts = jnp.zeros((N_EXPERTS,), jnp.int32).at[e_flat].add(1)
    padded = (counts + EXPERT_BLOCK - 1) // EXPERT_BLOCK * EXPERT_BLOCK
    pend = jnp.cumsum(padded)
    pstart = pend - padded
    gstart = jnp.cumsum(counts) - counts
    dest_sorted = pstart[e_sorted] + (jnp.arange(NA) - gstart[e_sorted])
    dest = jnp.zeros((NA,), jnp.int32).at[order].set(dest_sorted.astype(jnp.int32))
    R = NA + N_EXPERTS * EXPERT_BLOCK
    n_blocks = R // EXPERT_BLOCK
    x_buf = jnp.zeros((R, D), h.dtype).at[dest].set(xt[tok])
    block_expert = jnp.minimum(
        jnp.searchsorted(pend, jnp.arange(n_blocks) * EXPERT_BLOCK, side='right'),
        N_EXPERTS - 1)

    def expert_block(args):
        xb, e = args
        gu = xb @ w1[e] + b1[e]
        gate = jnp.minimum(gu[:, :D_FF], SWIGLU_LIMIT)
        up = jnp.clip(gu[:, D_FF:], -SWIGLU_LIMIT, SWIGLU_LIMIT)
        glu = gate * jax.nn.sigmoid(gate * SWIGLU_ALPHA)
        return ((up + 1.0) * glu) @ w2[e] + b2[e]

    y_buf = lax.map(expert_block, (x_buf.reshape(n_blocks, EXPERT_BLOCK, D), block_expert))
    y_assign = y_buf.reshape(R, D)[dest].reshape(N, TOP_K, D)
    y = jnp.einsum('nk,nkd->nd', gates.astype(h.dtype), y_assign)
    return y.reshape(B, S, D)


def setup_inputs(seed: int = 0) -> dict:
    key = jax.random.key(seed)
    ks = jax.random.split(key, 24)
    f32 = jnp.float32
    nrm = lambda k, shape, s: (jax.random.normal(k, shape, f32) * s)
    x = jax.random.normal(ks[0], (BATCH, SEQ, D_MODEL), f32)
    c = jax.random.normal(ks[1], (BATCH, D_MODEL), f32)
    offsets = jax.random.randint(ks[2], (BATCH, 1), 0, MAX_POS_OFFSET, dtype=jnp.int32)
    positions = (offsets + jnp.arange(SEQ, dtype=jnp.int32)[None, :]).astype(jnp.int32)
    return {
        'x': x,
        'c': c,
        'positions': positions,
        'ada_w': nrm(ks[3], (DEPTH, D_MODEL, 6 * D_MODEL), D_MODEL ** -0.5),
        'ada_b': nrm(ks[4], (DEPTH, 6 * D_MODEL), 0.01),
        'norm_mix': 1.0 + nrm(ks[5], (DEPTH, D_MODEL), 0.02),
        'norm_ffn': 1.0 + nrm(ks[6], (DEPTH, D_MODEL), 0.02),
        'w_in': nrm(ks[7], (DEPTH, D_MODEL, IN_COLS), D_MODEL ** -0.5),
        'b_forget': 2.0 + nrm(ks[8], (DEPTH, FOX_HEADS), 0.5),
        'lambda_q1': nrm(ks[9], (DEPTH, HEAD_DIM), 0.1),
        'lambda_k1': nrm(ks[10], (DEPTH, HEAD_DIM), 0.1),
        'lambda_q2': nrm(ks[11], (DEPTH, HEAD_DIM), 0.1),
        'lambda_k2': nrm(ks[12], (DEPTH, HEAD_DIM), 0.1),
        'diff_subln': 1.0 + nrm(ks[13], (DEPTH, DIFF_V_DIM), 0.02),
        'w_out': nrm(ks[14], (DEPTH, D_MIX, D_MODEL), D_MIX ** -0.5),
        'router_w': nrm(ks[15], (DEPTH, D_MODEL, N_EXPERTS), D_MODEL ** -0.5),
        'router_b': nrm(ks[16], (DEPTH, N_EXPERTS), 0.01),
        'exp_w1': nrm(ks[17], (DEPTH, N_EXPERTS, D_MODEL, 2 * D_FF), D_MODEL ** -0.5),
        'exp_b1': nrm(ks[18], (DEPTH, N_EXPERTS, 2 * D_FF), 0.01),
        'exp_w2': nrm(ks[19], (DEPTH, N_EXPERTS, D_FF, D_MODEL), D_FF ** -0.5),
        'exp_b2': nrm(ks[20], (DEPTH, N_EXPERTS, D_MODEL), 0.01),
        'final_norm': 1.0 + nrm(ks[21], (D_MODEL,), 0.02),
    }


def reference(x, c, positions, ada_w, ada_b, norm_mix, norm_ffn, w_in, b_forget,
              lambda_q1, lambda_k1, lambda_q2, lambda_k2, diff_subln, w_out,
              router_w, router_b, exp_w1, exp_b1, exp_w2, exp_b2, final_norm):
    cos, sin = rope_tables(positions, x.dtype)
    c_act = jax.nn.silu(c)
    for l in range(DEPTH):
        lam_init = 0.8 - 0.6 * math.exp(-0.3 * l)
        mod = (c_act @ ada_w[l] + ada_b[l])[:, None, :]
        sh1, sc1, g1, sh2, sc2, g2 = jnp.split(mod, 6, axis=-1)
        h = rmsnorm(x, norm_mix[l]) * (1.0 + sc1) + sh1
        x = x + g1 * hybrid_mixer(h, cos, sin, w_in[l], b_forget[l], lambda_q1[l], lambda_k1[l],
                                  lambda_q2[l], lambda_k2[l], diff_subln[l], w_out[l], lam_init)
        h = rmsnorm(x, norm_ffn[l]) * (1.0 + sc2) + sh2
        x = x + g2 * moe_ffn(h, router_w[l], router_b[l], exp_w1[l], exp_b1[l], exp_w2[l], exp_b2[l])
    return rmsnorm(x, final_norm)
```

```cpp
#include <hip/hip_runtime.h>
#include <hip/hip_bf16.h>
#include <cstdio>
#include <cstdint>
#include <cmath>

#ifndef MK_MULTI
#define MK_MULTI 0
#endif

constexpr int BATCH = 8, SEQ = 4096, DM = 1024, NTOK = BATCH * SEQ, DEPTH = 2, NEXP = 32, TOPK = 4;
constexpr int INCOLS = 3080, DFF = 1024;
constexpr int NWAVES = 8, NTHR = 512;
constexpr float NORM_EPS = 1e-6f;
constexpr float LOG2E = 1.4426950408889634f;
constexpr float QSCALE = 0.125f * LOG2E;
constexpr int ROWCAP = NTOK;
constexpr int MAXRB = (NTOK * TOPK) / 256 + NEXP;

constexpr size_t MiB = 1u << 20;
constexpr size_t WS_CTL = 0, CTL_ZERO_BYTES = 2 * MiB;
constexpr size_t WS_MOD = 2 * MiB;
constexpr size_t WS_RWT = 3 * MiB;
constexpr size_t WS_WFT = 3 * MiB + 512 * 1024;
constexpr size_t WS_ROPE = 4 * MiB;
constexpr size_t WS_NCK = 6 * MiB;
constexpr size_t WS_LF = 7 * MiB;
constexpr size_t WS_GATES = 8 * MiB;
constexpr size_t WS_ROWL = 9 * MiB;
constexpr size_t WS_WIN = 16 * MiB;
constexpr size_t WS_WOUT = 28 * MiB;
constexpr size_t WS_W1 = 32 * MiB;
constexpr size_t WS_W2 = 288 * MiB;
constexpr size_t WS_XN = 416 * MiB;
constexpr size_t WS_QKV = 480 * MiB;
constexpr size_t WS_AO = 672 * MiB;
constexpr size_t WS_X1 = 736 * MiB;
constexpr size_t WS_X2 = 864 * MiB;
constexpr size_t WS_XN2 = 992 * MiB;
constexpr size_t WS_HID = 1056 * MiB;
constexpr size_t WS_Y = 1328 * MiB;
constexpr size_t WS_END = 1585 * MiB;
constexpr int CW_BAR = 4096;
constexpr int CW_CNT = 16384;

constexpr int RING_BYTES = 131072;
constexpr int MISC_OFF = RING_BYTES;
constexpr int L_XBST = MISC_OFF;
constexpr int L_CNT = MISC_OFF + 64;
constexpr int L_BLK = MISC_OFF + 192;
constexpr int L_HIST = MISC_OFF + 384;
constexpr int L_BASE = MISC_OFF + 512;
constexpr int L_SCAN = MISC_OFF + 640;
constexpr int IDX_OFF = MISC_OFF + 1024;
constexpr int IDX_BYTES = 18432;
constexpr int BIAS_OFF = IDX_OFF + IDX_BYTES;
constexpr int LDS_BYTES = BIAS_OFF + 8192;

#define GAS __attribute__((address_space(1)))
#define LAS __attribute__((address_space(3)))
typedef unsigned short bf16_t;
typedef short bf16x8 __attribute__((ext_vector_type(8)));
typedef short s16x4 __attribute__((ext_vector_type(4)));
typedef float f32x4 __attribute__((ext_vector_type(4)));
typedef float f32x2 __attribute__((ext_vector_type(2)));
typedef float f32x16 __attribute__((ext_vector_type(16)));
typedef unsigned u32x4 __attribute__((ext_vector_type(4)));
typedef unsigned u32x2 __attribute__((ext_vector_type(2)));

__device__ __forceinline__ unsigned cvt_pk_bf16(float lo, float hi) { unsigned r; asm volatile("v_cvt_pk_bf16_f32 %0, %1, %2" : "=v"(r) : "v"(lo), "v"(hi)); return r; }
__device__ __forceinline__ int fresh_tid() { int t = threadIdx.x; asm volatile("" : "+v"(t)); return t; }
__device__ __forceinline__ unsigned pack4_fp8(float a, float b, float c, float d) {
    int w = __builtin_amdgcn_cvt_pk_fp8_f32(a, b, 0, false); w = __builtin_amdgcn_cvt_pk_fp8_f32(c, d, w, true); return (unsigned)w; }
__device__ __forceinline__ float bf_lo(unsigned w) { return __uint_as_float(w << 16); }
__device__ __forceinline__ float bf_hi(unsigned w) { return __uint_as_float(w & 0xffff0000u); }
__device__ __forceinline__ float wave_sum(float v) {
#pragma unroll
    for (int o = 1; o < 64; o <<= 1) v += __shfl_xor(v, o);
    return v;
}

#define XB_TMO      128
#define XB_XCNT(j)  (256  + 64 * (j))
#define XB_XSUB(j)  (1280 + 64 * (j))
#define XB_XGEN(j)  (2304 + 64 * (j))
#define XB_TOP      3328
#define XB_TOPGEN   3392
#define XCD_BAR_WORDS 3456
#define XB_SPIN_CAP (1u << 18)
__device__ __forceinline__ unsigned xb_ld(unsigned* p)              { return __hip_atomic_load(p, __ATOMIC_RELAXED, __HIP_MEMORY_SCOPE_AGENT); }
__device__ __forceinline__ unsigned xb_add(unsigned* p, unsigned v) { return __hip_atomic_fetch_add(p, v, __ATOMIC_RELAXED, __HIP_MEMORY_SCOPE_AGENT); }
__device__ __forceinline__ unsigned xb_xcc_id() { return (unsigned)__builtin_amdgcn_s_getreg((3 << 11) | 20) & 0xFu; }
#define XB_SPIN(cond, bar) do { unsigned _sp = 0; while (cond) { __builtin_amdgcn_s_sleep(1); \
    if ((++_sp & 255u) == 0u) { if (xb_ld(&(bar)[XB_TMO])) break; if (_sp > XB_SPIN_CAP) { atomicAdd(&(bar)[XB_TMO], 1u); break; } } } } while (0)
struct XcdBarrier { unsigned* bar; unsigned x; volatile LAS unsigned* st; };
__device__ __forceinline__ XcdBarrier xcd_barrier_post(unsigned* bar, volatile LAS unsigned* st) {
    XcdBarrier b; b.bar = bar; b.x = xb_xcc_id(); b.st = st;
    if (threadIdx.x == 0) (void)xb_add(&bar[XB_XCNT(b.x)], 1u);
    return b;
}
__device__ __forceinline__ void xcd_barrier_complete(unsigned* bar, unsigned x, unsigned& nloc, unsigned& nx) {
    const unsigned G = gridDim.x * gridDim.y * gridDim.z;
    unsigned sum, cnt, mine, sp = 0u;
    for (;;) {
        sum = 0u; cnt = 0u; mine = 0u;
#pragma unroll
        for (unsigned j = 0; j < 16; ++j) { const unsigned c = xb_ld(&bar[XB_XCNT(j)]); sum += c; cnt += (c > 0u) ? 1u : 0u; mine = (j == x) ? c : mine; }
        if (sum == G) break;
        __builtin_amdgcn_s_sleep(1);
        if ((++sp & 255u) == 0u) { if (xb_ld(&bar[XB_TMO])) break; if (sp > XB_SPIN_CAP) { atomicAdd(&bar[XB_TMO], 1u); break; } }
    }
    nloc = mine > 0u ? mine : 1u; nx = cnt > 0u ? cnt : 1u;
}
__device__ __forceinline__ void xcd_barrier(const XcdBarrier& b) {
    asm volatile("s_waitcnt vmcnt(0)" ::: "memory");
    __syncthreads();
    if (threadIdx.x == 0) {
        unsigned* bar = b.bar;
        __builtin_amdgcn_s_waitcnt(0);
        unsigned nloc = b.st[0], nx = b.st[1];
        if (nloc == 0u) { xcd_barrier_complete(bar, b.x, nloc, nx); b.st[0] = nloc; b.st[1] = nx; }
        const unsigned old = xb_add(&bar[XB_XSUB(b.x)], 1u);
        const unsigned gen = old / nloc;
        if (old + 1u == (gen + 1u) * nloc) {
            __builtin_amdgcn_fence(__ATOMIC_RELEASE, "agent");
            asm volatile("s_waitcnt vmcnt(0)" ::: "memory");
            const unsigned og = xb_add(&bar[XB_TOP], 1u);
            const unsigned tg = og / nx;
            if (og + 1u == (tg + 1u) * nx) xb_add(&bar[XB_TOPGEN], 1u);
            else XB_SPIN(xb_ld(&bar[XB_TOPGEN]) == tg, bar);
            __builtin_amdgcn_fence(__ATOMIC_ACQUIRE, "agent");
            xb_add(&bar[XB_XGEN(b.x)], 1u);
            asm volatile("s_waitcnt vmcnt(0)" ::: "memory");
        } else {
            XB_SPIN(xb_ld(&bar[XB_XGEN(b.x)]) == gen, bar);
            __builtin_amdgcn_fence(__ATOMIC_ACQUIRE, "agent");
            asm volatile("s_waitcnt vmcnt(0)" ::: "memory");
        }
    }
    __syncthreads();
}

namespace pg8 {
constexpr int BM = 256, BK = 64, HALF = 128, HTB = HALF * BK * 2, STAGE_BYTES = 8 * HTB;
__host__ __device__ __forceinline__ int lds_byte(int r, int c) { const int st = (r >> 4) * 2 + (c >> 5), rr = r & 15, cc = c & 31, ob = rr * 64 + cc * 2; return st * 1024 + (ob ^ (((ob >> 9) & 1) << 5)); }
__host__ __device__ __forceinline__ void stage_rc(int b, int& R, int& C) { const int st = b / 1024, sb = b % 1024, swz = sb ^ (((sb >> 9) & 1) << 5); R = (st >> 1) * 16 + swz / 64; C = (st & 1) * 32 + (swz % 64) / 2; }
__host__ __device__ __forceinline__ int perm32(int rho) { const int n = rho >> 4, i = rho & 15; return 8 * (i >> 2) + 4 * n + (i & 3); }

typedef int i32x8 __attribute__((ext_vector_type(8)));
typedef int i32x4 __attribute__((ext_vector_type(4)));
__device__ __forceinline__ i32x8 cat8(bf16x8 lo, bf16x8 hi) { const i32x4 a = __builtin_bit_cast(i32x4, lo), b = __builtin_bit_cast(i32x4, hi); return (i32x8){a[0], a[1], a[2], a[3], b[0], b[1], b[2], b[3]}; }
struct Unit { int pm, pn, e; };

template <class Epi, class Sched, bool ALIGN_EPI, bool F8 = false>
__device__ __forceinline__ void gemm_phase(LAS unsigned char* lds, const int K, const Sched& S, const Epi& E) {
    const int tid = fresh_tid(), wid = __builtin_amdgcn_readfirstlane(tid >> 6), lane = tid & 63, wr = wid >> 2, wc = wid & 3, fr = lane & 15, fq = lane >> 4;
    const int nt = F8 ? K / (2 * BK) : K / BK;
    const int rowb = F8 ? K : 2 * K;
    int Rp[2]; unsigned voffA[2], voffB[2];
#pragma unroll
    for (int i = 0; i < 2; ++i) { int R, C; stage_rc(tid * 16 + i * 8192, R, C); Rp[i] = R; const int Rb = Epi::PERM ? ((R & ~31) + perm32(R & 31)) : R;
        voffA[i] = Sched::GATHER ? (unsigned)C * 2u : (unsigned)(R * rowb + C * 2); voffB[i] = (unsigned)(Rb * rowb + C * 2); }
    const size_t kstep = (size_t)(BK * 2);
    const size_t hstep = (size_t)HALF * rowb;
    const unsigned ldsw = (unsigned)wid * 1024u;
    const int aoff = lds_byte(wr * 64 + fr, fq * 8), boff = lds_byte(wc * 32 + fr, fq * 8);
#define PG8_SA(b, h) (((b) * 2 + (h)) * HTB)
#define PG8_SB(b, h) ((4 + (b) * 2 + (h)) * HTB)
#define PG8_STAGE(bufoff, gbase, v0, v1) do { \
        __builtin_amdgcn_global_load_lds((const unsigned*)((const char*)(gbase) + (v0)), (LAS unsigned*)(lds + (bufoff) + ldsw), 16, 0, 0); \
        __builtin_amdgcn_global_load_lds((const unsigned*)((const char*)(gbase) + (v1)), (LAS unsigned*)(lds + (bufoff) + ldsw + 8192), 16, 0, 0); } while (0)
#define PG8_STAGE_A(bufoff, gbase, h) do { if constexpr (Sched::GATHER) { PG8_STAGE(bufoff, gbase, (unsigned)tok[h][0] * (unsigned)rowb + voffA[0], (unsigned)tok[h][1] * (unsigned)rowb + voffA[1]); } \
        else { PG8_STAGE(bufoff, (gbase) + (h) * hstep, voffA[0], voffA[1]); } } while (0)
#define PG8_LDA_(dst, b, h) do { if constexpr (F8) { _Pragma("unroll") for (int m = 0; m < 4; ++m) { const i32x4 lo_ = *(const LAS i32x4*)(lds + PG8_SA(b, h) + aoff + m * 2048), hi_ = *(const LAS i32x4*)(lds + PG8_SA(b, h) + aoff + m * 2048 + 1024); \
            dst##8[m] = __builtin_shufflevector(lo_, hi_, 0, 1, 2, 3, 4, 5, 6, 7); } } \
        else { _Pragma("unroll") for (int m = 0; m < 4; ++m) _Pragma("unroll") for (int k = 0; k < 2; ++k) dst[m][k] = *(const LAS bf16x8*)(lds + PG8_SA(b, h) + aoff + m * 2048 + k * 1024); } } while (0)
#define PG8_LDB_(dst, b, h) do { if constexpr (F8) { _Pragma("unroll") for (int n = 0; n < 2; ++n) { const i32x4 lo_ = *(const LAS i32x4*)(lds + PG8_SB(b, h) + boff + n * 2048), hi_ = *(const LAS i32x4*)(lds + PG8_SB(b, h) + boff + n * 2048 + 1024); \
            dst##8[n] = __builtin_shufflevector(lo_, hi_, 0, 1, 2, 3, 4, 5, 6, 7); } } \
        else { _Pragma("unroll") for (int n = 0; n < 2; ++n) _Pragma("unroll") for (int k = 0; k < 2; ++k) dst[n][k] = *(const LAS bf16x8*)(lds + PG8_SB(b, h) + boff + n * 2048 + k * 1024); } } while (0)
#define PG8_LDA(dst, b, h) PG8_LDA_(dst, b, h)
#define PG8_LDB(dst, b, h) PG8_LDB_(dst, b, h)
#define PG8_MMA(ai, bj, At, Bt) do { __builtin_amdgcn_s_setprio(1); \
        if constexpr (F8) { _Pragma("unroll") for (int m = 0; m < 4; ++m) _Pragma("unroll") for (int n = 0; n < 2; ++n) \
            acc[ai][bj][m][n] = __builtin_amdgcn_mfma_scale_f32_16x16x128_f8f6f4(Bt##8[n], At##8[m], acc[ai][bj][m][n], 0, 0, 0, 0x7f7f7f7f, 0, 0x7f7f7f7f); } \
        else { _Pragma("unroll") for (int m = 0; m < 4; ++m) _Pragma("unroll") for (int n = 0; n < 2; ++n) _Pragma("unroll") for (int k = 0; k < 2; ++k) \
            acc[ai][bj][m][n] = __builtin_amdgcn_mfma_f32_16x16x32_bf16(Bt[n][k], At[m][k], acc[ai][bj][m][n], 0, 0, 0); } \
        __builtin_amdgcn_s_setprio(0); } while (0)
#define PG8_WAIT_V(n) asm volatile("s_waitcnt vmcnt(" #n ")" ::: "memory")
#define PG8_WAIT_L(n) asm volatile("s_waitcnt lgkmcnt(" #n ")" ::: "memory")
#define PG8_BAR __builtin_amdgcn_s_barrier()
#define PG8_SCHED __builtin_amdgcn_sched_barrier(0)
    Unit cur, nxt; int ui = 0;
    if (!S.next(0, cur)) return;
    f32x4 acc[2][2][4][2];
#pragma unroll
    for (int a = 0; a < 2; ++a)
#pragma unroll
        for (int b = 0; b < 2; ++b)
#pragma unroll
            for (int m = 0; m < 4; ++m)
#pragma unroll
                for (int n = 0; n < 2; ++n) acc[a][b][m][n] = (f32x4){0.f, 0.f, 0.f, 0.f};
    bf16x8 At[4][2], B0[2][2], B1[2][2]; i32x8 At8[4], B08[2], B18[2];
    int tok[2][2] = {{0, 0}, {0, 0}};
    if constexpr (Sched::GATHER) S.load_tok(cur, 0, Rp, tok);
    const char* cA = S.a_ptr(cur); const char* cB = S.b_ptr(cur);
    PG8_STAGE(PG8_SB(0, 0), cB, voffB[0], voffB[1]); PG8_STAGE(PG8_SB(0, 1), cB + hstep, voffB[0], voffB[1]); PG8_STAGE_A(PG8_SA(0, 0), cA, 0); PG8_STAGE_A(PG8_SA(0, 1), cA, 1);
    if (wr == 1) PG8_BAR;
    PG8_WAIT_V(2); PG8_BAR;
    PG8_STAGE(PG8_SB(1, 0), cB + kstep, voffB[0], voffB[1]); PG8_STAGE_A(PG8_SA(1, 0), cA + kstep, 0); PG8_STAGE(PG8_SB(1, 1), cB + hstep + kstep, voffB[0], voffB[1]);
    PG8_WAIT_V(6); PG8_BAR;
    for (;;) {
        if constexpr (Epi::PRE) E.pre(cur, wid, lane);
        const bool has_next = S.next(ui + 1, nxt);
        const char* nA = has_next ? S.a_ptr(nxt) : cA; const char* nB = has_next ? S.b_ptr(nxt) : cB;
#pragma unroll 1
        for (int t = 0; t < nt; t += 2) {
            const bool last = (t == nt - 2);
            const char* a1 = cA + (size_t)(t + 1) * kstep;
            const char* a2 = last ? nA : cA + (size_t)(t + 2) * kstep; const char* b2 = last ? nB : cB + (size_t)(t + 2) * kstep;
            const char* a3 = a2 + kstep; const char* b3 = b2 + kstep;
            PG8_LDB(B0, 0, 0); PG8_LDB(B1, 0, 1); PG8_SCHED; PG8_LDA(At, 0, 0); PG8_STAGE_A(PG8_SA(1, 1), a1, 1);
            if constexpr (Sched::GATHER) { if (last && has_next) S.load_tok(nxt, ui + 1, Rp, tok); }
            PG8_WAIT_V(8); PG8_WAIT_L(0); PG8_BAR; PG8_MMA(0, 0, At, B0); PG8_MMA(0, 1, At, B1); PG8_BAR; PG8_SCHED;
            PG8_LDA(At, 0, 1); PG8_STAGE(PG8_SB(0, 0), b2, voffB[0], voffB[1]); PG8_STAGE(PG8_SB(0, 1), b2 + hstep, voffB[0], voffB[1]); PG8_STAGE_A(PG8_SA(0, 0), a2, 0);
            PG8_WAIT_V(8); PG8_WAIT_L(0); PG8_BAR; PG8_MMA(1, 0, At, B0); PG8_MMA(1, 1, At, B1); PG8_BAR; PG8_SCHED;
            PG8_LDB(B0, 1, 0); PG8_LDB(B1, 1, 1); PG8_SCHED; PG8_LDA(At, 1, 0); PG8_STAGE_A(PG8_SA(0, 1), a2, 1);
            PG8_WAIT_V(8); PG8_WAIT_L(0); PG8_BAR; PG8_MMA(0, 0, At, B0); PG8_MMA(0, 1, At, B1); PG8_BAR; PG8_SCHED;
            PG8_LDA(At, 1, 1); PG8_STAGE(PG8_SB(1, 0), b3, voffB[0], voffB[1]); PG8_STAGE(PG8_SB(1, 1), b3 + hstep, voffB[0], voffB[1]); PG8_STAGE_A(PG8_SA(1, 0), a3, 0);
            PG8_WAIT_V(8); PG8_WAIT_L(0); PG8_BAR; PG8_MMA(1, 0, At, B0); PG8_MMA(1, 1, At, B1); PG8_BAR; PG8_SCHED;
        }
        if constexpr (ALIGN_EPI) { if (wr == 0) PG8_BAR; }
        { int fr_ = fr, fq_ = fq; asm volatile("" : "+v"(fr_), "+v"(fq_));
          E(acc, cur, ui, wr, wc, fr_, fq_); }
        if (!has_next) break;
#pragma unroll
        for (int a = 0; a < 2; ++a)
#pragma unroll
            for (int b = 0; b < 2; ++b)
#pragma unroll
                for (int m = 0; m < 4; ++m)
#pragma unroll
                    for (int n = 0; n < 2; ++n) acc[a][b][m][n] = (f32x4){0.f, 0.f, 0.f, 0.f};
        cur = nxt; cA = nA; cB = nB; ++ui;
        if constexpr (ALIGN_EPI) { if (wr == 1) PG8_BAR; }
    }
    PG8_WAIT_V(0);
    if constexpr (!ALIGN_EPI) { if (wr == 0) PG8_BAR; }
    PG8_BAR;
#undef PG8_SA
#undef PG8_SB
#undef PG8_STAGE
#undef PG8_STAGE_A
#undef PG8_LDA
#undef PG8_LDB
#undef PG8_LDA_
#undef PG8_LDB_
#undef PG8_MMA
#undef PG8_WAIT_V
#undef PG8_WAIT_L
#undef PG8_BAR
#undef PG8_SCHED
}

struct SchedDense {
    const char* A; const char* B; int nN, nUnits, G, vcu, K;
    __device__ __forceinline__ bool next(int i, Unit& u) const { const int L = i * G + vcu; if (L >= nUnits) return false; u.pm = L / nN; u.pn = L - u.pm * nN; u.e = 0; return true; }
    __device__ __forceinline__ const char* a_ptr(const Unit& u) const { return A + (size_t)u.pm * BM * K * 2; }
    __device__ __forceinline__ const char* b_ptr(const Unit& u) const { return B + (size_t)u.pn * BM * K * 2; }
    static constexpr bool GATHER = false;
    __device__ __forceinline__ void load_tok(const Unit&, int, const int (&)[2], int (&)[2][2]) const {}
};
__device__ __forceinline__ int find_expert(const LAS int* blk, int rb) { int e = 0;
#pragma unroll
    for (int j = 1; j < NEXP; ++j) e += (rb >= blk[j]) ? 1 : 0;
    return e; }
struct SchedMoe1 {
    const char* A; const char* W; const LAS int* blk; const LAS int* idx; int nUnits, G, vcu;
    __device__ __forceinline__ bool next(int i, Unit& u) const { const int L = i * G + vcu; if (L >= nUnits) return false; u.pm = L >> 3; u.pn = L & 7; u.e = find_expert(blk, u.pm); return true; }
    __device__ __forceinline__ const char* a_ptr(const Unit&) const { return A; }
    __device__ __forceinline__ const char* b_ptr(const Unit& u) const { return W + ((size_t)u.e * 2048 + (size_t)u.pn * 256) * DM; }
    static constexpr bool GATHER = true;
    __device__ __forceinline__ void load_tok(const Unit&, int ui, const int (&Rp)[2], int (&tok)[2][2]) const {
#pragma unroll
        for (int h = 0; h < 2; ++h)
#pragma unroll
            for (int i = 0; i < 2; ++i) tok[h][i] = idx[ui * 256 + h * HALF + Rp[i]];
    }
};
struct SchedMoe2 {
    const char* A; const char* W; const LAS int* blk; int nUnits, G, vcu;
    __device__ __forceinline__ bool next(int i, Unit& u) const { const int L = i * G + vcu; if (L >= nUnits) return false; u.pm = L >> 2; u.pn = L & 3; u.e = find_expert(blk, u.pm); return true; }
    __device__ __forceinline__ const char* a_ptr(const Unit&) const { return A; }
    __device__ __forceinline__ const char* b_ptr(const Unit& u) const { return W + ((size_t)u.e * 1024 + (size_t)u.pn * 256) * DM; }
    static constexpr bool GATHER = true;
    __device__ __forceinline__ void load_tok(const Unit& u, int, const int (&Rp)[2], int (&tok)[2][2]) const {
#pragma unroll
        for (int h = 0; h < 2; ++h)
#pragma unroll
            for (int i = 0; i < 2; ++i) tok[h][i] = u.pm * BM + h * HALF + Rp[i];
    }
};

struct EpiInProj {
    static constexpr bool PERM = true, PRE = false;
    bf16_t* QKV; const float* rope;
    __device__ __forceinline__ void operator()(const f32x4 (&acc)[2][2][4][2], const Unit& u, int, int wr, int wc, int fr, int fq) const {
        const int t = u.pn >> 1; bf16_t* base = QKV + (size_t)t * NTOK * 512;
        const float sc = (t == 0 || t == 3) ? QSCALE : 1.0f;
        const bool dorope = (t < 2) && ((wc & 1) == 0);
        const int col0 = (u.pn & 1) * 256 + wc * 32 + 8 * fq;
        const float sgn = (fq == 0) ? -1.0f : 1.0f; const bool rl = fq < 2;
#pragma unroll
        for (int ai = 0; ai < 2; ++ai)
#pragma unroll
            for (int m = 0; m < 4; ++m) {
                const int row = u.pm * BM + ai * HALF + wr * 64 + m * 16 + fr;
                f32x4 cs0 = {1.f, 1.f, 1.f, 1.f}, cs1 = cs0, sn0 = {0.f, 0.f, 0.f, 0.f}, sn1 = sn0;
                if (dorope) { const f32x4* rp = (const f32x4*)(rope + (size_t)row * 16); cs0 = rp[0]; cs1 = rp[1]; sn0 = rp[2]; sn1 = rp[3]; }
#pragma unroll
                for (int bj = 0; bj < 2; ++bj) {
                    f32x4 v0 = acc[ai][bj][m][0], v1 = acc[ai][bj][m][1];
                    if (dorope) {
#pragma unroll
                        for (int i = 0; i < 4; ++i) { const float p0 = __shfl_xor(v0[i], 16), p1 = __shfl_xor(v1[i], 16);
                            const float r0 = v0[i] * cs0[i] + sgn * p0 * sn0[i], r1 = v1[i] * cs1[i] + sgn * p1 * sn1[i];
                            v0[i] = rl ? r0 : v0[i]; v1[i] = rl ? r1 : v1[i]; }
                    }
                    v0 = v0 * sc; v1 = v1 * sc;
                    u32x4 w; w.x = cvt_pk_bf16(v0[0], v0[1]); w.y = cvt_pk_bf16(v0[2], v0[3]); w.z = cvt_pk_bf16(v1[0], v1[1]); w.w = cvt_pk_bf16(v1[2], v1[3]);
                    *(u32x4*)(base + (size_t)row * 512 + col0 + bj * HALF) = w;
                }
            }
    }
};
struct EpiOutProj {
    static constexpr bool PERM = false, PRE = false;
    const float* xin; float* xout; const float* g1;
    __device__ __forceinline__ void operator()(const f32x4 (&acc)[2][2][4][2], const Unit& u, int, int wr, int wc, int fr, int fq) const {
        const int b = u.pm >> 4; const int col0 = u.pn * BM + wc * 32 + 4 * fq;
        f32x4 gv[2][2];
#pragma unroll
        for (int bj = 0; bj < 2; ++bj)
#pragma unroll
            for (int n = 0; n < 2; ++n) gv[bj][n] = *(const f32x4*)(g1 + (size_t)b * 6144 + col0 + bj * HALF + n * 16);
#pragma unroll
        for (int ai = 0; ai < 2; ++ai)
#pragma unroll
            for (int m = 0; m < 4; ++m) { const size_t off = (size_t)(u.pm * BM + ai * HALF + wr * 64 + m * 16 + fr) * DM + col0;
#pragma unroll
                for (int bj = 0; bj < 2; ++bj)
#pragma unroll
                    for (int n = 0; n < 2; ++n) { const f32x4 xi = *(const f32x4*)(xin + off + bj * HALF + n * 16); *(f32x4*)(xout + off + bj * HALF + n * 16) = xi + gv[bj][n] * acc[ai][bj][m][n]; }
            }
    }
};
struct EpiMoe1 {
    static constexpr bool PERM = true, PRE = true;
    unsigned char* HID; const float* b1; LAS float* biasl;
    __device__ __forceinline__ void pre(const Unit& u, int wid, int lane) const {
        const float* g = b1 + (size_t)u.e * 2048 + u.pn * HALF + ((lane < 32) ? 4 * lane : 1024 + 4 * (lane - 32));
        __builtin_amdgcn_global_load_lds((const unsigned*)g, (LAS unsigned*)(biasl + wid * 256), 16, 0, 0);
    }
    __device__ __forceinline__ void operator()(const f32x4 (&acc)[2][2][4][2], const Unit& u, int, int wr, int wc, int fr, int fq) const {
        const int wid = wr * 4 + wc; const int hl = wc * 32 + 8 * fq; const int hc = u.pn * HALF + hl; const LAS float* bb = biasl + wid * 256 + hl;
        const f32x4 bg0 = *(const LAS f32x4*)(bb), bg1 = *(const LAS f32x4*)(bb + 4), bu0 = *(const LAS f32x4*)(bb + 128), bu1 = *(const LAS f32x4*)(bb + 132);
#pragma unroll
        for (int ai = 0; ai < 2; ++ai)
#pragma unroll
            for (int m = 0; m < 4; ++m) {
                const size_t row = (size_t)u.pm * BM + ai * HALF + wr * 64 + m * 16 + fr;
                float o[8];
#pragma unroll
                for (int n = 0; n < 2; ++n) { const f32x4 g = acc[ai][0][m][n] * 0.03125f + (n ? bg1 : bg0), up = acc[ai][1][m][n] * 0.03125f + (n ? bu1 : bu0);
#pragma unroll
                    for (int i = 0; i < 4; ++i) { const float gt = fminf(g[i], 7.0f), uu = fminf(fmaxf(up[i], -7.0f), 7.0f);
                        const float sg = __builtin_amdgcn_rcpf(1.0f + __builtin_amdgcn_exp2f(-1.702f * LOG2E * gt)); o[n * 4 + i] = (uu + 1.0f) * gt * sg; } }
                u32x2 w; w.x = pack4_fp8(o[0], o[1], o[2], o[3]); w.y = pack4_fp8(o[4], o[5], o[6], o[7]);
                *(u32x2*)(HID + row * DM + hc) = w;
            }
    }
};
struct EpiMoe2 {
    static constexpr bool PERM = true, PRE = true;
    bf16_t* Y; const float* b2; const LAS int* aidx; LAS float* biasl;
    __device__ __forceinline__ void pre(const Unit& u, int wid, int lane) const {
        __builtin_amdgcn_global_load_lds((const unsigned*)(b2 + (size_t)u.e * 1024 + u.pn * BM + 4 * lane), (LAS unsigned*)(biasl + wid * 256), 16, 0, 0);
    }
    __device__ __forceinline__ void operator()(const f32x4 (&acc)[2][2][4][2], const Unit& u, int ui, int wr, int wc, int fr, int fq) const {
        const int wid = wr * 4 + wc; const int cl = wc * 32 + 8 * fq; const int col0 = u.pn * BM + cl; const LAS float* bb = biasl + wid * 256 + cl;
        f32x4 bv[2][2];
#pragma unroll
        for (int bj = 0; bj < 2; ++bj)
#pragma unroll
            for (int n = 0; n < 2; ++n) bv[bj][n] = *(const LAS f32x4*)(bb + bj * HALF + 4 * n);
#pragma unroll
        for (int ai = 0; ai < 2; ++ai)
#pragma unroll
            for (int m = 0; m < 4; ++m) {
                const int aid = aidx[ui * 256 + ai * HALF + wr * 64 + m * 16 + fr];
#pragma unroll
                for (int bj = 0; bj < 2; ++bj) { const f32x4 v0 = acc[ai][bj][m][0] * 0.03125f + bv[bj][0], v1 = acc[ai][bj][m][1] * 0.03125f + bv[bj][1];
                    u32x4 w; w.x = cvt_pk_bf16(v0[0], v0[1]); w.y = cvt_pk_bf16(v0[2], v0[3]); w.z = cvt_pk_bf16(v1[0], v1[1]); w.w = cvt_pk_bf16(v1[2], v1[3]);
                    *(u32x4*)(Y + (size_t)aid * DM + col0 + bj * HALF) = w; }
            }
    }
};
}

namespace att {
constexpr int STG_F = 16384, STG_D = 32768;
constexpr int LDS_NCK = 98304;
typedef LAS const char* lds_cptr;
typedef short v4i16_t __attribute__((ext_vector_type(4)));
typedef __bf16 bf16x2_t __attribute__((ext_vector_type(2)));
__device__ __forceinline__ void glds16(const void* gsrc, unsigned lds_dst) { unsigned keep;
    asm volatile("s_mov_b32 %0, m0\n\ts_mov_b32 m0, %2\n\ts_nop 0\n\tglobal_load_lds_dwordx4 %1, off\n\ts_mov_b32 m0, %0" : "=&s"(keep) : "v"(gsrc), "s"(lds_dst) : "memory"); }
__device__ __forceinline__ unsigned cvtpk(float lo, float hi) { f32x2 v = {lo, hi}; bf16x2_t b = __builtin_convertvector(v, bf16x2_t); return __builtin_bit_cast(unsigned, b); }
__device__ __forceinline__ s16x4 vtr(lds_cptr p) { return __builtin_bit_cast(s16x4, __builtin_amdgcn_ds_read_tr16_b64_v4i16((LAS v4i16_t*)p)); }
__device__ __forceinline__ float swapmax(float m) { auto rr = __builtin_amdgcn_permlane32_swap(__float_as_uint(m), __float_as_uint(m), false, false); return fmaxf(__uint_as_float(rr[0]), __uint_as_float(rr[1])); }
__device__ __forceinline__ float swapsum(float m) { auto rr = __builtin_amdgcn_permlane32_swap(__float_as_uint(m), __float_as_uint(m), false, false); return __uint_as_float(rr[0]) + __uint_as_float(rr[1]); }
#define ATT_WAIT_BAR(N) asm volatile("s_waitcnt vmcnt(" #N ") lgkmcnt(0)\n\ts_barrier" ::: "memory")
#define ATT_BAR() asm volatile("s_waitcnt lgkmcnt(0)\n\ts_barrier" ::: "memory")

__device__ __forceinline__ float max3f(float a, float b, float c) { float r; asm("v_max3_f32 %0, %1, %2, %3" : "=v"(r) : "v"(a), "v"(b), "v"(c)); return r; }
template <int NO, bool REL>
__device__ __forceinline__ void softmax_tile(f32x16& p0, f32x16& p1, float& m, float& l, f32x16 (&o)[NO], u32x4 (&pw)[4], f32x16& negm, bool first) {
    float mx = max3f(p0[0], p1[0], p0[1]);
    mx = max3f(mx, p1[1], p0[2]); mx = max3f(mx, p1[2], p0[3]); mx = max3f(mx, p1[3], p0[4]); mx = max3f(mx, p1[4], p0[5]); mx = max3f(mx, p1[5], p0[6]); mx = max3f(mx, p1[6], p0[7]);
    float my = max3f(p1[7], p0[8], p1[8]);
    my = max3f(my, p0[9], p1[9]); my = max3f(my, p0[10], p1[10]); my = max3f(my, p0[11], p1[11]); my = max3f(my, p0[12], p1[12]); my = max3f(my, p0[13], p1[13]); my = max3f(my, p0[14], p1[14]);
    mx = max3f(mx, my, p0[15]); mx = fmaxf(mx, p1[15]);
    mx = swapmax(mx);
    if constexpr (REL) {
        if (first || __any(mx > 8.0f)) {
            const float dl = first ? mx : fmaxf(mx, 0.f); const float al = __builtin_amdgcn_exp2f(-dl); m += dl; l *= al;
#pragma unroll
            for (int r = 0; r < 16; ++r) { p0[r] -= dl; p1[r] -= dl; negm[r] = -m; }
#pragma unroll
            for (int d = 0; d < NO; ++d)
#pragma unroll
                for (int r = 0; r < 16; ++r) o[d][r] *= al;
        }
    } else {
        if (__any(mx > m + 8.0f)) {
            const float mn = fmaxf(m, mx); const float al = __builtin_amdgcn_exp2f(m - mn); m = mn; l *= al;
#pragma unroll
            for (int d = 0; d < NO; ++d)
#pragma unroll
                for (int r = 0; r < 16; ++r) o[d][r] *= al;
        }
#pragma unroll
        for (int r = 0; r < 16; ++r) { p0[r] -= m; p1[r] -= m; }
    }
    float ls0 = 0.f, ls1 = 0.f;
#pragma unroll
    for (int r = 0; r < 16; ++r) { p0[r] = __builtin_amdgcn_exp2f(p0[r]); p1[r] = __builtin_amdgcn_exp2f(p1[r]); ls0 += p0[r]; ls1 += p1[r]; }
    l += ls0 + ls1;
    pw[0] = (u32x4){cvtpk(p0[0], p0[1]), cvtpk(p0[2], p0[3]), cvtpk(p0[4], p0[5]), cvtpk(p0[6], p0[7])};
    pw[1] = (u32x4){cvtpk(p0[8], p0[9]), cvtpk(p0[10], p0[11]), cvtpk(p0[12], p0[13]), cvtpk(p0[14], p0[15])};
    pw[2] = (u32x4){cvtpk(p1[0], p1[1]), cvtpk(p1[2], p1[3]), cvtpk(p1[4], p1[5]), cvtpk(p1[6], p1[7])};
    pw[3] = (u32x4){cvtpk(p1[8], p1[9]), cvtpk(p1[10], p1[11]), cvtpk(p1[12], p1[13]), cvtpk(p1[14], p1[15])};
}
#define ATT_SBAR() __builtin_amdgcn_sched_barrier(0)
struct VFrag { s16x4 lo[4], hi[4]; };
__device__ __forceinline__ void vload(VFrag& f, lds_cptr vp, int d) {
#pragma unroll
    for (int ks = 0; ks < 4; ++ks) { f.lo[ks] = vtr(vp + d * 4096 + ks * 1024); f.hi[ks] = vtr(vp + d * 4096 + ks * 1024 + 512); }
}
__device__ __forceinline__ void pv_block(f32x16& o, const VFrag& f, const u32x4 (&pw)[4]) {
#pragma unroll
    for (int ks = 0; ks < 4; ++ks) {
        const bf16x8 vf = (bf16x8){f.lo[ks][0], f.lo[ks][1], f.lo[ks][2], f.lo[ks][3], f.hi[ks][0], f.hi[ks][1], f.hi[ks][2], f.hi[ks][3]};
        o = __builtin_amdgcn_mfma_f32_32x32x16_bf16(vf, __builtin_bit_cast(bf16x8, pw[ks]), o, 0, 0, 0);
    }
}
__device__ __forceinline__ void kload(bf16x8 (&kf)[8], lds_cptr kb, int hi, int sw) {
#pragma unroll
    for (int d0 = 0; d0 < 4; ++d0) { const int co = ((2 * d0 + hi) ^ sw) << 4; kf[2 * d0] = *(const LAS bf16x8*)(kb + co); kf[2 * d0 + 1] = *(const LAS bf16x8*)(kb + co + 4096); }
}
__device__ __forceinline__ void qk_mma(f32x16& p0, f32x16& p1, const bf16x8 (&kf)[8], const bf16x8 (&qr)[4]) {
#pragma unroll
    for (int d0 = 0; d0 < 4; ++d0) {
        p0 = __builtin_amdgcn_mfma_f32_32x32x16_bf16(kf[2 * d0], qr[d0], p0, 0, 0, 0);
        p1 = __builtin_amdgcn_mfma_f32_32x32x16_bf16(kf[2 * d0 + 1], qr[d0], p1, 0, 0, 0);
    }
}

template <int PV>
__device__ __forceinline__ void fox_unit(int b, int h, int qb, const bf16_t* FQ, const bf16_t* FK, const bf16_t* FV, const float* NCK, bf16_t* AO, char* shm) {
    const int tid = fresh_tid(), lane = tid & 63, r32 = lane & 31, hi = lane >> 5; const int wid = __builtin_amdgcn_readfirstlane(tid >> 6);
    const long rowbase = (long)b * SEQ; const int q0 = qb * 256;
    const int NT = 4 * (qb + 1), tl = 4 * qb + (wid >> 1);
    const unsigned lds0 = (unsigned)(uintptr_t)shm;
    const lds_cptr shm3 = (lds_cptr)shm;
    LAS float* nckl = (LAS float*)(shm3 + LDS_NCK);
    const int krow = wid * 8 + (lane >> 3);
    const bf16_t* ksrc = FK + (rowbase + krow) * 512 + h * 64 + (((lane & 7) ^ ((krow >> 1) & 7)) << 3);
    const bf16_t* vsrc = FV + (rowbase + 16 * (wid & 3) + (lane >> 2)) * 512 + h * 64 + (wid >> 2) * 32 + (lane & 3) * 8;
    const unsigned kdst = lds0 + wid * 1024, vdst = lds0 + 8192 + wid * 1024;
#define FOX_DMA(t, so) do { glds16(ksrc + (long)(t) * 64 * 512, (unsigned)__builtin_amdgcn_readfirstlane(kdst + (so))); glds16(vsrc + (long)(t) * 64 * 512, (unsigned)__builtin_amdgcn_readfirstlane(vdst + (so))); } while (0)
    if ((PV & 8) == 0) { FOX_DMA(0, 0); FOX_DMA(1, STG_F); }
    { const f32x4* src = (const f32x4*)(NCK + (size_t)(b * 8 + h) * SEQ); const int n4 = 16 * NT;
      f32x4 c0 = {0.f, 0.f, 0.f, 0.f}, c1 = c0; if (tid < n4) c0 = src[tid]; if (tid + NTHR < n4) c1 = src[tid + NTHR];
      if (tid < n4) ((LAS f32x4*)nckl)[tid] = c0; if (tid + NTHR < n4) ((LAS f32x4*)nckl)[tid + NTHR] = c1; }
    const bf16_t* Qw = FQ + (rowbase + q0 + wid * 32 + r32) * 512 + h * 64;
    bf16x8 qr[4];
#pragma unroll
    for (int d0 = 0; d0 < 4; ++d0) qr[d0] = *(const bf16x8*)(Qw + d0 * 16 + hi * 8);
    asm volatile("" : "+v"(qr[0]), "+v"(qr[1]), "+v"(qr[2]), "+v"(qr[3]));
    const lds_cptr kp0 = shm3 + r32 * 128; const int ksw = (r32 >> 1) & 7;
    const lds_cptr vp0 = shm3 + 8192 + ((lane >> 4) & 1) * 32 + (lane & 3) * 8 + (4 * hi + ((lane & 15) >> 2)) * 64;
    float m = -1e30f, l = 0.f; f32x16 o[2]; o[0] = f32x16{}; o[1] = f32x16{};
    const int qrow = q0 + wid * 32 + r32;
    int so = 0, so2 = 2 * STG_F;
    for (int t = 0; t < NT; ++t) {
        if ((PV & 8) == 0) { if (t + 1 < NT) ATT_WAIT_BAR(2); else ATT_WAIT_BAR(0); } else ATT_BAR();
        bf16x8 kf[8];
        if ((PV & 4) == 0 && t <= tl) kload(kf, kp0 + so, hi, ksw);
        if ((PV & 8) == 0 && t + 2 < NT) FOX_DMA(t + 2, so2);
        if (t <= tl) {
            f32x16 p0, p1; VFrag va, vb;
            const LAS float* nk = nckl + 64 * t + 4 * hi;
#pragma unroll
            for (int g = 0; g < 4; ++g) { const f32x4 a = *(const LAS f32x4*)(nk + 8 * g), c = *(const LAS f32x4*)(nk + 32 + 8 * g);
                p0[4 * g] = a[0]; p0[4 * g + 1] = a[1]; p0[4 * g + 2] = a[2]; p0[4 * g + 3] = a[3]; p1[4 * g] = c[0]; p1[4 * g + 1] = c[1]; p1[4 * g + 2] = c[2]; p1[4 * g + 3] = c[3]; }
            if ((PV & 1) == 0) vload(va, vp0 + so, 0);
            ATT_SBAR();
            if ((PV & 4) == 0) qk_mma(p0, p1, kf, qr);
            asm volatile("s_nop 15\n\ts_nop 7" : "+v"(p0), "+v"(p1));
            ATT_SBAR();
            if (t == tl) { const int kb = 64 * t + 4 * hi;
#pragma unroll
                for (int r = 0; r < 16; ++r) { const int kv = kb + (r & 3) + 8 * (r >> 2); if (kv > qrow) p0[r] = -INFINITY; if (kv + 32 > qrow) p1[r] = -INFINITY; } }
            u32x4 pw[4];
            if ((PV & 2) == 0) softmax_tile<2, false>(p0, p1, m, l, o, pw, p0, false); else { pw[0] = (u32x4){__float_as_uint(p0[0]), __float_as_uint(p0[1]), __float_as_uint(p1[0]), __float_as_uint(p1[1])}; pw[1] = pw[0]; pw[2] = pw[0]; pw[3] = pw[0]; }
            ATT_SBAR();
            if ((PV & 1) == 0) { vload(vb, vp0 + so, 1);
            pv_block(o[0], va, pw);
            ATT_SBAR();
            pv_block(o[1], vb, pw); } else { o[0][0] += __uint_as_float(pw[0][0]); o[1][0] += __uint_as_float(pw[1][1]); }
            ATT_SBAR();
        }
        so = (so == 2 * STG_F) ? 0 : so + STG_F; so2 = (so2 == 2 * STG_F) ? 0 : so2 + STG_F;
    }
#undef FOX_DMA
    l = swapsum(l);
    const float inv = __builtin_amdgcn_rcpf(l);
    bf16_t* Ow = AO + (rowbase + qrow) * 1024 + 512 + h * 64 + 4 * hi;
#pragma unroll
    for (int d = 0; d < 2; ++d)
#pragma unroll
        for (int g = 0; g < 4; ++g) { u32x2 w; w.x = cvt_pk_bf16(o[d][4 * g] * inv, o[d][4 * g + 1] * inv); w.y = cvt_pk_bf16(o[d][4 * g + 2] * inv, o[d][4 * g + 3] * inv);
            *(u32x2*)(Ow + d * 32 + 8 * g) = w; }
    ATT_BAR();
}

template <int PV>
__device__ __forceinline__ void diff_unit(int b, int h, int qb, const bf16_t* DQ, const bf16_t* DK, const bf16_t* DV, const float* subg, float lam, float post, bf16_t* AO, char* shm) {
    const int tid = fresh_tid(), lane = tid & 63, r32 = lane & 31, hi = lane >> 5; const int wid = __builtin_amdgcn_readfirstlane(tid >> 6);
    const int map = wid >> 2, wq = wid & 3;
    const long rowbase = (long)b * SEQ; const int q0 = qb * 128;
    const int NT = 2 * (qb + 1), tl = 2 * qb + (wq >> 1);
    const unsigned lds0 = (unsigned)(uintptr_t)shm;
    const lds_cptr shm3 = (lds_cptr)shm;
    const int qrow = q0 + wq * 32 + r32;
    const int krow = wid * 8 + (lane >> 3);
    const bf16_t* ksrc = DK + (rowbase + krow) * 512 + h * 128 + (((lane & 7) ^ ((krow >> 1) & 7)) << 3);
    const bf16_t* vsrc = DV + (rowbase + 16 * (wid & 3) + (lane >> 2)) * 512 + h * 128 + (wid >> 2) * 32 + (lane & 3) * 8;
    const unsigned kdst = lds0 + wid * 1024, vdst = lds0 + 16384 + wid * 1024;
#define DIFF_DMA(t, so) do { glds16(ksrc + (long)(t) * 64 * 512, (unsigned)__builtin_amdgcn_readfirstlane(kdst + (so))); glds16(ksrc + (long)(t) * 64 * 512 + 64, (unsigned)__builtin_amdgcn_readfirstlane(kdst + 8192 + (so))); \
        glds16(vsrc + (long)(t) * 64 * 512, (unsigned)__builtin_amdgcn_readfirstlane(vdst + (so))); glds16(vsrc + (long)(t) * 64 * 512 + 64, (unsigned)__builtin_amdgcn_readfirstlane(vdst + 8192 + (so))); } while (0)
    if ((PV & 8) == 0) { DIFF_DMA(0, 0); DIFF_DMA(1, STG_D); }
    const bf16_t* Qw = DQ + (rowbase + qrow) * 512 + h * 128 + map * 64;
    bf16x8 qr[4];
#pragma unroll
    for (int d0 = 0; d0 < 4; ++d0) qr[d0] = *(const bf16x8*)(Qw + d0 * 16 + hi * 8);
    asm volatile("" : "+v"(qr[0]), "+v"(qr[1]), "+v"(qr[2]), "+v"(qr[3]));
    const lds_cptr kp0 = shm3 + map * 8192 + r32 * 128; const int ksw = (r32 >> 1) & 7;
    const lds_cptr vp0 = shm3 + 16384 + ((lane >> 4) & 1) * 32 + (lane & 3) * 8 + (4 * hi + ((lane & 15) >> 2)) * 64;
    float m = 0.f, l = 0.f; f32x16 o[4]; o[0] = f32x16{}; o[1] = f32x16{}; o[2] = f32x16{}; o[3] = f32x16{};
    f32x16 negm = f32x16{}; asm volatile("" : "+v"(negm));
    int so = 0, so2 = 2 * STG_D;
    for (int t = 0; t < NT; ++t) {
        if ((PV & 8) == 0) { if (t + 1 < NT) ATT_WAIT_BAR(4); else ATT_WAIT_BAR(0); } else ATT_BAR();
        bf16x8 kf[8];
        if ((PV & 4) == 0 && t <= tl) kload(kf, kp0 + so, hi, ksw);
        if ((PV & 8) == 0 && t + 2 < NT) DIFF_DMA(t + 2, so2);
        if (t <= tl) {
            f32x16 p0 = negm, p1 = negm; VFrag va, vb;
            if ((PV & 1) == 0) vload(va, vp0 + so, 0);
            ATT_SBAR();
            if ((PV & 4) == 0) qk_mma(p0, p1, kf, qr);
            asm volatile("s_nop 15\n\ts_nop 7" : "+v"(p0), "+v"(p1));
            ATT_SBAR();
            u32x4 pw[4];
            if ((PV & 2) == 0) softmax_tile<4, true>(p0, p1, m, l, o, pw, negm, t == 0); else { pw[0] = (u32x4){__float_as_uint(p0[0]), __float_as_uint(p0[1]), __float_as_uint(p1[0]), __float_as_uint(p1[1])}; pw[1] = pw[0]; pw[2] = pw[0]; pw[3] = pw[0]; }
            ATT_SBAR();
            if ((PV & 1) == 0) { vload(vb, vp0 + so, 1);
            pv_block(o[0], va, pw);
            ATT_SBAR();
            vload(va, vp0 + so, 2);
            pv_block(o[1], vb, pw);
            ATT_SBAR();
            vload(vb, vp0 + so, 3);
            pv_block(o[2], va, pw);
            ATT_SBAR();
            pv_block(o[3], vb, pw); } else { o[0][0] += __uint_as_float(pw[0][0]); o[1][0] += __uint_as_float(pw[1][1]); }
            ATT_SBAR();
        }
        so = (so == 2 * STG_D) ? 0 : so + STG_D; so2 = (so2 == 2 * STG_D) ? 0 : so2 + STG_D;
    }
#undef DIFF_DMA
    l = swapsum(l);
    const float inv = __builtin_amdgcn_rcpf(l);
    ATT_BAR();
    LAS float* xch = (LAS float*)shm3 + (wq * 64) * 64 + lane;
    if (map == 1) {
#pragma unroll
        for (int d = 0; d < 4; ++d)
#pragma unroll
            for (int r = 0; r < 16; ++r) xch[(d * 16 + r) * 64] = o[d][r] * inv;
    }
    ATT_BAR();
    if (map == 0) {
        float ss = 0.f;
#pragma unroll
        for (int d = 0; d < 4; ++d)
#pragma unroll
            for (int r = 0; r < 16; ++r) { const float a = o[d][r] * inv - lam * xch[(d * 16 + r) * 64]; o[d][r] = a; ss += a * a; }
        ss = swapsum(ss);
        const float rn = __builtin_amdgcn_rsqf(ss * (1.0f / 128.0f) + NORM_EPS) * post;
        bf16_t* Ow = AO + (rowbase + qrow) * 1024 + h * 128 + 4 * hi;
#pragma unroll
        for (int d = 0; d < 4; ++d)
#pragma unroll
            for (int g = 0; g < 4; ++g) { const f32x4 sg = *(const f32x4*)(subg + d * 32 + 8 * g + 4 * hi);
                u32x2 w; w.x = cvt_pk_bf16(o[d][4 * g] * rn * sg[0], o[d][4 * g + 1] * rn * sg[1]); w.y = cvt_pk_bf16(o[d][4 * g + 2] * rn * sg[2], o[d][4 * g + 3] * rn * sg[3]);
                *(u32x2*)(Ow + d * 32 + 8 * g) = w; }
    }
    ATT_BAR();
}
}

struct Args {
    const float* x; const float* c; const int* pos; const float* ada_w; const float* ada_b; const float* norm_mix; const float* norm_ffn; const float* w_in;
    const float* b_forget; const float* lq1; const float* lk1; const float* lq2; const float* lk2; const float* subln; const float* w_out; const float* router_w;
    const float* router_b; const float* w1; const float* b1; const float* w2; const float* b2; const float* final_norm;
    float* out; unsigned char* ws; int ph_lo, ph_hi;
};

__device__ __forceinline__ void transpose_item(const float* W, int ldw, int K, bf16_t* WT, int k0, int n0, int drow, LAS float* scr, int lane) {
#pragma unroll 8
    for (int i = 0; i < 32; ++i) { const int kk = 2 * i + (lane >> 5); scr[kk * 33 + (lane & 31)] = W[(size_t)(k0 + kk) * ldw + n0 + (lane & 31)]; }
    asm volatile("s_waitcnt lgkmcnt(0)" ::: "memory");
    const int c = lane & 7;
#pragma unroll
    for (int j = 0; j < 4; ++j) { const int n = (lane >> 3) + 8 * j; const LAS float* s = scr + (8 * c) * 33 + n;
        u32x4 o; o.x = cvt_pk_bf16(s[0 * 33], s[1 * 33]); o.y = cvt_pk_bf16(s[2 * 33], s[3 * 33]); o.z = cvt_pk_bf16(s[4 * 33], s[5 * 33]); o.w = cvt_pk_bf16(s[6 * 33], s[7 * 33]);
        *(u32x4*)(WT + (size_t)(drow + n) * K + k0 + 8 * c) = o; }
    asm volatile("s_waitcnt lgkmcnt(0)" ::: "memory");
}

__device__ __forceinline__ void transpose_item_f8(const float* W, int ldw, int K, unsigned char* WT, int k0, int n0, int drow, LAS float* scr, int lane) {
#pragma unroll 8
    for (int i = 0; i < 32; ++i) { const int kk = 2 * i + (lane >> 5); scr[kk * 33 + (lane & 31)] = W[(size_t)(k0 + kk) * ldw + n0 + (lane & 31)]; }
    asm volatile("s_waitcnt lgkmcnt(0)" ::: "memory");
    const int c = lane & 7;
#pragma unroll
    for (int j = 0; j < 4; ++j) { const int n = (lane >> 3) + 8 * j; const LAS float* s = scr + (8 * c) * 33 + n;
        u32x2 o; o.x = pack4_fp8(s[0 * 33] * 32.f, s[1 * 33] * 32.f, s[2 * 33] * 32.f, s[3 * 33] * 32.f); o.y = pack4_fp8(s[4 * 33] * 32.f, s[5 * 33] * 32.f, s[6 * 33] * 32.f, s[7 * 33] * 32.f);
        *(u32x2*)(WT + (size_t)(drow + n) * K + k0 + 8 * c) = o; }
    asm volatile("s_waitcnt lgkmcnt(0)" ::: "memory");
}

__device__ __forceinline__ void norm1_row(const f32x4 (&v)[4], const f32x4 (&gm)[4], const f32x4 (&sh)[4], const LAS float* wft, const float* bfor, bf16_t* xnrow, float* LF, int b, int s, int lane) {
    float ss = 0.f;
#pragma unroll
    for (int j = 0; j < 4; ++j) ss += (v[j][0] * v[j][0] + v[j][1] * v[j][1]) + (v[j][2] * v[j][2] + v[j][3] * v[j][3]);
    const float rstd = __builtin_amdgcn_rsqf(wave_sum(ss) * (1.0f / DM) + NORM_EPS);
    f32x4 hv[4];
#pragma unroll
    for (int j = 0; j < 4; ++j) { hv[j] = v[j] * rstd * gm[j] + sh[j];
        u32x2 w; w.x = cvt_pk_bf16(hv[j][0], hv[j][1]); w.y = cvt_pk_bf16(hv[j][2], hv[j][3]); *(u32x2*)(xnrow + 4 * lane + 256 * j) = w; }
    float mine = 0.f;
#pragma unroll
    for (int hh = 0; hh < 8; ++hh) { float a = 0.f;
#pragma unroll
        for (int j = 0; j < 4; ++j) { const f32x4 w = *(const LAS f32x4*)(wft + hh * DM + 4 * lane + 256 * j); a += (hv[j][0] * w[0] + hv[j][1] * w[1]) + (hv[j][2] * w[2] + hv[j][3] * w[3]); }
        a = wave_sum(a); mine = (lane == hh) ? a : mine; }
    if (lane < 8) { const float z = mine + bfor[lane];
        const float lf = (z >= 0.f) ? -log1pf(__expf(-z)) : (z - log1pf(__expf(z)));
        LF[(size_t)(b * 8 + lane) * SEQ + s] = lf; }
}

__global__ void __launch_bounds__(NTHR, 2) fwd_kernel(Args args) {
    extern __shared__ __attribute__((aligned(16))) unsigned char lds[];
    LAS unsigned char* L = (LAS unsigned char*)lds;
    int tid = threadIdx.x, lane = tid & 63, wave = __builtin_amdgcn_readfirstlane(tid >> 6);
#define FRESH_IDS() do { tid = fresh_tid(); lane = tid & 63; wave = __builtin_amdgcn_readfirstlane(tid >> 6); gw = vcu * NWAVES + wave; } while (0)
    const int G = gridDim.x; const int bx = blockIdx.x; const int vcu = (G % 8 == 0) ? (bx % 8) * (G / 8) + bx / 8 : bx;
#define WSPTRS() unsigned char* ws = args.ws; asm volatile("" : "+s"(ws)); \
    unsigned* ctl = (unsigned*)(ws + WS_CTL); (void)ctl; \
    float* MOD = (float*)(ws + WS_MOD); float* RWT = (float*)(ws + WS_RWT); float* WFT = (float*)(ws + WS_WFT); float* ROPE = (float*)(ws + WS_ROPE); \
    float* NCK = (float*)(ws + WS_NCK); float* LF = (float*)(ws + WS_LF); float* GATES = (float*)(ws + WS_GATES); int* ROWL = (int*)(ws + WS_ROWL); \
    bf16_t* WIN = (bf16_t*)(ws + WS_WIN); bf16_t* WOUT = (bf16_t*)(ws + WS_WOUT); unsigned char* W1T = ws + WS_W1; unsigned char* W2T = ws + WS_W2; \
    bf16_t* XN = (bf16_t*)(ws + WS_XN); bf16_t* QKV = (bf16_t*)(ws + WS_QKV); bf16_t* AO = (bf16_t*)(ws + WS_AO); \
    float* X1 = (float*)(ws + WS_X1); float* X2 = (float*)(ws + WS_X2); unsigned char* XN2 = ws + WS_XN2; unsigned char* HID = ws + WS_HID; bf16_t* Y = (bf16_t*)(ws + WS_Y); \
    (void)MOD; (void)RWT; (void)WFT; (void)ROPE; (void)NCK; (void)LF; (void)GATES; (void)ROWL; (void)WIN; (void)WOUT; (void)W1T; (void)W2T; (void)XN; (void)QKV; (void)AO; (void)X1; (void)X2; (void)XN2; (void)HID; (void)Y
    for (int u = tid; u < 256; u += NTHR) ((LAS unsigned*)(L + MISC_OFF))[u] = 0u;
    __syncthreads();
#if MK_MULTI
#define GRID_BAR() do { } while (0)
#else
    XcdBarrier bar = xcd_barrier_post((unsigned*)(args.ws + WS_CTL) + CW_BAR, (volatile LAS unsigned*)(L + L_XBST));
#define GRID_BAR() xcd_barrier(bar)
#endif
    const int lo = args.ph_lo, hi_ = args.ph_hi;
#ifndef PH_MASK
#define PH_MASK 0x1ff
#endif
#define IN(k) (lo <= (k) && (k) < hi_)
#define ON(j) (((PH_MASK) >> (j)) & 1)
#ifndef REP_MASK
#define REP_MASK 0
#endif
#define NREP(j) (1 + (((REP_MASK) >> (j)) & 1))
#define BOTH(k) (IN(k) && IN((k) + 1))
    int gw = vcu * NWAVES + wave; const int NGW = G * NWAVES;

    if (ON(0) && IN(0)) {
        FRESH_IDS(); WSPTRS();
        for (int rep_ = 0; rep_ < NREP(0); ++rep_) {
        {
            LAS float* cact = (LAS float*)(L + 73728);
            LAS float* part = (LAS float*)(L + 73728 + 32768);
            for (int i = tid; i < 8 * DM; i += NTHR) { const float cv = args.c[i]; cact[i] = cv / (1.0f + __expf(-cv)); }
            __syncthreads();
            for (int it = vcu; it < 192; it += G) {
                const int l = it / 96, j0 = (it % 96) * 64;
                const float* aw = args.ada_w + (size_t)l * DM * 6144 + j0 + lane;
                float a8[8] = {0.f, 0.f, 0.f, 0.f, 0.f, 0.f, 0.f, 0.f};
#pragma unroll 4
                for (int k = wave * 128; k < wave * 128 + 128; ++k) { const float a = aw[(size_t)k * 6144];
#pragma unroll
                    for (int b = 0; b < 8; ++b) a8[b] += cact[b * DM + k] * a; }
#pragma unroll
                for (int b = 0; b < 8; ++b) part[(wave * 8 + b) * 64 + lane] = a8[b];
                __syncthreads();
                { const int b = tid >> 6; float s = 0.f;
#pragma unroll
                  for (int w = 0; w < 8; ++w) s += part[(w * 8 + b) * 64 + lane];
                  MOD[((size_t)l * 8 + b) * 6144 + j0 + lane] = s + args.ada_b[l * 6144 + j0 + lane]; }
                __syncthreads();
            }
        }
        {
            const int gt = vcu * NTHR + tid, NGT = G * NTHR;
            const double invf[8] = {1.0, 0.1939227432012558, 0.03760603070259094, 0.007292664609849453, 0.0014142135623842478, 0.00027424818836152554, 5.3182957344688475e-05, 1.0313385246263351e-05};
            for (int i = gt; i < NTOK * 8; i += NGT) { const int tok = i >> 3, j = i & 7;
                double iv = invf[0];
#pragma unroll
                for (int q = 1; q < 8; ++q) iv = (j == q) ? invf[q] : iv;
                double rev = (double)args.pos[tok] * iv * 0.15915494309189535; rev -= rint(rev); const float fr_ = (float)rev;
                ROPE[(size_t)tok * 16 + j] = __builtin_amdgcn_cosf(fr_); ROPE[(size_t)tok * 16 + 8 + j] = __builtin_amdgcn_sinf(fr_); }
            for (int i = gt; i < DEPTH * NEXP * DM; i += NGT) { const int l = i / (NEXP * DM), r = i % (NEXP * DM), e = r / DM, k = r % DM; RWT[i] = args.router_w[((size_t)l * DM + k) * NEXP + e]; }
            for (int i = gt; i < DEPTH * 8 * DM; i += NGT) { const int l = i / (8 * DM), r = i % (8 * DM), hh = r / DM, k = r % DM; WFT[i] = args.w_in[((size_t)l * DM + k) * INCOLS + 3072 + hh]; }
        }
        {
            LAS float* scr = (LAS float*)(L + wave * 8704);
            constexpr int I_IN = 16 * 96, I_OUT = 16 * 32, I_1 = 16 * 64, I_2 = 16 * 32;
            constexpr int T_IN = DEPTH * I_IN, T_OUT = DEPTH * I_OUT, T_1 = DEPTH * NEXP * I_1, T_2 = DEPTH * NEXP * I_2;
            for (int it = gw; it < T_IN + T_OUT + T_1 + T_2; it += NGW) {
                int r = it;
                if (r < T_IN) { const int l = r / I_IN, q = r % I_IN, kb = q / 96, nb = q % 96;
                    transpose_item(args.w_in + (size_t)l * DM * INCOLS, INCOLS, DM, WIN + (size_t)l * 3072 * DM, kb * 64, nb * 32, nb * 32, scr, lane); continue; }
                r -= T_IN;
                if (r < T_OUT) { const int l = r / I_OUT, q = r % I_OUT, kb = q / 32, nb = q % 32;
                    transpose_item(args.w_out + (size_t)l * DM * DM, DM, DM, WOUT + (size_t)l * DM * DM, kb * 64, nb * 32, nb * 32, scr, lane); continue; }
                r -= T_OUT;
                if (r < T_1) { const int le = r / I_1, q = r % I_1, kb = q / 64, nb = q % 64; const int n0 = nb * 32;
                    const int drow = (n0 < 1024) ? ((n0 >> 7) * 256 + (n0 & 127)) : ((((n0 - 1024) >> 7) * 256) + 128 + ((n0 - 1024) & 127));
                    transpose_item_f8(args.w1 + (size_t)le * DM * 2048, 2048, DM, W1T + (size_t)le * 2048 * DM, kb * 64, n0, drow, scr, lane); continue; }
                r -= T_1;
                { const int le = r / I_2, q = r % I_2, kb = q / 32, nb = q % 32;
                    transpose_item_f8(args.w2 + (size_t)le * DM * DM, DM, DM, W2T + (size_t)le * DM * DM, kb * 64, nb * 32, nb * 32, scr, lane); }
            }
        }
        } if (BOTH(0)) GRID_BAR();
    }

    if (ON(1) && IN(1)) {
        FRESH_IDS(); WSPTRS();
        for (int rep_ = 0; rep_ < NREP(1); ++rep_) {
        LAS float* wft = (LAS float*)L;
        for (int i = tid; i < 8 * DM; i += NTHR) wft[i] = WFT[i];
        __syncthreads();
        for (int ch = gw; ch < NTOK / 16; ch += NGW) {
            const int b = ch >> 8; const float* mod = MOD + (size_t)b * 6144;
            f32x4 gm[4], sh[4];
#pragma unroll
            for (int j = 0; j < 4; ++j) { const int c0 = 4 * lane + 256 * j; const f32x4 g = *(const f32x4*)(args.norm_mix + c0), sc = *(const f32x4*)(mod + 1024 + c0); gm[j] = g * (sc + 1.0f); sh[j] = *(const f32x4*)(mod + c0); }
            for (int rr = 0; rr < 16; ++rr) { const int mrow = ch * 16 + rr;
                f32x4 v[4];
#pragma unroll
                for (int j = 0; j < 4; ++j) v[j] = *(const f32x4*)(args.x + (size_t)mrow * DM + 4 * lane + 256 * j);
                norm1_row(v, gm, sh, wft, args.b_forget, XN + (size_t)mrow * DM, LF, b, mrow & (SEQ - 1), lane); }
        }
        __syncthreads();
        } if (BOTH(1)) GRID_BAR();
    }

    for (int l = 0; l < DEPTH; ++l) {
        const int pb = 2 + 7 * l;
#define modl (MOD + (size_t)l * 8 * 6144)
#define xin ((l == 0) ? args.x : (const float*)X2)
        if (ON(2) && IN(pb + 0)) {
            FRESH_IDS(); WSPTRS();
        for (int rep_ = 0; rep_ < NREP(2); ++rep_) {
            if (vcu < 64) {
                const float* src = LF + (size_t)vcu * SEQ + 8 * tid; float* dst = NCK + (size_t)vcu * SEQ + 8 * tid;
                f32x4 a = *(const f32x4*)src, c2 = *(const f32x4*)(src + 4);
                float e[8] = {a[0], a[1], a[2], a[3], c2[0], c2[1], c2[2], c2[3]};
#pragma unroll
                for (int i = 1; i < 8; ++i) e[i] += e[i - 1];
                float tot = e[7], inc = tot;
#pragma unroll
                for (int o = 1; o < 64; o <<= 1) { const float n = __shfl_up(inc, o); if (lane >= o) inc += n; }
                LAS float* sc = (LAS float*)(L + L_SCAN);
                if (lane == 63) sc[wave] = inc;
                __syncthreads();
                float pre = inc - tot;
                for (int w = 0; w < wave; ++w) pre += sc[w];
                f32x4 o0, o1;
                o0[0] = -(e[0] + pre) * LOG2E; o0[1] = -(e[1] + pre) * LOG2E; o0[2] = -(e[2] + pre) * LOG2E; o0[3] = -(e[3] + pre) * LOG2E;
                o1[0] = -(e[4] + pre) * LOG2E; o1[1] = -(e[5] + pre) * LOG2E; o1[2] = -(e[6] + pre) * LOG2E; o1[3] = -(e[7] + pre) * LOG2E;
                *(f32x4*)dst = o0; *(f32x4*)(dst + 4) = o1;
            }
            __syncthreads();
            pg8::SchedDense S{(const char*)XN, (const char*)(WIN + (size_t)l * 3072 * DM), 12, (NTOK / 256) * 12, G, vcu, DM};
            pg8::EpiInProj E{QKV, ROPE};
            pg8::gemm_phase<pg8::EpiInProj, pg8::SchedDense, true>(L, DM, S, E);
            } if (BOTH(pb + 0)) GRID_BAR();
        }
        if (ON(3) && IN(pb + 1)) {
            FRESH_IDS(); WSPTRS();
        for (int rep_ = 0; rep_ < NREP(3); ++rep_) {
            const bf16_t* DQ = QKV; const bf16_t* DK = QKV + (size_t)NTOK * 512; const bf16_t* DV = QKV + (size_t)2 * NTOK * 512;
            const bf16_t* FQ = QKV + (size_t)3 * NTOK * 512; const bf16_t* FK = QKV + (size_t)4 * NTOK * 512; const bf16_t* FV = QKV + (size_t)5 * NTOK * 512;
            const float lam_init = 0.8f - 0.6f * expf(-0.3f * (float)l);
            const float s1 = wave_sum(args.lq1[l * 64 + lane] * args.lk1[l * 64 + lane]), s2 = wave_sum(args.lq2[l * 64 + lane] * args.lk2[l * 64 + lane]);
            const float lam = expf(s1) - expf(s2) + lam_init;
#ifndef ATT_PV
#define ATT_PV 0
#endif
            if (NREP(3) == 2 && rep_ == 0) {
                if ((ATT_PV & 16) == 0) for (int p = vcu; p < 512; p += G) { const int bh = p >> 3, s = p & 7;
                    att::fox_unit<ATT_PV & 15>(bh >> 3, bh & 7, 15 - s, FQ, FK, FV, NCK, AO, (char*)lds);
                    att::fox_unit<ATT_PV & 15>(bh >> 3, bh & 7, s, FQ, FK, FV, NCK, AO, (char*)lds); }
                if ((ATT_PV & 32) == 0) for (int p = vcu; p < 512; p += G) { const int bh = p >> 4, s = p & 15;
                    att::diff_unit<ATT_PV & 15>(bh >> 2, bh & 3, 31 - s, DQ, DK, DV, args.subln + l * 128, lam, 1.0f - lam_init, AO, (char*)lds);
                    att::diff_unit<ATT_PV & 15>(bh >> 2, bh & 3, s, DQ, DK, DV, args.subln + l * 128, lam, 1.0f - lam_init, AO, (char*)lds); }
            } else {
            for (int p = vcu; p < 512; p += G) { const int bh = p >> 3, s = p & 7;
                att::fox_unit<0>(bh >> 3, bh & 7, 15 - s, FQ, FK, FV, NCK, AO, (char*)lds);
                att::fox_unit<0>(bh >> 3, bh & 7, s, FQ, FK, FV, NCK, AO, (char*)lds); }
            for (int p = vcu; p < 512; p += G) { const int bh = p >> 4, s = p & 15;
                att::diff_unit<0>(bh >> 2, bh & 3, 31 - s, DQ, DK, DV, args.subln + l * 128, lam, 1.0f - lam_init, AO, (char*)lds);
                att::diff_unit<0>(bh >> 2, bh & 3, s, DQ, DK, DV, args.subln + l * 128, lam, 1.0f - lam_init, AO, (char*)lds); }
            }
            } if (BOTH(pb + 1)) GRID_BAR();
        }
        if (ON(4) && IN(pb + 2)) {
            FRESH_IDS(); WSPTRS();
        for (int rep_ = 0; rep_ < NREP(4); ++rep_) {
            pg8::SchedDense S{(const char*)AO, (const char*)(WOUT + (size_t)l * DM * DM), 4, (NTOK / 256) * 4, G, vcu, DM};
            pg8::EpiOutProj E{xin, X1, modl + 2 * 1024};
            pg8::gemm_phase<pg8::EpiOutProj, pg8::SchedDense, true>(L, DM, S, E);
            } if (BOTH(pb + 2)) GRID_BAR();
        }
        if (ON(5) && IN(pb + 3)) {
            FRESH_IDS(); WSPTRS();
            LAS float* wt = (LAS float*)L;
            LAS float* lgt = (LAS float*)(L + IDX_OFF) + wave * (16 * 33);
            LAS int* hist = (LAS int*)(L + L_HIST); LAS int* basel = (LAS int*)(L + L_BASE);
            for (int i = tid; i < NEXP * DM; i += NTHR) wt[i] = RWT[(size_t)l * NEXP * DM + i];
            if (tid < 32) hist[tid] = 0;
            __syncthreads();
            unsigned* cntg = ctl + CW_CNT + l * 32 * 64;
            const int nch = NTOK / 16, niter = (nch + NGW - 1) / NGW;
            for (int itr = 0; itr < niter; ++itr) {
                const int ch = itr * NGW + gw; const bool act = ch < nch;
                int te[4] = {0, 0, 0, 0}, lr[4] = {0, 0, 0, 0}; float tg[4] = {0.f, 0.f, 0.f, 0.f};
                for (int rep_ = 0; rep_ < NREP(5); ++rep_)
                if (act) {
                    const int b = ch >> 8; const float* mod = modl + (size_t)b * 6144;
                    f32x4 gm[4], sh[4];
#pragma unroll
                    for (int j = 0; j < 4; ++j) { const int c0 = 4 * lane + 256 * j; const f32x4 g = *(const f32x4*)(args.norm_ffn + l * DM + c0), sc = *(const f32x4*)(mod + 4 * 1024 + c0); gm[j] = g * (sc + 1.0f); sh[j] = *(const f32x4*)(mod + 3 * 1024 + c0); }
                    for (int rr = 0; rr < 16; ++rr) { const int mrow = ch * 16 + rr;
                        f32x4 v[4]; float ss = 0.f;
#pragma unroll
                        for (int j = 0; j < 4; ++j) { v[j] = *(const f32x4*)(X1 + (size_t)mrow * DM + 4 * lane + 256 * j); ss += (v[j][0] * v[j][0] + v[j][1] * v[j][1]) + (v[j][2] * v[j][2] + v[j][3] * v[j][3]); }
                        const float rstd = __builtin_amdgcn_rsqf(wave_sum(ss) * (1.0f / DM) + NORM_EPS);
#pragma unroll
                        for (int j = 0; j < 4; ++j) { v[j] = v[j] * rstd * gm[j] + sh[j];
                            *(unsigned*)(XN2 + (size_t)mrow * DM + 4 * lane + 256 * j) = pack4_fp8(v[j][0], v[j][1], v[j][2], v[j][3]); }
                        float ac[32];
#pragma unroll
                        for (int e = 0; e < 32; ++e) { float a = 0.f;
#pragma unroll
                            for (int j = 0; j < 4; ++j) { const f32x4 w = *(const LAS f32x4*)(wt + e * DM + 4 * lane + 256 * j); a += (v[j][0] * w[0] + v[j][1] * w[1]) + (v[j][2] * w[2] + v[j][3] * w[3]); }
                            ac[e] = a; }
                        float a16[16], a8[8], a4[4], a2[2], a1;
                        { const bool up = (lane & 32) != 0;
#pragma unroll
                          for (int i = 0; i < 16; ++i) { const float snd = up ? ac[i] : ac[i + 16], kp = up ? ac[i + 16] : ac[i]; a16[i] = kp + __shfl_xor(snd, 32); } }
                        { const bool up = (lane & 16) != 0;
#pragma unroll
                          for (int i = 0; i < 8; ++i) { const float snd = up ? a16[i] : a16[i + 8], kp = up ? a16[i + 8] : a16[i]; a8[i] = kp + __shfl_xor(snd, 16); } }
                        { const bool up = (lane & 8) != 0;
#pragma unroll
                          for (int i = 0; i < 4; ++i) { const float snd = up ? a8[i] : a8[i + 4], kp = up ? a8[i + 4] : a8[i]; a4[i] = kp + __shfl_xor(snd, 8); } }
                        { const bool up = (lane & 4) != 0;
#pragma unroll
                          for (int i = 0; i < 2; ++i) { const float snd = up ? a4[i] : a4[i + 2], kp = up ? a4[i + 2] : a4[i]; a2[i] = kp + __shfl_xor(snd, 4); } }
                        { const bool up = (lane & 2) != 0; const float snd = up ? a2[0] : a2[1], kp = up ? a2[1] : a2[0]; a1 = kp + __shfl_xor(snd, 2); }
                        a1 += __shfl_xor(a1, 1);
                        if ((lane & 1) == 0) lgt[rr * 33 + (lane >> 1)] = a1 + args.router_b[l * NEXP + (lane >> 1)];
                    }
                    asm volatile("s_waitcnt lgkmcnt(0)" ::: "memory");
                    if (lane < 16) {
                        float v0 = -INFINITY, v1 = -INFINITY, v2 = -INFINITY, v3 = -INFINITY; int i0 = 0, i1 = 0, i2 = 0, i3 = 0;
#pragma unroll
                        for (int e = 0; e < 32; ++e) { const float x = lgt[lane * 33 + e];
                            if (x > v3) { v3 = x; i3 = e;
                                if (v3 > v2) { float tf = v2; v2 = v3; v3 = tf; int ti = i2; i2 = i3; i3 = ti;
                                    if (v2 > v1) { tf = v1; v1 = v2; v2 = tf; ti = i1; i1 = i2; i2 = ti;
                                        if (v1 > v0) { tf = v0; v0 = v1; v1 = tf; ti = i0; i0 = i1; i1 = ti; } } } } }
                        const float e1 = __expf(v1 - v0), e2 = __expf(v2 - v0), e3 = __expf(v3 - v0); const float rs = 1.0f / (1.0f + e1 + e2 + e3);
                        te[0] = i0; te[1] = i1; te[2] = i2; te[3] = i3; tg[0] = rs; tg[1] = e1 * rs; tg[2] = e2 * rs; tg[3] = e3 * rs;
#pragma unroll
                        for (int k = 0; k < 4; ++k) if (rep_ == NREP(5) - 1) lr[k] = atomicAdd((int*)(lds + L_HIST) + te[k], 1);
                    }
                }
                __syncthreads();
                if (tid < 32) { const int c = hist[tid]; int base = 0; if (c > 0) base = (int)__hip_atomic_fetch_add(cntg + tid * 64, (unsigned)c, __ATOMIC_RELAXED, __HIP_MEMORY_SCOPE_AGENT); basel[tid] = base; hist[tid] = 0; }
                __syncthreads();
                if (act && lane < 16) { const int mrow = ch * 16 + lane;
#pragma unroll
                    for (int k = 0; k < 4; ++k) { ROWL[(size_t)te[k] * ROWCAP + basel[te[k]] + lr[k]] = mrow * 4 + k; GATES[mrow * 4 + k] = tg[k]; } }
                __syncthreads();
            }
            if (BOTH(pb + 3)) GRID_BAR();
        }
        if ((ON(6) && IN(pb + 4)) || (ON(7) && IN(pb + 5))) {
            FRESH_IDS(); WSPTRS();
            LAS int* lcnt = (LAS int*)(L + L_CNT); LAS int* lblk = (LAS int*)(L + L_BLK); LAS int* idx = (LAS int*)(L + IDX_OFF);
            unsigned* cntg = ctl + CW_CNT + l * 32 * 64;
            __syncthreads();
            if (tid < 32) lcnt[tid] = (int)__hip_atomic_load(cntg + tid * 64, __ATOMIC_RELAXED, __HIP_MEMORY_SCOPE_AGENT);
            __syncthreads();
            if (tid == 0) { int s = 0; for (int e = 0; e < 32; ++e) { lblk[e] = s; s += (lcnt[e] + 255) >> 8; } lblk[32] = s; }
            __syncthreads();
            const int nrb = lblk[32];
            if (ON(6) && IN(pb + 4)) {
        for (int rep_ = 0; rep_ < NREP(6); ++rep_) {
                const int nU = nrb * 8;
                for (int i = 0; i * G + vcu < nU; ++i) { const int rb = (i * G + vcu) >> 3; const int e = pg8::find_expert(lblk, rb);
                    if (tid < 256) { const int r = (rb - lblk[e]) * 256 + tid; idx[i * 256 + tid] = (r < lcnt[e]) ? (ROWL[(size_t)e * ROWCAP + r] >> 2) : 0; } }
                __syncthreads();
                pg8::SchedMoe1 S{(const char*)XN2, (const char*)(W1T + (size_t)l * NEXP * 2048 * DM), lblk, idx, nU, G, vcu};
                pg8::EpiMoe1 E{HID, args.b1 + (size_t)l * NEXP * 2048, (LAS float*)(L + BIAS_OFF)};
                pg8::gemm_phase<pg8::EpiMoe1, pg8::SchedMoe1, true, true>(L, DM, S, E);
                } if (BOTH(pb + 4)) GRID_BAR();
            }
            if (ON(7) && IN(pb + 5)) {
        for (int rep_ = 0; rep_ < NREP(7); ++rep_) {
                const int nU = nrb * 4;
                __syncthreads();
                for (int i = 0; i * G + vcu < nU; ++i) { const int rb = (i * G + vcu) >> 2; const int e = pg8::find_expert(lblk, rb);
                    if (tid < 256) { const int r = (rb - lblk[e]) * 256 + tid; idx[i * 256 + tid] = (r < lcnt[e]) ? ROWL[(size_t)e * ROWCAP + r] : NTOK * TOPK; } }
                __syncthreads();
                pg8::SchedMoe2 S{(const char*)HID, (const char*)(W2T + (size_t)l * NEXP * DM * DM), lblk, nU, G, vcu};
                pg8::EpiMoe2 E{Y, args.b2 + (size_t)l * NEXP * DM, idx, (LAS float*)(L + BIAS_OFF)};
                pg8::gemm_phase<pg8::EpiMoe2, pg8::SchedMoe2, true, true>(L, DM, S, E);
                } if (BOTH(pb + 5)) GRID_BAR();
            }
        }
        if (ON(8) && IN(pb + 6)) {
            FRESH_IDS(); WSPTRS();
        for (int rep_ = 0; rep_ < NREP(8); ++rep_) {
            LAS float* wft = (LAS float*)L;
            if (l + 1 < DEPTH) { for (int i = tid; i < 8 * DM; i += NTHR) wft[i] = WFT[(size_t)(l + 1) * 8 * DM + i]; }
            __syncthreads();
            for (int ch = gw; ch < NTOK / 16; ch += NGW) {
                const int b = ch >> 8; const float* mod = modl + (size_t)b * 6144;
                f32x4 g2[4], gm[4], sh[4];
#pragma unroll
                for (int j = 0; j < 4; ++j) { const int c0 = 4 * lane + 256 * j; g2[j] = *(const f32x4*)(mod + 5 * 1024 + c0);
                    if (l + 1 < DEPTH) { const float* mod2 = MOD + ((size_t)(l + 1) * 8 + b) * 6144; const f32x4 g = *(const f32x4*)(args.norm_mix + (l + 1) * DM + c0), sc = *(const f32x4*)(mod2 + 1024 + c0); gm[j] = g * (sc + 1.0f); sh[j] = *(const f32x4*)(mod2 + c0); }
                    else { gm[j] = *(const f32x4*)(args.final_norm + c0); sh[j] = (f32x4){0.f, 0.f, 0.f, 0.f}; } }
                for (int rr = 0; rr < 16; ++rr) { const int mrow = ch * 16 + rr;
                    const f32x4 gt = *(const f32x4*)(GATES + (size_t)mrow * 4);
                    f32x4 v[4];
#pragma unroll
                    for (int j = 0; j < 4; ++j) { const int c0 = 4 * lane + 256 * j;
                        f32x4 a = {0.f, 0.f, 0.f, 0.f};
#pragma unroll
                        for (int k = 0; k < 4; ++k) { const u32x2 yw = *(const u32x2*)(Y + ((size_t)mrow * 4 + k) * DM + c0); const float gk = gt[k];
                            a[0] += gk * bf_lo(yw.x); a[1] += gk * bf_hi(yw.x); a[2] += gk * bf_lo(yw.y); a[3] += gk * bf_hi(yw.y); }
                        v[j] = *(const f32x4*)(X1 + (size_t)mrow * DM + c0) + g2[j] * a; }
                    if (l + 1 < DEPTH) {
#pragma unroll
                        for (int j = 0; j < 4; ++j) *(f32x4*)(X2 + (size_t)mrow * DM + 4 * lane + 256 * j) = v[j];
                        norm1_row(v, gm, sh, wft, args.b_forget + (l + 1) * 8, XN + (size_t)mrow * DM, LF, b, mrow & (SEQ - 1), lane);
                    } else {
                        float ss = 0.f;
#pragma unroll
                        for (int j = 0; j < 4; ++j) ss += (v[j][0] * v[j][0] + v[j][1] * v[j][1]) + (v[j][2] * v[j][2] + v[j][3] * v[j][3]);
                        const float rstd = __builtin_amdgcn_rsqf(wave_sum(ss) * (1.0f / DM) + NORM_EPS);
#pragma unroll
                        for (int j = 0; j < 4; ++j) *(f32x4*)(args.out + (size_t)mrow * DM + 4 * lane + 256 * j) = v[j] * rstd * gm[j];
                    }
                }
            }
            __syncthreads();
            } if (BOTH(pb + 6)) GRID_BAR();
        }
    }
#undef IN
#undef BOTH
}

extern "C" void kernel_launch(void* const* d_in, const int* in_sizes, int n_in, void* d_out, int out_size, void* d_ws, size_t ws_size, hipStream_t stream) {
    static int grid = 0;
    if (grid == 0) {
        if (n_in != 22 || in_sizes[0] != NTOK * DM || out_size != NTOK * DM || ws_size < WS_END) {
            fprintf(stderr, "kernel_launch: unexpected shapes: n_in %d in0 %d out %d ws %zu (need %zu)\n", n_in, n_in > 0 ? in_sizes[0] : -1, out_size, ws_size, (size_t)WS_END); grid = -1; return; }
        int dev = 0, cus = 0, per_cu = 0;
        if (hipGetDevice(&dev) != hipSuccess || hipDeviceGetAttribute(&cus, hipDeviceAttributeMultiprocessorCount, dev) != hipSuccess) { grid = -1; return; }
        if (hipFuncSetAttribute((const void*)fwd_kernel, hipFuncAttributeMaxDynamicSharedMemorySize, LDS_BYTES) != hipSuccess) { fprintf(stderr, "kernel_launch: hipFuncSetAttribute failed\n"); grid = -1; return; }
        if (hipOccupancyMaxActiveBlocksPerMultiprocessor(&per_cu, (const void*)fwd_kernel, NTHR, LDS_BYTES) != hipSuccess || per_cu < 1)
            fprintf(stderr, "kernel_launch: occupancy query reports %d blocks per CU\n", per_cu);
        (void)hipGetLastError();
        grid = cus;
    }
    if (grid < 0) return;
    (void)hipMemsetAsync((char*)d_ws + WS_CTL, 0, CTL_ZERO_BYTES, stream);
    Args a{};
    a.x = (const float*)d_in[0]; a.c = (const float*)d_in[1]; a.pos = (const int*)d_in[2]; a.ada_w = (const float*)d_in[3]; a.ada_b = (const float*)d_in[4];
    a.norm_mix = (const float*)d_in[5]; a.norm_ffn = (const float*)d_in[6]; a.w_in = (const float*)d_in[7]; a.b_forget = (const float*)d_in[8];
    a.lq1 = (const float*)d_in[9]; a.lk1 = (const float*)d_in[10]; a.lq2 = (const float*)d_in[11]; a.lk2 = (const float*)d_in[12]; a.subln = (const float*)d_in[13];
    a.w_out = (const float*)d_in[14]; a.router_w = (const float*)d_in[15]; a.router_b = (const float*)d_in[16]; a.w1 = (const float*)d_in[17]; a.b1 = (const float*)d_in[18];
    a.w2 = (const float*)d_in[19]; a.b2 = (const float*)d_in[20]; a.final_norm = (const float*)d_in[21];
    a.out = (float*)d_out; a.ws = (unsigned char*)d_ws;
    constexpr int NPH = 2 + 7 * DEPTH;
#if MK_MULTI
    for (int p = 0; p < NPH; ++p) { a.ph_lo = p; a.ph_hi = p + 1; hipLaunchKernelGGL(fwd_kernel, dim3(grid), dim3(NTHR), LDS_BYTES, stream, a); }
#else
    a.ph_lo = 0; a.ph_hi = NPH;
    hipLaunchKernelGGL(fwd_kernel, dim3(grid), dim3(NTHR), LDS_BYTES, stream, a);
#endif
    const hipError_t le = hipPeekAtLastError();
    if (le != hipSuccess) fprintf(stderr, "kernel_launch: launch failed: %s\n", hipGetErrorName(le));
}
```

```cpp
#include <hip/hip_runtime.h>
#include <hip/hip_bf16.h>
#include <cstdio>
#include <cstdint>
#include <cmath>

#ifndef MK_MULTI
#define MK_MULTI 0
#endif

constexpr int BATCH = 8, SEQ = 4096, DM = 1024, NTOK = BATCH * SEQ, DEPTH = 2, NEXP = 32, TOPK = 4;
constexpr int INCOLS = 3080, DFF = 1024;
constexpr int NWAVES = 8, NTHR = 512;
constexpr float NORM_EPS = 1e-6f;
constexpr float LOG2E = 1.4426950408889634f;
constexpr float QSCALE = 0.125f * LOG2E;
constexpr int ROWCAP = NTOK;
constexpr int MAXRB = (NTOK * TOPK) / 256 + NEXP;

constexpr size_t MiB = 1u << 20;
constexpr size_t WS_CTL = 0, CTL_ZERO_BYTES = 2 * MiB;
constexpr size_t WS_MOD = 2 * MiB;
constexpr size_t WS_RWT = 3 * MiB;
constexpr size_t WS_WFT = 3 * MiB + 512 * 1024;
constexpr size_t WS_ROPE = 4 * MiB;
constexpr size_t WS_NCK = 6 * MiB;
constexpr size_t WS_LF = 7 * MiB;
constexpr size_t WS_GATES = 8 * MiB;
constexpr size_t WS_ROWL = 9 * MiB;
constexpr size_t WS_WQ = 13 * MiB;
constexpr size_t WS_BQ = 15 * MiB;
constexpr size_t WS_WIN = 16 * MiB;
constexpr size_t WS_WOUT = 28 * MiB;
constexpr size_t WS_W1 = 32 * MiB;
constexpr size_t WS_W2 = 288 * MiB;
constexpr size_t WS_XN = 416 * MiB;
constexpr size_t WS_QKV = 480 * MiB;
constexpr size_t WS_AO = 672 * MiB;
constexpr size_t WS_X1 = 736 * MiB;
constexpr size_t WS_X2 = 864 * MiB;
constexpr size_t WS_XN2 = 992 * MiB;
constexpr size_t WS_HID = 1056 * MiB;
constexpr size_t WS_Y = 1328 * MiB;
constexpr size_t WS_END = 1585 * MiB;
constexpr int CW_BAR = 4096;
constexpr int CW_CNT = 16384;

constexpr int RING_BYTES = 131072;
constexpr int MISC_OFF = RING_BYTES;
constexpr int L_XBST = MISC_OFF;
constexpr int L_CNT = MISC_OFF + 64;
constexpr int L_BLK = MISC_OFF + 192;
constexpr int L_HIST = MISC_OFF + 384;
constexpr int L_BASE = MISC_OFF + 512;
constexpr int L_SCAN = MISC_OFF + 640;
constexpr int IDX_OFF = MISC_OFF + 1024;
constexpr int IDX_BYTES = 18432;
constexpr int BIAS_OFF = IDX_OFF + IDX_BYTES;
constexpr int LDS_BYTES = BIAS_OFF + 8192;

#define GAS __attribute__((address_space(1)))
#define LAS __attribute__((address_space(3)))
typedef unsigned short bf16_t;
typedef short bf16x8 __attribute__((ext_vector_type(8)));
typedef short s16x4 __attribute__((ext_vector_type(4)));
typedef float f32x4 __attribute__((ext_vector_type(4)));
typedef float f32x2 __attribute__((ext_vector_type(2)));
typedef float f32x16 __attribute__((ext_vector_type(16)));
typedef unsigned u32x4 __attribute__((ext_vector_type(4)));
typedef unsigned u32x2 __attribute__((ext_vector_type(2)));

__device__ __forceinline__ unsigned cvt_pk_bf16(float lo, float hi) { unsigned r; asm volatile("v_cvt_pk_bf16_f32 %0, %1, %2" : "=v"(r) : "v"(lo), "v"(hi)); return r; }
__device__ __forceinline__ int fresh_tid() { int t = threadIdx.x; asm volatile("" : "+v"(t)); return t; }
__device__ __forceinline__ unsigned pack4_fp8(float a, float b, float c, float d) {
    int w = __builtin_amdgcn_cvt_pk_fp8_f32(a, b, 0, false); w = __builtin_amdgcn_cvt_pk_fp8_f32(c, d, w, true); return (unsigned)w; }
__device__ __forceinline__ float bf_lo(unsigned w) { return __uint_as_float(w << 16); }
__device__ __forceinline__ float bf_hi(unsigned w) { return __uint_as_float(w & 0xffff0000u); }
__device__ __forceinline__ float wave_sum(float v) {
#pragma unroll
    for (int o = 1; o < 64; o <<= 1) v += __shfl_xor(v, o);
    return v;
}

#define XB_TMO      128
#define XB_XCNT(j)  (256  + 64 * (j))
#define XB_XSUB(j)  (1280 + 64 * (j))
#define XB_XGEN(j)  (2304 + 64 * (j))
#define XB_TOP      3328
#define XB_TOPGEN   3392
#define XCD_BAR_WORDS 3456
#define XB_SPIN_CAP (1u << 18)
__device__ __forceinline__ unsigned xb_ld(unsigned* p)              { return __hip_atomic_load(p, __ATOMIC_RELAXED, __HIP_MEMORY_SCOPE_AGENT); }
__device__ __forceinline__ unsigned xb_add(unsigned* p, unsigned v) { return __hip_atomic_fetch_add(p, v, __ATOMIC_RELAXED, __HIP_MEMORY_SCOPE_AGENT); }
__device__ __forceinline__ unsigned xb_xcc_id() { return (unsigned)__builtin_amdgcn_s_getreg((3 << 11) | 20) & 0xFu; }
#define XB_SPIN(cond, bar) do { unsigned _sp = 0; while (cond) { __builtin_amdgcn_s_sleep(1); \
    if ((++_sp & 255u) == 0u) { if (xb_ld(&(bar)[XB_TMO])) break; if (_sp > XB_SPIN_CAP) { atomicAdd(&(bar)[XB_TMO], 1u); break; } } } } while (0)
struct XcdBarrier { unsigned* bar; unsigned x; volatile LAS unsigned* st; };
__device__ __forceinline__ XcdBarrier xcd_barrier_post(unsigned* bar, volatile LAS unsigned* st) {
    XcdBarrier b; b.bar = bar; b.x = xb_xcc_id(); b.st = st;
    if (threadIdx.x == 0) (void)xb_add(&bar[XB_XCNT(b.x)], 1u);
    return b;
}
__device__ __forceinline__ void xcd_barrier_complete(unsigned* bar, unsigned x, unsigned& nloc, unsigned& nx) {
    const unsigned G = gridDim.x * gridDim.y * gridDim.z;
    unsigned sum, cnt, mine, sp = 0u;
    for (;;) {
        sum = 0u; cnt = 0u; mine = 0u;
#pragma unroll
        for (unsigned j = 0; j < 16; ++j) { const unsigned c = xb_ld(&bar[XB_XCNT(j)]); sum += c; cnt += (c > 0u) ? 1u : 0u; mine = (j == x) ? c : mine; }
        if (sum == G) break;
        __builtin_amdgcn_s_sleep(1);
        if ((++sp & 255u) == 0u) { if (xb_ld(&bar[XB_TMO])) break; if (sp > XB_SPIN_CAP) { atomicAdd(&bar[XB_TMO], 1u); break; } }
    }
    nloc = mine > 0u ? mine : 1u; nx = cnt > 0u ? cnt : 1u;
}
__device__ __forceinline__ void xcd_barrier(const XcdBarrier& b) {
    asm volatile("s_waitcnt vmcnt(0)" ::: "memory");
    __syncthreads();
    if (threadIdx.x == 0) {
        unsigned* bar = b.bar;
        __builtin_amdgcn_s_waitcnt(0);
        unsigned nloc = b.st[0], nx = b.st[1];
        if (nloc == 0u) { xcd_barrier_complete(bar, b.x, nloc, nx); b.st[0] = nloc; b.st[1] = nx; }
        const unsigned old = xb_add(&bar[XB_XSUB(b.x)], 1u);
        const unsigned gen = old / nloc;
        if (old + 1u == (gen + 1u) * nloc) {
            __builtin_amdgcn_fence(__ATOMIC_RELEASE, "agent");
            asm volatile("s_waitcnt vmcnt(0)" ::: "memory");
            const unsigned og = xb_add(&bar[XB_TOP], 1u);
            const unsigned tg = og / nx;
            if (og + 1u == (tg + 1u) * nx) xb_add(&bar[XB_TOPGEN], 1u);
            else XB_SPIN(xb_ld(&bar[XB_TOPGEN]) == tg, bar);
            __builtin_amdgcn_fence(__ATOMIC_ACQUIRE, "agent");
            xb_add(&bar[XB_XGEN(b.x)], 1u);
            asm volatile("s_waitcnt vmcnt(0)" ::: "memory");
        } else {
            XB_SPIN(xb_ld(&bar[XB_XGEN(b.x)]) == gen, bar);
            __builtin_amdgcn_fence(__ATOMIC_ACQUIRE, "agent");
            asm volatile("s_waitcnt vmcnt(0)" ::: "memory");
        }
    }
    __syncthreads();
}

namespace pg8 {
constexpr int BM = 256, BK = 64, HALF = 128, HTB = HALF * BK * 2, STAGE_BYTES = 8 * HTB;
__host__ __device__ __forceinline__ int lds_byte(int r, int c) { const int st = (r >> 4) * 2 + (c >> 5), rr = r & 15, cc = c & 31, ob = rr * 64 + cc * 2; return st * 1024 + (ob ^ (((ob >> 9) & 1) << 5)); }
__host__ __device__ __forceinline__ void stage_rc(int b, int& R, int& C) { const int st = b / 1024, sb = b % 1024, swz = sb ^ (((sb >> 9) & 1) << 5); R = (st >> 1) * 16 + swz / 64; C = (st & 1) * 32 + (swz % 64) / 2; }
__host__ __device__ __forceinline__ int perm32(int rho) { const int n = rho >> 4, i = rho & 15; return 8 * (i >> 2) + 4 * n + (i & 3); }

typedef int i32x8 __attribute__((ext_vector_type(8)));
typedef int i32x4 __attribute__((ext_vector_type(4)));
__device__ __forceinline__ i32x8 cat8(bf16x8 lo, bf16x8 hi) { const i32x4 a = __builtin_bit_cast(i32x4, lo), b = __builtin_bit_cast(i32x4, hi); return (i32x8){a[0], a[1], a[2], a[3], b[0], b[1], b[2], b[3]}; }
struct Unit { int pm, pn, e; };

template <class Epi, class Sched, bool ALIGN_EPI, bool F8 = false>
__device__ __forceinline__ void gemm_phase(LAS unsigned char* lds, const int K, const Sched& S, const Epi& E) {
    const int tid = fresh_tid(), wid = __builtin_amdgcn_readfirstlane(tid >> 6), lane = tid & 63, wr = wid >> 2, wc = wid & 3, fr = lane & 15, fq = lane >> 4;
    const int nt = F8 ? K / (2 * BK) : K / BK;
    const int rowb = F8 ? K : 2 * K;
    int Rp[2]; unsigned voffA[2], voffB[2];
#pragma unroll
    for (int i = 0; i < 2; ++i) { int R, C; stage_rc(tid * 16 + i * 8192, R, C); Rp[i] = R; const int Rb = Epi::PERM ? ((R & ~31) + perm32(R & 31)) : R;
        voffA[i] = Sched::GATHER ? (unsigned)C * 2u : (unsigned)(R * rowb + C * 2); voffB[i] = (unsigned)(Rb * rowb + C * 2); }
    const size_t kstep = (size_t)(BK * 2);
    const size_t hstep = (size_t)HALF * rowb;
    const unsigned ldsw = (unsigned)wid * 1024u;
    const int aoff = lds_byte(wr * 64 + fr, fq * 8), boff = lds_byte(wc * 32 + fr, fq * 8);
#define PG8_SA(b, h) (((b) * 2 + (h)) * HTB)
#define PG8_SB(b, h) ((4 + (b) * 2 + (h)) * HTB)
#define PG8_STAGE(bufoff, gbase, v0, v1) do { \
        __builtin_amdgcn_global_load_lds((const unsigned*)((const char*)(gbase) + (v0)), (LAS unsigned*)(lds + (bufoff) + ldsw), 16, 0, 0); \
        __builtin_amdgcn_global_load_lds((const unsigned*)((const char*)(gbase) + (v1)), (LAS unsigned*)(lds + (bufoff) + ldsw + 8192), 16, 0, 0); } while (0)
#define PG8_STAGE_A(bufoff, gbase, h) do { if constexpr (Sched::GATHER) { PG8_STAGE(bufoff, gbase, (unsigned)tok[h][0] * (unsigned)rowb + voffA[0], (unsigned)tok[h][1] * (unsigned)rowb + voffA[1]); } \
        else { PG8_STAGE(bufoff, (gbase) + (h) * hstep, voffA[0], voffA[1]); } } while (0)
#define PG8_LDA_(dst, b, h) do { if constexpr (F8) { _Pragma("unroll") for (int m = 0; m < 4; ++m) { const i32x4 lo_ = *(const LAS i32x4*)(lds + PG8_SA(b, h) + aoff + m * 2048), hi_ = *(const LAS i32x4*)(lds + PG8_SA(b, h) + aoff + m * 2048 + 1024); \
            dst##8[m] = __builtin_shufflevector(lo_, hi_, 0, 1, 2, 3, 4, 5, 6, 7); } } \
        else { _Pragma("unroll") for (int m = 0; m < 4; ++m) _Pragma("unroll") for (int k = 0; k < 2; ++k) dst[m][k] = *(const LAS bf16x8*)(lds + PG8_SA(b, h) + aoff + m * 2048 + k * 1024); } } while (0)
#define PG8_LDB_(dst, b, h) do { if constexpr (F8) { _Pragma("unroll") for (int n = 0; n < 2; ++n) { const i32x4 lo_ = *(const LAS i32x4*)(lds + PG8_SB(b, h) + boff + n * 2048), hi_ = *(const LAS i32x4*)(lds + PG8_SB(b, h) + boff + n * 2048 + 1024); \
            dst##8[n] = __builtin_shufflevector(lo_, hi_, 0, 1, 2, 3, 4, 5, 6, 7); } } \
        else { _Pragma("unroll") for (int n = 0; n < 2; ++n) _Pragma("unroll") for (int k = 0; k < 2; ++k) dst[n][k] = *(const LAS bf16x8*)(lds + PG8_SB(b, h) + boff + n * 2048 + k * 1024); } } while (0)
#define PG8_LDA(dst, b, h) PG8_LDA_(dst, b, h)
#define PG8_LDB(dst, b, h) PG8_LDB_(dst, b, h)
#define PG8_MMA(ai, bj, At, Bt) do { __builtin_amdgcn_s_setprio(1); \
        if constexpr (F8) { _Pragma("unroll") for (int m = 0; m < 4; ++m) _Pragma("unroll") for (int n = 0; n < 2; ++n) \
            acc[ai][bj][m][n] = __builtin_amdgcn_mfma_scale_f32_16x16x128_f8f6f4(Bt##8[n], At##8[m], acc[ai][bj][m][n], 0, 0, 0, 0x7f7f7f7f, 0, 0x7f7f7f7f); } \
        else { _Pragma("unroll") for (int m = 0; m < 4; ++m) _Pragma("unroll") for (int n = 0; n < 2; ++n) _Pragma("unroll") for (int k = 0; k < 2; ++k) \
            acc[ai][bj][m][n] = __builtin_amdgcn_mfma_f32_16x16x32_bf16(Bt[n][k], At[m][k], acc[ai][bj][m][n], 0, 0, 0); } \
        __builtin_amdgcn_s_setprio(0); } while (0)
#define PG8_WAIT_V(n) asm volatile("s_waitcnt vmcnt(" #n ")" ::: "memory")
#define PG8_WAIT_L(n) asm volatile("s_waitcnt lgkmcnt(" #n ")" ::: "memory")
#define PG8_BAR __builtin_amdgcn_s_barrier()
#define PG8_SCHED __builtin_amdgcn_sched_barrier(0)
    Unit cur, nxt; int ui = 0;
    if (!S.next(0, cur)) return;
    f32x4 acc[2][2][4][2];
#pragma unroll
    for (int a = 0; a < 2; ++a)
#pragma unroll
        for (int b = 0; b < 2; ++b)
#pragma unroll
            for (int m = 0; m < 4; ++m)
#pragma unroll
                for (int n = 0; n < 2; ++n) acc[a][b][m][n] = (f32x4){0.f, 0.f, 0.f, 0.f};
    bf16x8 At[4][2], B0[2][2], B1[2][2]; i32x8 At8[4], B08[2], B18[2];
    int tok[2][2] = {{0, 0}, {0, 0}};
    if constexpr (Sched::GATHER) S.load_tok(cur, 0, Rp, tok);
    const char* cA = S.a_ptr(cur); const char* cB = S.b_ptr(cur);
    PG8_STAGE(PG8_SB(0, 0), cB, voffB[0], voffB[1]); PG8_STAGE(PG8_SB(0, 1), cB + hstep, voffB[0], voffB[1]); PG8_STAGE_A(PG8_SA(0, 0), cA, 0); PG8_STAGE_A(PG8_SA(0, 1), cA, 1);
    if (wr == 1) PG8_BAR;
    PG8_WAIT_V(2); PG8_BAR;
    PG8_STAGE(PG8_SB(1, 0), cB + kstep, voffB[0], voffB[1]); PG8_STAGE_A(PG8_SA(1, 0), cA + kstep, 0); PG8_STAGE(PG8_SB(1, 1), cB + hstep + kstep, voffB[0], voffB[1]);
    PG8_WAIT_V(6); PG8_BAR;
    for (;;) {
        if constexpr (Epi::PRE) E.pre(cur, wid, lane);
        const bool has_next = S.next(ui + 1, nxt);
        const char* nA = has_next ? S.a_ptr(nxt) : cA; const char* nB = has_next ? S.b_ptr(nxt) : cB;
#pragma unroll 1
        for (int t = 0; t < nt; t += 2) {
            const bool last = (t == nt - 2);
            const char* a1 = cA + (size_t)(t + 1) * kstep;
            const char* a2 = last ? nA : cA + (size_t)(t + 2) * kstep; const char* b2 = last ? nB : cB + (size_t)(t + 2) * kstep;
            const char* a3 = a2 + kstep; const char* b3 = b2 + kstep;
            PG8_LDB(B0, 0, 0); PG8_LDB(B1, 0, 1); PG8_SCHED; PG8_LDA(At, 0, 0); PG8_STAGE_A(PG8_SA(1, 1), a1, 1);
            if constexpr (Sched::GATHER) { if (last && has_next) S.load_tok(nxt, ui + 1, Rp, tok); }
            PG8_WAIT_V(8); PG8_WAIT_L(0); PG8_BAR; PG8_MMA(0, 0, At, B0); PG8_MMA(0, 1, At, B1); PG8_BAR; PG8_SCHED;
            PG8_LDA(At, 0, 1); PG8_STAGE(PG8_SB(0, 0), b2, voffB[0], voffB[1]); PG8_STAGE(PG8_SB(0, 1), b2 + hstep, voffB[0], voffB[1]); PG8_STAGE_A(PG8_SA(0, 0), a2, 0);
            PG8_WAIT_V(8); PG8_WAIT_L(0); PG8_BAR; PG8_MMA(1, 0, At, B0); PG8_MMA(1, 1, At, B1); PG8_BAR; PG8_SCHED;
            PG8_LDB(B0, 1, 0); PG8_LDB(B1, 1, 1); PG8_SCHED; PG8_LDA(At, 1, 0); PG8_STAGE_A(PG8_SA(0, 1), a2, 1);
            PG8_WAIT_V(8); PG8_WAIT_L(0); PG8_BAR; PG8_MMA(0, 0, At, B0); PG8_MMA(0, 1, At, B1); PG8_BAR; PG8_SCHED;
            PG8_LDA(At, 1, 1); PG8_STAGE(PG8_SB(1, 0), b3, voffB[0], voffB[1]); PG8_STAGE(PG8_SB(1, 1), b3 + hstep, voffB[0], voffB[1]); PG8_STAGE_A(PG8_SA(1, 0), a3, 0);
            PG8_WAIT_V(8); PG8_WAIT_L(0); PG8_BAR; PG8_MMA(1, 0, At, B0); PG8_MMA(1, 1, At, B1); PG8_BAR; PG8_SCHED;
        }
        if constexpr (ALIGN_EPI) { if (wr == 0) PG8_BAR; }
        { int fr_ = fr, fq_ = fq; asm volatile("" : "+v"(fr_), "+v"(fq_));
          E(acc, cur, ui, wr, wc, fr_, fq_); }
        if (!has_next) break;
#pragma unroll
        for (int a = 0; a < 2; ++a)
#pragma unroll
            for (int b = 0; b < 2; ++b)
#pragma unroll
                for (int m = 0; m < 4; ++m)
#pragma unroll
                    for (int n = 0; n < 2; ++n) acc[a][b][m][n] = (f32x4){0.f, 0.f, 0.f, 0.f};
        cur = nxt; cA = nA; cB = nB; ++ui;
        if constexpr (ALIGN_EPI) { if (wr == 1) PG8_BAR; }
    }
    PG8_WAIT_V(0);
    if constexpr (!ALIGN_EPI) { if (wr == 0) PG8_BAR; }
    PG8_BAR;
#undef PG8_SA
#undef PG8_SB
#undef PG8_STAGE
#undef PG8_STAGE_A
#undef PG8_LDA
#undef PG8_LDB
#undef PG8_LDA_
#undef PG8_LDB_
#undef PG8_MMA
#undef PG8_WAIT_V
#undef PG8_WAIT_L
#undef PG8_BAR
#undef PG8_SCHED
}

struct SchedDense {
    const char* A; const char* B; int nN, nUnits, G, vcu, K;
    __device__ __forceinline__ bool next(int i, Unit& u) const { const int L = i * G + vcu; if (L >= nUnits) return false; u.pm = L / nN; u.pn = L - u.pm * nN; u.e = 0; return true; }
    __device__ __forceinline__ const char* a_ptr(const Unit& u) const { return A + (size_t)u.pm * BM * K * 2; }
    __device__ __forceinline__ const char* b_ptr(const Unit& u) const { return B + (size_t)u.pn * BM * K * 2; }
    static constexpr bool GATHER = false;
    __device__ __forceinline__ void load_tok(const Unit&, int, const int (&)[2], int (&)[2][2]) const {}
};
__device__ __forceinline__ int find_expert(const LAS int* blk, int rb) { int e = 0;
#pragma unroll
    for (int j = 1; j < NEXP; ++j) e += (rb >= blk[j]) ? 1 : 0;
    return e; }
struct SchedMoe1 {
    const char* A; const char* W; const LAS int* blk; const LAS int* idx; int nUnits, G, vcu;
    __device__ __forceinline__ bool next(int i, Unit& u) const { const int L = i * G + vcu; if (L >= nUnits) return false; u.pm = L >> 3; u.pn = L & 7; u.e = find_expert(blk, u.pm); return true; }
    __device__ __forceinline__ const char* a_ptr(const Unit&) const { return A; }
    __device__ __forceinline__ const char* b_ptr(const Unit& u) const { return W + ((size_t)u.e * 2048 + (size_t)u.pn * 256) * DM; }
    static constexpr bool GATHER = true;
    __device__ __forceinline__ void load_tok(const Unit&, int ui, const int (&Rp)[2], int (&tok)[2][2]) const {
#pragma unroll
        for (int h = 0; h < 2; ++h)
#pragma unroll
            for (int i = 0; i < 2; ++i) tok[h][i] = idx[ui * 256 + h * HALF + Rp[i]];
    }
};
struct SchedMoe2 {
    const char* A; const char* W; const LAS int* blk; int nUnits, G, vcu;
    __device__ __forceinline__ bool next(int i, Unit& u) const { const int L = i * G + vcu; if (L >= nUnits) return false; u.pm = L >> 2; u.pn = L & 3; u.e = find_expert(blk, u.pm); return true; }
    __device__ __forceinline__ const char* a_ptr(const Unit&) const { return A; }
    __device__ __forceinline__ const char* b_ptr(const Unit& u) const { return W + ((size_t)u.e * 1024 + (size_t)u.pn * 256) * DM; }
    static constexpr bool GATHER = true;
    __device__ __forceinline__ void load_tok(const Unit& u, int, const int (&Rp)[2], int (&tok)[2][2]) const {
#pragma unroll
        for (int h = 0; h < 2; ++h)
#pragma unroll
            for (int i = 0; i < 2; ++i) tok[h][i] = u.pm * BM + h * HALF + Rp[i];
    }
};

struct EpiInProj {
    static constexpr bool PERM = true, PRE = false;
    bf16_t* QKV; const float* rope;
    __device__ __forceinline__ void operator()(const f32x4 (&acc)[2][2][4][2], const Unit& u, int, int wr, int wc, int fr, int fq) const {
        const int t = u.pn >> 1; bf16_t* base = QKV + (size_t)t * NTOK * 512;
        const float sc = (t == 0 || t == 3) ? QSCALE : 1.0f;
        const bool dorope = (t < 2) && ((wc & 1) == 0);
        const int col0 = (u.pn & 1) * 256 + wc * 32 + 8 * fq;
        const float sgn = (fq == 0) ? -1.0f : 1.0f; const bool rl = fq < 2;
#pragma unroll
        for (int ai = 0; ai < 2; ++ai)
#pragma unroll
            for (int m = 0; m < 4; ++m) {
                const int row = u.pm * BM + ai * HALF + wr * 64 + m * 16 + fr;
                f32x4 cs0 = {1.f, 1.f, 1.f, 1.f}, cs1 = cs0, sn0 = {0.f, 0.f, 0.f, 0.f}, sn1 = sn0;
                if (dorope) { const f32x4* rp = (const f32x4*)(rope + (size_t)row * 16); cs0 = rp[0]; cs1 = rp[1]; sn0 = rp[2]; sn1 = rp[3]; }
#pragma unroll
                for (int bj = 0; bj < 2; ++bj) {
                    f32x4 v0 = acc[ai][bj][m][0], v1 = acc[ai][bj][m][1];
                    if (dorope) {
#pragma unroll
                        for (int i = 0; i < 4; ++i) { const float p0 = __shfl_xor(v0[i], 16), p1 = __shfl_xor(v1[i], 16);
                            const float r0 = v0[i] * cs0[i] + sgn * p0 * sn0[i], r1 = v1[i] * cs1[i] + sgn * p1 * sn1[i];
                            v0[i] = rl ? r0 : v0[i]; v1[i] = rl ? r1 : v1[i]; }
                    }
                    v0 = v0 * sc; v1 = v1 * sc;
                    u32x4 w; w.x = cvt_pk_bf16(v0[0], v0[1]); w.y = cvt_pk_bf16(v0[2], v0[3]); w.z = cvt_pk_bf16(v1[0], v1[1]); w.w = cvt_pk_bf16(v1[2], v1[3]);
                    *(u32x4*)(base + (size_t)row * 512 + col0 + bj * HALF) = w;
                }
            }
    }
};
struct EpiOutProj {
    static constexpr bool PERM = false, PRE = false;
    const float* xin; float* xout; const float* g1;
    __device__ __forceinline__ void operator()(const f32x4 (&acc)[2][2][4][2], const Unit& u, int, int wr, int wc, int fr, int fq) const {
        const int b = u.pm >> 4; const int col0 = u.pn * BM + wc * 32 + 4 * fq;
        f32x4 gv[2][2];
#pragma unroll
        for (int bj = 0; bj < 2; ++bj)
#pragma unroll
            for (int n = 0; n < 2; ++n) gv[bj][n] = *(const f32x4*)(g1 + (size_t)b * 6144 + col0 + bj * HALF + n * 16);
#pragma unroll
        for (int ai = 0; ai < 2; ++ai)
#pragma unroll
            for (int m = 0; m < 4; ++m) { const size_t off = (size_t)(u.pm * BM + ai * HALF + wr * 64 + m * 16 + fr) * DM + col0;
#pragma unroll
                for (int bj = 0; bj < 2; ++bj)
#pragma unroll
                    for (int n = 0; n < 2; ++n) { const f32x4 xi = *(const f32x4*)(xin + off + bj * HALF + n * 16); *(f32x4*)(xout + off + bj * HALF + n * 16) = xi + gv[bj][n] * acc[ai][bj][m][n]; }
            }
    }
};
struct EpiMoe1 {
    static constexpr bool PERM = true, PRE = true;
    unsigned char* HID; const float* b1; LAS float* biasl;
    __device__ __forceinline__ void pre(const Unit& u, int wid, int lane) const {
        const float* g = b1 + (size_t)u.e * 2048 + u.pn * HALF + ((lane < 32) ? 4 * lane : 1024 + 4 * (lane - 32));
        __builtin_amdgcn_global_load_lds((const unsigned*)g, (LAS unsigned*)(biasl + wid * 256), 16, 0, 0);
    }
    __device__ __forceinline__ void operator()(const f32x4 (&acc)[2][2][4][2], const Unit& u, int, int wr, int wc, int fr, int fq) const {
        const int wid = wr * 4 + wc; const int hl = wc * 32 + 8 * fq; const int hc = u.pn * HALF + hl; const LAS float* bb = biasl + wid * 256 + hl;
        const f32x4 bg0 = *(const LAS f32x4*)(bb), bg1 = *(const LAS f32x4*)(bb + 4), bu0 = *(const LAS f32x4*)(bb + 128), bu1 = *(const LAS f32x4*)(bb + 132);
#pragma unroll
        for (int ai = 0; ai < 2; ++ai)
#pragma unroll
            for (int m = 0; m < 4; ++m) {
                const size_t row = (size_t)u.pm * BM + ai * HALF + wr * 64 + m * 16 + fr;
                float o[8];
#pragma unroll
                for (int n = 0; n < 2; ++n) { const f32x4 g = acc[ai][0][m][n] * 0.03125f + (n ? bg1 : bg0), up = acc[ai][1][m][n] * 0.03125f + (n ? bu1 : bu0);
#pragma unroll
                    for (int i = 0; i < 4; ++i) { const float gt = fminf(g[i], 7.0f), uu = fminf(fmaxf(up[i], -7.0f), 7.0f);
                        const float sg = __builtin_amdgcn_rcpf(1.0f + __builtin_amdgcn_exp2f(-1.702f * LOG2E * gt)); o[n * 4 + i] = (uu + 1.0f) * gt * sg; } }
                u32x2 w; w.x = pack4_fp8(o[0], o[1], o[2], o[3]); w.y = pack4_fp8(o[4], o[5], o[6], o[7]);
                *(u32x2*)(HID + row * DM + hc) = w;
            }
    }
};
struct EpiMoe2 {
    static constexpr bool PERM = true, PRE = true;
    bf16_t* Y; const float* b2; const LAS int* aidx; LAS float* biasl;
    __device__ __forceinline__ void pre(const Unit& u, int wid, int lane) const {
        __builtin_amdgcn_global_load_lds((const unsigned*)(b2 + (size_t)u.e * 1024 + u.pn * BM + 4 * lane), (LAS unsigned*)(biasl + wid * 256), 16, 0, 0);
    }
    __device__ __forceinline__ void operator()(const f32x4 (&acc)[2][2][4][2], const Unit& u, int ui, int wr, int wc, int fr, int fq) const {
        const int wid = wr * 4 + wc; const int cl = wc * 32 + 8 * fq; const int col0 = u.pn * BM + cl; const LAS float* bb = biasl + wid * 256 + cl;
        f32x4 bv[2][2];
#pragma unroll
        for (int bj = 0; bj < 2; ++bj)
#pragma unroll
            for (int n = 0; n < 2; ++n) bv[bj][n] = *(const LAS f32x4*)(bb + bj * HALF + 4 * n);
#pragma unroll
        for (int ai = 0; ai < 2; ++ai)
#pragma unroll
            for (int m = 0; m < 4; ++m) {
                const int aid = aidx[ui * 256 + ai * HALF + wr * 64 + m * 16 + fr];
#pragma unroll
                for (int bj = 0; bj < 2; ++bj) { const f32x4 v0 = acc[ai][bj][m][0] * 0.03125f + bv[bj][0], v1 = acc[ai][bj][m][1] * 0.03125f + bv[bj][1];
                    u32x4 w; w.x = cvt_pk_bf16(v0[0], v0[1]); w.y = cvt_pk_bf16(v0[2], v0[3]); w.z = cvt_pk_bf16(v1[0], v1[1]); w.w = cvt_pk_bf16(v1[2], v1[3]);
                    *(u32x4*)(Y + (size_t)aid * DM + col0 + bj * HALF) = w; }
            }
    }
};
}

namespace att {
constexpr int STG_F = 16384, STG_D = 32768;
constexpr int LDS_NCK = 98304;
typedef LAS const char* lds_cptr;
typedef short v4i16_t __attribute__((ext_vector_type(4)));
typedef __bf16 bf16x2_t __attribute__((ext_vector_type(2)));
__device__ __forceinline__ void glds16(const void* gsrc, unsigned lds_dst) { unsigned keep;
    asm volatile("s_mov_b32 %0, m0\n\ts_mov_b32 m0, %2\n\ts_nop 0\n\tglobal_load_lds_dwordx4 %1, off\n\ts_mov_b32 m0, %0" : "=&s"(keep) : "v"(gsrc), "s"(lds_dst) : "memory"); }
__device__ __forceinline__ unsigned cvtpk(float lo, float hi) { f32x2 v = {lo, hi}; bf16x2_t b = __builtin_convertvector(v, bf16x2_t); return __builtin_bit_cast(unsigned, b); }
__device__ __forceinline__ s16x4 vtr(lds_cptr p) { return __builtin_bit_cast(s16x4, __builtin_amdgcn_ds_read_tr16_b64_v4i16((LAS v4i16_t*)p)); }
__device__ __forceinline__ float swapmax(float m) { auto rr = __builtin_amdgcn_permlane32_swap(__float_as_uint(m), __float_as_uint(m), false, false); return fmaxf(__uint_as_float(rr[0]), __uint_as_float(rr[1])); }
__device__ __forceinline__ float swapsum(float m) { auto rr = __builtin_amdgcn_permlane32_swap(__float_as_uint(m), __float_as_uint(m), false, false); return __uint_as_float(rr[0]) + __uint_as_float(rr[1]); }
#define ATT_WAIT_BAR(N) asm volatile("s_waitcnt vmcnt(" #N ") lgkmcnt(0)\n\ts_barrier" ::: "memory")
#define ATT_BAR() asm volatile("s_waitcnt lgkmcnt(0)\n\ts_barrier" ::: "memory")

__device__ __forceinline__ float max3f(float a, float b, float c) { float r; asm("v_max3_f32 %0, %1, %2, %3" : "=v"(r) : "v"(a), "v"(b), "v"(c)); return r; }
template <int NO, bool REL>
__device__ __forceinline__ void softmax_tile(f32x16& p0, f32x16& p1, float& m, float& l, f32x16 (&o)[NO], u32x4 (&pw)[4], f32x16& negm, bool first) {
    float mx = max3f(p0[0], p1[0], p0[1]);
    mx = max3f(mx, p1[1], p0[2]); mx = max3f(mx, p1[2], p0[3]); mx = max3f(mx, p1[3], p0[4]); mx = max3f(mx, p1[4], p0[5]); mx = max3f(mx, p1[5], p0[6]); mx = max3f(mx, p1[6], p0[7]);
    float my = max3f(p1[7], p0[8], p1[8]);
    my = max3f(my, p0[9], p1[9]); my = max3f(my, p0[10], p1[10]); my = max3f(my, p0[11], p1[11]); my = max3f(my, p0[12], p1[12]); my = max3f(my, p0[13], p1[13]); my = max3f(my, p0[14], p1[14]);
    mx = max3f(mx, my, p0[15]); mx = fmaxf(mx, p1[15]);
    mx = swapmax(mx);
    if constexpr (REL) {
        if (first || __any(mx > 8.0f)) {
            const float dl = first ? mx : fmaxf(mx, 0.f); const float al = __builtin_amdgcn_exp2f(-dl); m += dl; l *= al;
#pragma unroll
            for (int r = 0; r < 16; ++r) { p0[r] -= dl; p1[r] -= dl; negm[r] = -m; }
#pragma unroll
            for (int d = 0; d < NO; ++d)
#pragma unroll
                for (int r = 0; r < 16; ++r) o[d][r] *= al;
        }
    } else {
        if (__any(mx > m + 8.0f)) {
            const float mn = fmaxf(m, mx); const float al = __builtin_amdgcn_exp2f(m - mn); m = mn; l *= al;
#pragma unroll
            for (int d = 0; d < NO; ++d)
#pragma unroll
                for (int r = 0; r < 16; ++r) o[d][r] *= al;
        }
#pragma unroll
        for (int r = 0; r < 16; ++r) { p0[r] -= m; p1[r] -= m; }
    }
    float ls0 = 0.f, ls1 = 0.f;
#pragma unroll
    for (int r = 0; r < 16; ++r) { p0[r] = __builtin_amdgcn_exp2f(p0[r]); p1[r] = __builtin_amdgcn_exp2f(p1[r]); ls0 += p0[r]; ls1 += p1[r]; }
    l += ls0 + ls1;
    pw[0] = (u32x4){cvtpk(p0[0], p0[1]), cvtpk(p0[2], p0[3]), cvtpk(p0[4], p0[5]), cvtpk(p0[6], p0[7])};
    pw[1] = (u32x4){cvtpk(p0[8], p0[9]), cvtpk(p0[10], p0[11]), cvtpk(p0[12], p0[13]), cvtpk(p0[14], p0[15])};
    pw[2] = (u32x4){cvtpk(p1[0], p1[1]), cvtpk(p1[2], p1[3]), cvtpk(p1[4], p1[5]), cvtpk(p1[6], p1[7])};
    pw[3] = (u32x4){cvtpk(p1[8], p1[9]), cvtpk(p1[10], p1[11]), cvtpk(p1[12], p1[13]), cvtpk(p1[14], p1[15])};
}
#define ATT_SBAR() __builtin_amdgcn_sched_barrier(0)
struct VFrag { s16x4 lo[4], hi[4]; };
__device__ __forceinline__ void vload(VFrag& f, lds_cptr vp, int d) {
#pragma unroll
    for (int ks = 0; ks < 4; ++ks) { f.lo[ks] = vtr(vp + d * 4096 + ks * 1024); f.hi[ks] = vtr(vp + d * 4096 + ks * 1024 + 512); }
}
__device__ __forceinline__ void pv_block(f32x16& o, const VFrag& f, const u32x4 (&pw)[4]) {
#pragma unroll
    for (int ks = 0; ks < 4; ++ks) {
        const bf16x8 vf = (bf16x8){f.lo[ks][0], f.lo[ks][1], f.lo[ks][2], f.lo[ks][3], f.hi[ks][0], f.hi[ks][1], f.hi[ks][2], f.hi[ks][3]};
        o = __builtin_amdgcn_mfma_f32_32x32x16_bf16(vf, __builtin_bit_cast(bf16x8, pw[ks]), o, 0, 0, 0);
    }
}
__device__ __forceinline__ void kload(bf16x8 (&kf)[8], lds_cptr kb, int hi, int sw) {
#pragma unroll
    for (int d0 = 0; d0 < 4; ++d0) { const int co = ((2 * d0 + hi) ^ sw) << 4; kf[2 * d0] = *(const LAS bf16x8*)(kb + co); kf[2 * d0 + 1] = *(const LAS bf16x8*)(kb + co + 4096); }
}
__device__ __forceinline__ void qk_mma(f32x16& p0, f32x16& p1, const bf16x8 (&kf)[8], const bf16x8 (&qr)[4]) {
#pragma unroll
    for (int d0 = 0; d0 < 4; ++d0) {
        p0 = __builtin_amdgcn_mfma_f32_32x32x16_bf16(kf[2 * d0], qr[d0], p0, 0, 0, 0);
        p1 = __builtin_amdgcn_mfma_f32_32x32x16_bf16(kf[2 * d0 + 1], qr[d0], p1, 0, 0, 0);
    }
}

template <int PV>
__device__ __forceinline__ void fox_unit(int b, int h, int qb, const bf16_t* FQ, const bf16_t* FK, const bf16_t* FV, const float* NCK, bf16_t* AO, char* shm) {
    const int tid = fresh_tid(), lane = tid & 63, r32 = lane & 31, hi = lane >> 5; const int wid = __builtin_amdgcn_readfirstlane(tid >> 6);
    const long rowbase = (long)b * SEQ; const int q0 = qb * 256;
    const int NT = 4 * (qb + 1), tl = 4 * qb + (wid >> 1);
    const unsigned lds0 = (unsigned)(uintptr_t)shm;
    const lds_cptr shm3 = (lds_cptr)shm;
    LAS float* nckl = (LAS float*)(shm3 + LDS_NCK);
    const int krow = wid * 8 + (lane >> 3);
    const bf16_t* ksrc = FK + (rowbase + krow) * 512 + h * 64 + (((lane & 7) ^ ((krow >> 1) & 7)) << 3);
    const bf16_t* vsrc = FV + (rowbase + 16 * (wid & 3) + (lane >> 2)) * 512 + h * 64 + (wid >> 2) * 32 + (lane & 3) * 8;
    const unsigned kdst = lds0 + wid * 1024, vdst = lds0 + 8192 + wid * 1024;
#define FOX_DMA(t, so) do { glds16(ksrc + (long)(t) * 64 * 512, (unsigned)__builtin_amdgcn_readfirstlane(kdst + (so))); glds16(vsrc + (long)(t) * 64 * 512, (unsigned)__builtin_amdgcn_readfirstlane(vdst + (so))); } while (0)
    if ((PV & 8) == 0) { FOX_DMA(0, 0); FOX_DMA(1, STG_F); }
    { const f32x4* src = (const f32x4*)(NCK + (size_t)(b * 8 + h) * SEQ); const int n4 = 16 * NT;
      f32x4 c0 = {0.f, 0.f, 0.f, 0.f}, c1 = c0; if (tid < n4) c0 = src[tid]; if (tid + NTHR < n4) c1 = src[tid + NTHR];
      if (tid < n4) ((LAS f32x4*)nckl)[tid] = c0; if (tid + NTHR < n4) ((LAS f32x4*)nckl)[tid + NTHR] = c1; }
    const bf16_t* Qw = FQ + (rowbase + q0 + wid * 32 + r32) * 512 + h * 64;
    bf16x8 qr[4];
#pragma unroll
    for (int d0 = 0; d0 < 4; ++d0) qr[d0] = *(const bf16x8*)(Qw + d0 * 16 + hi * 8);
    asm volatile("" : "+v"(qr[0]), "+v"(qr[1]), "+v"(qr[2]), "+v"(qr[3]));
    const lds_cptr kp0 = shm3 + r32 * 128; const int ksw = (r32 >> 1) & 7;
    const lds_cptr vp0 = shm3 + 8192 + ((lane >> 4) & 1) * 32 + (lane & 3) * 8 + (4 * hi + ((lane & 15) >> 2)) * 64;
    float m = -1e30f, l = 0.f; f32x16 o[2]; o[0] = f32x16{}; o[1] = f32x16{};
    const int qrow = q0 + wid * 32 + r32;
    int so = 0, so2 = 2 * STG_F;
    for (int t = 0; t < NT; ++t) {
        if ((PV & 8) == 0) { if (t + 1 < NT) ATT_WAIT_BAR(2); else ATT_WAIT_BAR(0); } else ATT_BAR();
        bf16x8 kf[8];
        if ((PV & 4) == 0 && t <= tl) kload(kf, kp0 + so, hi, ksw);
        if ((PV & 8) == 0 && t + 2 < NT) FOX_DMA(t + 2, so2);
        if (t <= tl) {
            f32x16 p0, p1; VFrag va, vb;
            const LAS float* nk = nckl + 64 * t + 4 * hi;
#pragma unroll
            for (int g = 0; g < 4; ++g) { const f32x4 a = *(const LAS f32x4*)(nk + 8 * g), c = *(const LAS f32x4*)(nk + 32 + 8 * g);
                p0[4 * g] = a[0]; p0[4 * g + 1] = a[1]; p0[4 * g + 2] = a[2]; p0[4 * g + 3] = a[3]; p1[4 * g] = c[0]; p1[4 * g + 1] = c[1]; p1[4 * g + 2] = c[2]; p1[4 * g + 3] = c[3]; }
            if ((PV & 1) == 0) vload(va, vp0 + so, 0);
            ATT_SBAR();
            if ((PV & 4) == 0) qk_mma(p0, p1, kf, qr);
            asm volatile("s_nop 15\n\ts_nop 7" : "+v"(p0), "+v"(p1));
            ATT_SBAR();
            if (t == tl) { const int kb = 64 * t + 4 * hi;
#pragma unroll
                for (int r = 0; r < 16; ++r) { const int kv = kb + (r & 3) + 8 * (r >> 2); if (kv > qrow) p0[r] = -INFINITY; if (kv + 32 > qrow) p1[r] = -INFINITY; } }
            u32x4 pw[4];
            if ((PV & 2) == 0) softmax_tile<2, false>(p0, p1, m, l, o, pw, p0, false); else { pw[0] = (u32x4){__float_as_uint(p0[0]), __float_as_uint(p0[1]), __float_as_uint(p1[0]), __float_as_uint(p1[1])}; pw[1] = pw[0]; pw[2] = pw[0]; pw[3] = pw[0]; }
            ATT_SBAR();
            if ((PV & 1) == 0) { vload(vb, vp0 + so, 1);
            pv_block(o[0], va, pw);
            ATT_SBAR();
            pv_block(o[1], vb, pw); } else { o[0][0] += __uint_as_float(pw[0][0]); o[1][0] += __uint_as_float(pw[1][1]); }
            ATT_SBAR();
        }
        so = (so == 2 * STG_F) ? 0 : so + STG_F; so2 = (so2 == 2 * STG_F) ? 0 : so2 + STG_F;
    }
#undef FOX_DMA
    l = swapsum(l);
    const float inv = __builtin_amdgcn_rcpf(l);
    bf16_t* Ow = AO + (rowbase + qrow) * 1024 + 512 + h * 64 + 4 * hi;
#pragma unroll
    for (int d = 0; d < 2; ++d)
#pragma unroll
        for (int g = 0; g < 4; ++g) { u32x2 w; w.x = cvt_pk_bf16(o[d][4 * g] * inv, o[d][4 * g + 1] * inv); w.y = cvt_pk_bf16(o[d][4 * g + 2] * inv, o[d][4 * g + 3] * inv);
            *(u32x2*)(Ow + d * 32 + 8 * g) = w; }
    ATT_BAR();
}

template <int PV>
__device__ __forceinline__ void diff_unit(int b, int h, int qb, const bf16_t* DQ, const bf16_t* DK, const bf16_t* DV, const float* subg, float lam, float post, bf16_t* AO, char* shm) {
    const int tid = fresh_tid(), lane = tid & 63, r32 = lane & 31, hi = lane >> 5; const int wid = __builtin_amdgcn_readfirstlane(tid >> 6);
    const int map = wid >> 2, wq = wid & 3;
    const long rowbase = (long)b * SEQ; const int q0 = qb * 128;
    const int NT = 2 * (qb + 1), tl = 2 * qb + (wq >> 1);
    const unsigned lds0 = (unsigned)(uintptr_t)shm;
    const lds_cptr shm3 = (lds_cptr)shm;
    const int qrow = q0 + wq * 32 + r32;
    const int krow = wid * 8 + (lane >> 3);
    const bf16_t* ksrc = DK + (rowbase + krow) * 512 + h * 128 + (((lane & 7) ^ ((krow >> 1) & 7)) << 3);
    const bf16_t* vsrc = DV + (rowbase + 16 * (wid & 3) + (lane >> 2)) * 512 + h * 128 + (wid >> 2) * 32 + (lane & 3) * 8;
    const unsigned kdst = lds0 + wid * 1024, vdst = lds0 + 16384 + wid * 1024;
#define DIFF_DMA(t, so) do { glds16(ksrc + (long)(t) * 64 * 512, (unsigned)__builtin_amdgcn_readfirstlane(kdst + (so))); glds16(ksrc + (long)(t) * 64 * 512 + 64, (unsigned)__builtin_amdgcn_readfirstlane(kdst + 8192 + (so))); \
        glds16(vsrc + (long)(t) * 64 * 512, (unsigned)__builtin_amdgcn_readfirstlane(vdst + (so))); glds16(vsrc + (long)(t) * 64 * 512 + 64, (unsigned)__builtin_amdgcn_readfirstlane(vdst + 8192 + (so))); } while (0)
    if ((PV & 8) == 0) { DIFF_DMA(0, 0); DIFF_DMA(1, STG_D); }
    const bf16_t* Qw = DQ + (rowbase + qrow) * 512 + h * 128 + map * 64;
    bf16x8 qr[4];
#pragma unroll
    for (int d0 = 0; d0 < 4; ++d0) qr[d0] = *(const bf16x8*)(Qw + d0 * 16 + hi * 8);
    asm volatile("" : "+v"(qr[0]), "+v"(qr[1]), "+v"(qr[2]), "+v"(qr[3]));
    const lds_cptr kp0 = shm3 + map * 8192 + r32 * 128; const int ksw = (r32 >> 1) & 7;
    const lds_cptr vp0 = shm3 + 16384 + ((lane >> 4) & 1) * 32 + (lane & 3) * 8 + (4 * hi + ((lane & 15) >> 2)) * 64;
    float m = 0.f, l = 0.f; f32x16 o[4]; o[0] = f32x16{}; o[1] = f32x16{}; o[2] = f32x16{}; o[3] = f32x16{};
    f32x16 negm = f32x16{}; asm volatile("" : "+v"(negm));
    int so = 0, so2 = 2 * STG_D;
    for (int t = 0; t < NT; ++t) {
        if ((PV & 8) == 0) { if (t + 1 < NT) ATT_WAIT_BAR(4); else ATT_WAIT_BAR(0); } else ATT_BAR();
        bf16x8 kf[8];
        if ((PV & 4) == 0 && t <= tl) kload(kf, kp0 + so, hi, ksw);
        if ((PV & 8) == 0 && t + 2 < NT) DIFF_DMA(t + 2, so2);
        if (t <= tl) {
            f32x16 p0 = negm, p1 = negm; VFrag va, vb;
            if ((PV & 1) == 0) vload(va, vp0 + so, 0);
            ATT_SBAR();
            if ((PV & 4) == 0) qk_mma(p0, p1, kf, qr);
            asm volatile("s_nop 15\n\ts_nop 7" : "+v"(p0), "+v"(p1));
            ATT_SBAR();
            u32x4 pw[4];
            if ((PV & 2) == 0) softmax_tile<4, true>(p0, p1, m, l, o, pw, negm, t == 0); else { pw[0] = (u32x4){__float_as_uint(p0[0]), __float_as_uint(p0[1]), __float_as_uint(p1[0]), __float_as_uint(p1[1])}; pw[1] = pw[0]; pw[2] = pw[0]; pw[3] = pw[0]; }
            ATT_SBAR();
            if ((PV & 1) == 0) { vload(vb, vp0 + so, 1);
            pv_block(o[0], va, pw);
            ATT_SBAR();
            vload(va, vp0 + so, 2);
            pv_block(o[1], vb, pw);
            ATT_SBAR();
            vload(vb, vp0 + so, 3);
            pv_block(o[2], va, pw);
            ATT_SBAR();
            pv_block(o[3], vb, pw); } else { o[0][0] += __uint_as_float(pw[0][0]); o[1][0] += __uint_as_float(pw[1][1]); }
            ATT_SBAR();
        }
        so = (so == 2 * STG_D) ? 0 : so + STG_D; so2 = (so2 == 2 * STG_D) ? 0 : so2 + STG_D;
    }
#undef DIFF_DMA
    l = swapsum(l);
    const float inv = __builtin_amdgcn_rcpf(l);
    ATT_BAR();
    LAS float* xch = (LAS float*)shm3 + (wq * 64) * 64 + lane;
    if (map == 1) {
#pragma unroll
        for (int d = 0; d < 4; ++d)
#pragma unroll
            for (int r = 0; r < 16; ++r) xch[(d * 16 + r) * 64] = o[d][r] * inv;
    }
    ATT_BAR();
    if (map == 0) {
        float ss = 0.f;
#pragma unroll
        for (int d = 0; d < 4; ++d)
#pragma unroll
            for (int r = 0; r < 16; ++r) { const float a = o[d][r] * inv - lam * xch[(d * 16 + r) * 64]; o[d][r] = a; ss += a * a; }
        ss = swapsum(ss);
        const float rn = __builtin_amdgcn_rsqf(ss * (1.0f / 128.0f) + NORM_EPS) * post;
        bf16_t* Ow = AO + (rowbase + qrow) * 1024 + h * 128 + 4 * hi;
#pragma unroll
        for (int d = 0; d < 4; ++d)
#pragma unroll
            for (int g = 0; g < 4; ++g) { const f32x4 sg = *(const f32x4*)(subg + d * 32 + 8 * g + 4 * hi);
                u32x2 w; w.x = cvt_pk_bf16(o[d][4 * g] * rn * sg[0], o[d][4 * g + 1] * rn * sg[1]); w.y = cvt_pk_bf16(o[d][4 * g + 2] * rn * sg[2], o[d][4 * g + 3] * rn * sg[3]);
                *(u32x2*)(Ow + d * 32 + 8 * g) = w; }
    }
    ATT_BAR();
}
}

struct Args {
    const float* x; const float* c; const int* pos; const float* ada_w; const float* ada_b; const float* norm_mix; const float* norm_ffn; const float* w_in;
    const float* b_forget; const float* lq1; const float* lk1; const float* lq2; const float* lk2; const float* subln; const float* w_out; const float* router_w;
    const float* router_b; const float* w1; const float* b1; const float* w2; const float* b2; const float* final_norm;
    float* out; unsigned char* ws; int ph_lo, ph_hi;
};

__device__ __forceinline__ void transpose_item(const float* W, int ldw, int K, bf16_t* WT, int k0, int n0, int drow, LAS float* scr, int lane) {
#pragma unroll 8
    for (int i = 0; i < 32; ++i) { const int kk = 2 * i + (lane >> 5); scr[kk * 33 + (lane & 31)] = W[(size_t)(k0 + kk) * ldw + n0 + (lane & 31)]; }
    asm volatile("s_waitcnt lgkmcnt(0)" ::: "memory");
    const int c = lane & 7;
#pragma unroll
    for (int j = 0; j < 4; ++j) { const int n = (lane >> 3) + 8 * j; const LAS float* s = scr + (8 * c) * 33 + n;
        u32x4 o; o.x = cvt_pk_bf16(s[0 * 33], s[1 * 33]); o.y = cvt_pk_bf16(s[2 * 33], s[3 * 33]); o.z = cvt_pk_bf16(s[4 * 33], s[5 * 33]); o.w = cvt_pk_bf16(s[6 * 33], s[7 * 33]);
        *(u32x4*)(WT + (size_t)(drow + n) * K + k0 + 8 * c) = o; }
    asm volatile("s_waitcnt lgkmcnt(0)" ::: "memory");
}

__device__ __forceinline__ void transpose_item_f8(const float* W, int ldw, int K, unsigned char* WT, int k0, int n0, int drow, LAS float* scr, int lane) {
#pragma unroll 8
    for (int i = 0; i < 32; ++i) { const int kk = 2 * i + (lane >> 5); scr[kk * 33 + (lane & 31)] = W[(size_t)(k0 + kk) * ldw + n0 + (lane & 31)]; }
    asm volatile("s_waitcnt lgkmcnt(0)" ::: "memory");
    const int c = lane & 7;
#pragma unroll
    for (int j = 0; j < 4; ++j) { const int n = (lane >> 3) + 8 * j; const LAS float* s = scr + (8 * c) * 33 + n;
        u32x2 o; o.x = pack4_fp8(s[0 * 33] * 32.f, s[1 * 33] * 32.f, s[2 * 33] * 32.f, s[3 * 33] * 32.f); o.y = pack4_fp8(s[4 * 33] * 32.f, s[5 * 33] * 32.f, s[6 * 33] * 32.f, s[7 * 33] * 32.f);
        *(u32x2*)(WT + (size_t)(drow + n) * K + k0 + 8 * c) = o; }
    asm volatile("s_waitcnt lgkmcnt(0)" ::: "memory");
}

__device__ __forceinline__ void norm1_row(const f32x4 (&v)[4], const f32x4 (&gm)[4], const f32x4 (&sh)[4], const LAS float* wft, const float* bfor, bf16_t* xnrow, float* LF, int b, int s, int lane) {
    float ss = 0.f;
#pragma unroll
    for (int j = 0; j < 4; ++j) ss += (v[j][0] * v[j][0] + v[j][1] * v[j][1]) + (v[j][2] * v[j][2] + v[j][3] * v[j][3]);
    const float rstd = __builtin_amdgcn_rsqf(wave_sum(ss) * (1.0f / DM) + NORM_EPS);
    f32x4 hv[4];
#pragma unroll
    for (int j = 0; j < 4; ++j) { hv[j] = v[j] * rstd * gm[j] + sh[j];
        u32x2 w; w.x = cvt_pk_bf16(hv[j][0], hv[j][1]); w.y = cvt_pk_bf16(hv[j][2], hv[j][3]); *(u32x2*)(xnrow + 4 * lane + 256 * j) = w; }
    float mine = 0.f;
#pragma unroll
    for (int hh = 0; hh < 8; ++hh) { float a = 0.f;
#pragma unroll
        for (int j = 0; j < 4; ++j) { const f32x4 w = *(const LAS f32x4*)(wft + hh * DM + 4 * lane + 256 * j); a += (hv[j][0] * w[0] + hv[j][1] * w[1]) + (hv[j][2] * w[2] + hv[j][3] * w[3]); }
        a = wave_sum(a); mine = (lane == hh) ? a : mine; }
    if (lane < 8) { const float z = mine + bfor[lane];
        const float lf = (z >= 0.f) ? -log1pf(__expf(-z)) : (z - log1pf(__expf(z)));
        LF[(size_t)(b * 8 + lane) * SEQ + s] = lf; }
}

__global__ void __launch_bounds__(NTHR, 2) fwd_kernel(Args args) {
    extern __shared__ __attribute__((aligned(16))) unsigned char lds[];
    LAS unsigned char* L = (LAS unsigned char*)lds;
    int tid = threadIdx.x, lane = tid & 63, wave = __builtin_amdgcn_readfirstlane(tid >> 6);
#define FRESH_IDS() do { tid = fresh_tid(); lane = tid & 63; wave = __builtin_amdgcn_readfirstlane(tid >> 6); gw = vcu * NWAVES + wave; } while (0)
    const int G = gridDim.x; const int bx = blockIdx.x; const int vcu = (G % 8 == 0) ? (bx % 8) * (G / 8) + bx / 8 : bx;
#define WSPTRS() unsigned char* ws = args.ws; asm volatile("" : "+s"(ws)); \
    unsigned* ctl = (unsigned*)(ws + WS_CTL); (void)ctl; \
    bf16_t* WQ = (bf16_t*)(ws + WS_WQ); float* BQ = (float*)(ws + WS_BQ); (void)WQ; (void)BQ; \
    float* MOD = (float*)(ws + WS_MOD); float* RWT = (float*)(ws + WS_RWT); float* WFT = (float*)(ws + WS_WFT); float* ROPE = (float*)(ws + WS_ROPE); \
    float* NCK = (float*)(ws + WS_NCK); float* LF = (float*)(ws + WS_LF); float* GATES = (float*)(ws + WS_GATES); int* ROWL = (int*)(ws + WS_ROWL); \
    bf16_t* WIN = (bf16_t*)(ws + WS_WIN); bf16_t* WOUT = (bf16_t*)(ws + WS_WOUT); unsigned char* W1T = ws + WS_W1; unsigned char* W2T = ws + WS_W2; \
    bf16_t* XN = (bf16_t*)(ws + WS_XN); bf16_t* QKV = (bf16_t*)(ws + WS_QKV); bf16_t* AO = (bf16_t*)(ws + WS_AO); \
    float* X1 = (float*)(ws + WS_X1); float* X2 = (float*)(ws + WS_X2); unsigned char* XN2 = ws + WS_XN2; unsigned char* HID = ws + WS_HID; bf16_t* Y = (bf16_t*)(ws + WS_Y); \
    (void)MOD; (void)RWT; (void)WFT; (void)ROPE; (void)NCK; (void)LF; (void)GATES; (void)ROWL; (void)WIN; (void)WOUT; (void)W1T; (void)W2T; (void)XN; (void)QKV; (void)AO; (void)X1; (void)X2; (void)XN2; (void)HID; (void)Y
    for (int u = tid; u < 256; u += NTHR) ((LAS unsigned*)(L + MISC_OFF))[u] = 0u;
    __syncthreads();
#if MK_MULTI
#define GRID_BAR() do { } while (0)
#else
    XcdBarrier bar = xcd_barrier_post((unsigned*)(args.ws + WS_CTL) + CW_BAR, (volatile LAS unsigned*)(L + L_XBST));
#define GRID_BAR() xcd_barrier(bar)
#endif
    const int lo = args.ph_lo, hi_ = args.ph_hi;
#ifndef PH_MASK
#define PH_MASK 0x1ff
#endif
#define IN(k) (lo <= (k) && (k) < hi_)
#define ON(j) (((PH_MASK) >> (j)) & 1)
#ifndef REP_MASK
#define REP_MASK 0
#endif
#define NREP(j) (1 + (((REP_MASK) >> (j)) & 1))
#define BOTH(k) (IN(k) && IN((k) + 1))
    int gw = vcu * NWAVES + wave; const int NGW = G * NWAVES;

    if (ON(0) && IN(0)) {
        FRESH_IDS(); WSPTRS();
        for (int rep_ = 0; rep_ < NREP(0); ++rep_) {
        {
            LAS float* cact = (LAS float*)(L + 73728);
            LAS float* part = (LAS float*)(L + 73728 + 32768);
            for (int i = tid; i < 8 * DM; i += NTHR) { const float cv = args.c[i]; cact[i] = cv / (1.0f + __expf(-cv)); }
            __syncthreads();
            for (int it = vcu; it < 192; it += G) {
                const int l = it / 96, j0 = (it % 96) * 64;
                const float* aw = args.ada_w + (size_t)l * DM * 6144 + j0 + lane;
                float a8[8] = {0.f, 0.f, 0.f, 0.f, 0.f, 0.f, 0.f, 0.f};
#pragma unroll 4
                for (int k = wave * 128; k < wave * 128 + 128; ++k) { const float a = aw[(size_t)k * 6144];
#pragma unroll
                    for (int b = 0; b < 8; ++b) a8[b] += cact[b * DM + k] * a; }
#pragma unroll
                for (int b = 0; b < 8; ++b) part[(wave * 8 + b) * 64 + lane] = a8[b];
                __syncthreads();
                { const int b = tid >> 6; float s = 0.f;
#pragma unroll
                  for (int w = 0; w < 8; ++w) s += part[(w * 8 + b) * 64 + lane];
                  MOD[((size_t)l * 8 + b) * 6144 + j0 + lane] = s + args.ada_b[l * 6144 + j0 + lane]; }
                __syncthreads();
            }
        }
        {
            const int gt = vcu * NTHR + tid, NGT = G * NTHR;
            const double invf[8] = {1.0, 0.1939227432012558, 0.03760603070259094, 0.007292664609849453, 0.0014142135623842478, 0.00027424818836152554, 5.3182957344688475e-05, 1.0313385246263351e-05};
            for (int i = gt; i < NTOK * 8; i += NGT) { const int tok = i >> 3, j = i & 7;
                double iv = invf[0];
#pragma unroll
                for (int q = 1; q < 8; ++q) iv = (j == q) ? invf[q] : iv;
                double rev = (double)args.pos[tok] * iv * 0.15915494309189535; rev -= rint(rev); const float fr_ = (float)rev;
                ROPE[(size_t)tok * 16 + j] = __builtin_amdgcn_cosf(fr_); ROPE[(size_t)tok * 16 + 8 + j] = __builtin_amdgcn_sinf(fr_); }
            for (int i = gt; i < DEPTH * NEXP * DM; i += NGT) { const int l = i / (NEXP * DM), r = i % (NEXP * DM), e = r / DM, k = r % DM; RWT[i] = args.router_w[((size_t)l * DM + k) * NEXP + e]; }
            for (int i = gt; i < DEPTH * 8 * DM; i += NGT) { const int l = i / (8 * DM), r = i % (8 * DM), hh = r / DM, k = r % DM; WFT[i] = args.w_in[((size_t)l * DM + k) * INCOLS + 3072 + hh]; }
        }
        {
            LAS float* scr = (LAS float*)(L + wave * 8704);
            constexpr int I_IN = 16 * 96, I_OUT = 16 * 32, I_1 = 16 * 64, I_2 = 16 * 32;
            constexpr int T_IN = DEPTH * I_IN, T_OUT = DEPTH * I_OUT, T_1 = DEPTH * NEXP * I_1, T_2 = DEPTH * NEXP * I_2;
            for (int it = gw; it < T_IN + T_OUT + T_1 + T_2; it += NGW) {
                int r = it;
                if (r < T_IN) { const int l = r / I_IN, q = r % I_IN, kb = q / 96, nb = q % 96;
                    transpose_item(args.w_in + (size_t)l * DM * INCOLS, INCOLS, DM, WIN + (size_t)l * 3072 * DM, kb * 64, nb * 32, nb * 32, scr, lane); continue; }
                r -= T_IN;
                if (r < T_OUT) { const int l = r / I_OUT, q = r % I_OUT, kb = q / 32, nb = q % 32;
                    transpose_item(args.w_out + (size_t)l * DM * DM, DM, DM, WOUT + (size_t)l * DM * DM, kb * 64, nb * 32, nb * 32, scr, lane); continue; }
                r -= T_OUT;
                if (r < T_1) { const int le = r / I_1, q = r % I_1, kb = q / 64, nb = q % 64; const int n0 = nb * 32;
                    const int drow = (n0 < 1024) ? ((n0 >> 7) * 256 + (n0 & 127)) : ((((n0 - 1024) >> 7) * 256) + 128 + ((n0 - 1024) & 127));
                    transpose_item_f8(args.w1 + (size_t)le * DM * 2048, 2048, DM, W1T + (size_t)le * 2048 * DM, kb * 64, n0, drow, scr, lane); continue; }
                r -= T_1;
                { const int le = r / I_2, q = r % I_2, kb = q / 32, nb = q % 32;
                    transpose_item_f8(args.w2 + (size_t)le * DM * DM, DM, DM, W2T + (size_t)le * DM * DM, kb * 64, nb * 32, nb * 32, scr, lane); }
            }
        }
        } if (BOTH(0)) GRID_BAR();
    }

    if (ON(1) && IN(1)) {
        FRESH_IDS(); WSPTRS();
        for (int rep_ = 0; rep_ < NREP(1); ++rep_) {
        for (int i = vcu * NTHR + tid; i < DEPTH * 8 * 32 * 2 * 64; i += G * NTHR) {
            const int ln = i & 63, blk = (i >> 6) & 1, sq = (i >> 7) & 31, bb = (i >> 12) & 7, ll = i >> 15;
            const int e = 16 * blk + (ln & 15), k0 = 32 * sq + 8 * (ln >> 4);
            const float* md = MOD + ((size_t)ll * 8 + bb) * 6144 + 4 * 1024;
            float w[8]; unsigned hi4[4], lo4[4];
#pragma unroll
            for (int j = 0; j < 8; ++j) w[j] = args.router_w[((size_t)ll * DM + k0 + j) * NEXP + e] * args.norm_ffn[ll * DM + k0 + j] * (1.0f + md[k0 + j]);
#pragma unroll
            for (int j = 0; j < 4; ++j) { hi4[j] = cvt_pk_bf16(w[2 * j], w[2 * j + 1]); lo4[j] = cvt_pk_bf16(w[2 * j] - bf_lo(hi4[j]), w[2 * j + 1] - bf_hi(hi4[j])); }
            u32x4* dst = (u32x4*)(WQ + ((((size_t)(ll * 8 + bb) * 32 + sq) * 2 + blk) * 2) * 64 * 8);
            dst[ln] = (u32x4){hi4[0], hi4[1], hi4[2], hi4[3]}; dst[64 + ln] = (u32x4){lo4[0], lo4[1], lo4[2], lo4[3]};
        }
        for (int i = gw; i < DEPTH * 8 * 32; i += NGW) { const int e = i & 31, bb = (i >> 5) & 7, ll = i >> 8;
            const float* md = MOD + ((size_t)ll * 8 + bb) * 6144 + 3 * 1024; float a = 0.f;
#pragma unroll 4
            for (int j = 0; j < 16; ++j) { const int k = lane + 64 * j; a += md[k] * args.router_w[((size_t)ll * DM + k) * NEXP + e]; }
            a = wave_sum(a); if (lane == 0) BQ[i] = a + args.router_b[ll * NEXP + e]; }
        LAS float* wft = (LAS float*)L;
        for (int i = tid; i < 8 * DM; i += NTHR) wft[i] = WFT[i];
        __syncthreads();
        for (int ch = gw; ch < NTOK / 16; ch += NGW) {
            const int b = ch >> 8; const float* mod = MOD + (size_t)b * 6144;
            f32x4 gm[4], sh[4];
#pragma unroll
            for (int j = 0; j < 4; ++j) { const int c0 = 4 * lane + 256 * j; const f32x4 g = *(const f32x4*)(args.norm_mix + c0), sc = *(const f32x4*)(mod + 1024 + c0); gm[j] = g * (sc + 1.0f); sh[j] = *(const f32x4*)(mod + c0); }
            for (int rr = 0; rr < 16; ++rr) { const int mrow = ch * 16 + rr;
                f32x4 v[4];
#pragma unroll
                for (int j = 0; j < 4; ++j) v[j] = *(const f32x4*)(args.x + (size_t)mrow * DM + 4 * lane + 256 * j);
                norm1_row(v, gm, sh, wft, args.b_forget, XN + (size_t)mrow * DM, LF, b, mrow & (SEQ - 1), lane); }
        }
        __syncthreads();
        } if (BOTH(1)) GRID_BAR();
    }

    for (int l = 0; l < DEPTH; ++l) {
        const int pb = 2 + 7 * l;
#define modl (MOD + (size_t)l * 8 * 6144)
#define xin ((l == 0) ? args.x : (const float*)X2)
        if (ON(2) && IN(pb + 0)) {
            FRESH_IDS(); WSPTRS();
        for (int rep_ = 0; rep_ < NREP(2); ++rep_) {
            if (vcu < 64) {
                const float* src = LF + (size_t)vcu * SEQ + 8 * tid; float* dst = NCK + (size_t)vcu * SEQ + 8 * tid;
                f32x4 a = *(const f32x4*)src, c2 = *(const f32x4*)(src + 4);
                float e[8] = {a[0], a[1], a[2], a[3], c2[0], c2[1], c2[2], c2[3]};
#pragma unroll
                for (int i = 1; i < 8; ++i) e[i] += e[i - 1];
                float tot = e[7], inc = tot;
#pragma unroll
                for (int o = 1; o < 64; o <<= 1) { const float n = __shfl_up(inc, o); if (lane >= o) inc += n; }
                LAS float* sc = (LAS float*)(L + L_SCAN);
                if (lane == 63) sc[wave] = inc;
                __syncthreads();
                float pre = inc - tot;
                for (int w = 0; w < wave; ++w) pre += sc[w];
                f32x4 o0, o1;
                o0[0] = -(e[0] + pre) * LOG2E; o0[1] = -(e[1] + pre) * LOG2E; o0[2] = -(e[2] + pre) * LOG2E; o0[3] = -(e[3] + pre) * LOG2E;
                o1[0] = -(e[4] + pre) * LOG2E; o1[1] = -(e[5] + pre) * LOG2E; o1[2] = -(e[6] + pre) * LOG2E; o1[3] = -(e[7] + pre) * LOG2E;
                *(f32x4*)dst = o0; *(f32x4*)(dst + 4) = o1;
            }
            __syncthreads();
            pg8::SchedDense S{(const char*)XN, (const char*)(WIN + (size_t)l * 3072 * DM), 12, (NTOK / 256) * 12, G, vcu, DM};
            pg8::EpiInProj E{QKV, ROPE};
            pg8::gemm_phase<pg8::EpiInProj, pg8::SchedDense, true>(L, DM, S, E);
            } if (BOTH(pb + 0)) GRID_BAR();
        }
        if (ON(3) && IN(pb + 1)) {
            FRESH_IDS(); WSPTRS();
        for (int rep_ = 0; rep_ < NREP(3); ++rep_) {
            const bf16_t* DQ = QKV; const bf16_t* DK = QKV + (size_t)NTOK * 512; const bf16_t* DV = QKV + (size_t)2 * NTOK * 512;
            const bf16_t* FQ = QKV + (size_t)3 * NTOK * 512; const bf16_t* FK = QKV + (size_t)4 * NTOK * 512; const bf16_t* FV = QKV + (size_t)5 * NTOK * 512;
            const float lam_init = 0.8f - 0.6f * expf(-0.3f * (float)l);
            const float s1 = wave_sum(args.lq1[l * 64 + lane] * args.lk1[l * 64 + lane]), s2 = wave_sum(args.lq2[l * 64 + lane] * args.lk2[l * 64 + lane]);
            const float lam = expf(s1) - expf(s2) + lam_init;
#ifndef ATT_PV
#define ATT_PV 0
#endif
            if (NREP(3) == 2 && rep_ == 0) {
                if ((ATT_PV & 16) == 0) for (int p = vcu; p < 512; p += G) { const int bh = p >> 3, s = p & 7;
                    att::fox_unit<ATT_PV & 15>(bh >> 3, bh & 7, 15 - s, FQ, FK, FV, NCK, AO, (char*)lds);
                    att::fox_unit<ATT_PV & 15>(bh >> 3, bh & 7, s, FQ, FK, FV, NCK, AO, (char*)lds); }
                if ((ATT_PV & 32) == 0) for (int p = vcu; p < 512; p += G) { const int bh = p >> 4, s = p & 15;
                    att::diff_unit<ATT_PV & 15>(bh >> 2, bh & 3, 31 - s, DQ, DK, DV, args.subln + l * 128, lam, 1.0f - lam_init, AO, (char*)lds);
                    att::diff_unit<ATT_PV & 15>(bh >> 2, bh & 3, s, DQ, DK, DV, args.subln + l * 128, lam, 1.0f - lam_init, AO, (char*)lds); }
            } else {
            for (int p = vcu; p < 512; p += G) { const int bh = p >> 3, s = p & 7;
                att::fox_unit<0>(bh >> 3, bh & 7, 15 - s, FQ, FK, FV, NCK, AO, (char*)lds);
                att::fox_unit<0>(bh >> 3, bh & 7, s, FQ, FK, FV, NCK, AO, (char*)lds); }
            for (int p = vcu; p < 512; p += G) { const int bh = p >> 4, s = p & 15;
                att::diff_unit<0>(bh >> 2, bh & 3, 31 - s, DQ, DK, DV, args.subln + l * 128, lam, 1.0f - lam_init, AO, (char*)lds);
                att::diff_unit<0>(bh >> 2, bh & 3, s, DQ, DK, DV, args.subln + l * 128, lam, 1.0f - lam_init, AO, (char*)lds); }
            }
            } if (BOTH(pb + 1)) GRID_BAR();
        }
        if (ON(4) && IN(pb + 2)) {
            FRESH_IDS(); WSPTRS();
        for (int rep_ = 0; rep_ < NREP(4); ++rep_) {
            pg8::SchedDense S{(const char*)AO, (const char*)(WOUT + (size_t)l * DM * DM), 4, (NTOK / 256) * 4, G, vcu, DM};
            pg8::EpiOutProj E{xin, X1, modl + 2 * 1024};
            pg8::gemm_phase<pg8::EpiOutProj, pg8::SchedDense, true>(L, DM, S, E);
            } if (BOTH(pb + 2)) GRID_BAR();
        }
        if (ON(5) && IN(pb + 3)) {
            FRESH_IDS(); WSPTRS();
            LAS u32x4* wq = (LAS u32x4*)L;
            LAS float* rsl = (LAS float*)(L + IDX_OFF) + wave * 16;
            LAS float* bql = (LAS float*)(L + IDX_OFF + 1024);
            LAS int* hist = (LAS int*)(L + L_HIST); LAS int* basel = (LAS int*)(L + L_BASE);
            const int nch = NTOK / 16, niter = (nch + NGW - 1) / NGW;
            int bcur = -1;
            if (tid < 32) hist[tid] = 0;
            unsigned* cntg = ctl + CW_CNT + l * 32 * 64;
            for (int itr = 0; itr < niter; ++itr) {
                const int ch = itr * NGW + gw; const bool act = ch < nch;
                const int bwg = ((itr * NGW + vcu * NWAVES) >> 8) & 7;
                if (bwg != bcur) { __syncthreads(); bcur = bwg;
                    const u32x4* src = (const u32x4*)(WQ + (size_t)(l * 8 + bwg) * 32 * 2 * 2 * 64 * 8);
                    for (int i = tid; i < 32 * 2 * 2 * 64; i += NTHR) wq[i] = src[i];
                    if (tid < 32) bql[tid] = BQ[(l * 8 + bwg) * 32 + tid];
                    __syncthreads(); }
                int te[4] = {0, 0, 0, 0}, lr[4] = {0, 0, 0, 0}; float tg[4] = {0.f, 0.f, 0.f, 0.f};
                for (int rep_ = 0; rep_ < NREP(5); ++rep_)
                if (act) {
                    const int b = ch >> 8; const float* mod = modl + (size_t)b * 6144;
                    const int tk = lane & 15, kg = lane >> 4;
                    const float* xr = X1 + (size_t)(ch * 16 + tk) * DM + 8 * kg;
                    f32x4 acc0 = {0.f, 0.f, 0.f, 0.f}, acc1 = acc0; float ssq = 0.f;
#pragma unroll 4
                    for (int sq = 0; sq < 32; ++sq) {
                        const f32x4 xa = *(const f32x4*)(xr + 32 * sq), xb = *(const f32x4*)(xr + 32 * sq + 4);
                        ssq += (xa[0] * xa[0] + xa[1] * xa[1]) + (xa[2] * xa[2] + xa[3] * xa[3]) + (xb[0] * xb[0] + xb[1] * xb[1]) + (xb[2] * xb[2] + xb[3] * xb[3]);
                        u32x4 xh, xl;
                        xh[0] = cvt_pk_bf16(xa[0], xa[1]); xh[1] = cvt_pk_bf16(xa[2], xa[3]); xh[2] = cvt_pk_bf16(xb[0], xb[1]); xh[3] = cvt_pk_bf16(xb[2], xb[3]);
                        xl[0] = cvt_pk_bf16(xa[0] - bf_lo(xh[0]), xa[1] - bf_hi(xh[0])); xl[1] = cvt_pk_bf16(xa[2] - bf_lo(xh[1]), xa[3] - bf_hi(xh[1]));
                        xl[2] = cvt_pk_bf16(xb[0] - bf_lo(xh[2]), xb[1] - bf_hi(xh[2])); xl[3] = cvt_pk_bf16(xb[2] - bf_lo(xh[3]), xb[3] - bf_hi(xh[3]));
                        const bf16x8 bh = __builtin_bit_cast(bf16x8, xh), bl = __builtin_bit_cast(bf16x8, xl);
                        const LAS u32x4* wp = wq + sq * 256 + lane;
                        const bf16x8 w0h = __builtin_bit_cast(bf16x8, wp[0]), w0l = __builtin_bit_cast(bf16x8, wp[64]), w1h = __builtin_bit_cast(bf16x8, wp[128]), w1l = __builtin_bit_cast(bf16x8, wp[192]);
                        acc0 = __builtin_amdgcn_mfma_f32_16x16x32_bf16(w0h, bh, acc0, 0, 0, 0); acc1 = __builtin_amdgcn_mfma_f32_16x16x32_bf16(w1h, bh, acc1, 0, 0, 0);
                        acc0 = __builtin_amdgcn_mfma_f32_16x16x32_bf16(w0l, bh, acc0, 0, 0, 0); acc1 = __builtin_amdgcn_mfma_f32_16x16x32_bf16(w1l, bh, acc1, 0, 0, 0);
                        acc0 = __builtin_amdgcn_mfma_f32_16x16x32_bf16(w0h, bl, acc0, 0, 0, 0); acc1 = __builtin_amdgcn_mfma_f32_16x16x32_bf16(w1h, bl, acc1, 0, 0, 0);
                    }
                    ssq += __shfl_xor(ssq, 16); ssq += __shfl_xor(ssq, 32);
                    const float rstd = __builtin_amdgcn_rsqf(ssq * (1.0f / DM) + NORM_EPS);
                    if (lane < 16) rsl[lane] = rstd;
                    float v0 = -INFINITY, v1 = -INFINITY, v2 = -INFINITY, v3 = -INFINITY; int i0 = 0, i1 = 0, i2 = 0, i3 = 0;
#define TOPK_INS(x_, e_) do { const float xx_ = (x_); const int ee_ = (e_); \
                        if (xx_ > v3 || (xx_ == v3 && ee_ < i3)) { v3 = xx_; i3 = ee_; \
                            if (v3 > v2 || (v3 == v2 && i3 < i2)) { float tf = v2; v2 = v3; v3 = tf; int ti = i2; i2 = i3; i3 = ti; \
                                if (v2 > v1 || (v2 == v1 && i2 < i1)) { tf = v1; v1 = v2; v2 = tf; ti = i1; i1 = i2; i2 = ti; \
                                    if (v1 > v0 || (v1 == v0 && i1 < i0)) { tf = v0; v0 = v1; v1 = tf; ti = i0; i0 = i1; i1 = ti; } } } } } while (0)
#pragma unroll
                    for (int r = 0; r < 4; ++r) { TOPK_INS(acc0[r] * rstd + bql[4 * kg + r], 4 * kg + r); }
#pragma unroll
                    for (int r = 0; r < 4; ++r) { TOPK_INS(acc1[r] * rstd + bql[16 + 4 * kg + r], 16 + 4 * kg + r); }
#pragma unroll
                    for (int st = 16; st <= 32; st <<= 1) {
                        const float p0 = __shfl_xor(v0, st), p1 = __shfl_xor(v1, st), p2 = __shfl_xor(v2, st), p3 = __shfl_xor(v3, st);
                        const int q0 = __shfl_xor(i0, st), q1 = __shfl_xor(i1, st), q2 = __shfl_xor(i2, st), q3 = __shfl_xor(i3, st);
                        TOPK_INS(p0, q0); TOPK_INS(p1, q1); TOPK_INS(p2, q2); TOPK_INS(p3, q3);
                    }
#undef TOPK_INS
                    if (lane < 16) {
                        const float e1 = __expf(v1 - v0), e2 = __expf(v2 - v0), e3 = __expf(v3 - v0); const float rs = 1.0f / (1.0f + e1 + e2 + e3);
                        te[0] = i0; te[1] = i1; te[2] = i2; te[3] = i3; tg[0] = rs; tg[1] = e1 * rs; tg[2] = e2 * rs; tg[3] = e3 * rs;
#pragma unroll
                        for (int k = 0; k < 4; ++k) if (rep_ == NREP(5) - 1) lr[k] = atomicAdd((int*)(lds + L_HIST) + te[k], 1);
                    }
                    f32x4 gm[4], sh[4];
#pragma unroll
                    for (int j = 0; j < 4; ++j) { const int c0 = 4 * lane + 256 * j; const f32x4 g = *(const f32x4*)(args.norm_ffn + l * DM + c0), sc = *(const f32x4*)(mod + 4 * 1024 + c0); gm[j] = g * (sc + 1.0f); sh[j] = *(const f32x4*)(mod + 3 * 1024 + c0); }
                    asm volatile("s_waitcnt lgkmcnt(0)" ::: "memory");
#pragma unroll 2
                    for (int rr = 0; rr < 16; ++rr) { const int mrow = ch * 16 + rr; const float rs2 = rsl[rr];
#pragma unroll
                        for (int j = 0; j < 4; ++j) { const f32x4 v = *(const f32x4*)(X1 + (size_t)mrow * DM + 4 * lane + 256 * j) * rs2 * gm[j] + sh[j];
                            *(unsigned*)(XN2 + (size_t)mrow * DM + 4 * lane + 256 * j) = pack4_fp8(v[0], v[1], v[2], v[3]); } }
                }
                __syncthreads();
                if (tid < 32) { const int c = hist[tid]; int base = 0; if (c > 0) base = (int)__hip_atomic_fetch_add(cntg + tid * 64, (unsigned)c, __ATOMIC_RELAXED, __HIP_MEMORY_SCOPE_AGENT); basel[tid] = base; hist[tid] = 0; }
                __syncthreads();
                if (act && lane < 16) { const int mrow = ch * 16 + lane;
#pragma unroll
                    for (int k = 0; k < 4; ++k) { ROWL[(size_t)te[k] * ROWCAP + basel[te[k]] + lr[k]] = mrow * 4 + k; GATES[mrow * 4 + k] = tg[k]; } }
                __syncthreads();
            }
            if (BOTH(pb + 3)) GRID_BAR();
        }
        if ((ON(6) && IN(pb + 4)) || (ON(7) && IN(pb + 5))) {
            FRESH_IDS(); WSPTRS();
            LAS int* lcnt = (LAS int*)(L + L_CNT); LAS int* lblk = (LAS int*)(L + L_BLK); LAS int* idx = (LAS int*)(L + IDX_OFF);
            unsigned* cntg = ctl + CW_CNT + l * 32 * 64;
            __syncthreads();
            if (tid < 32) lcnt[tid] = (int)__hip_atomic_load(cntg + tid * 64, __ATOMIC_RELAXED, __HIP_MEMORY_SCOPE_AGENT);
            __syncthreads();
            if (tid == 0) { int s = 0; for (int e = 0; e < 32; ++e) { lblk[e] = s; s += (lcnt[e] + 255) >> 8; } lblk[32] = s; }
            __syncthreads();
            const int nrb = lblk[32];
            if (ON(6) && IN(pb + 4)) {
        for (int rep_ = 0; rep_ < NREP(6); ++rep_) {
                const int nU = nrb * 8;
                for (int i = 0; i * G + vcu < nU; ++i) { const int rb = (i * G + vcu) >> 3; const int e = pg8::find_expert(lblk, rb);
                    if (tid < 256) { const int r = (rb - lblk[e]) * 256 + tid; idx[i * 256 + tid] = (r < lcnt[e]) ? (ROWL[(size_t)e * ROWCAP + r] >> 2) : 0; } }
                __syncthreads();
                pg8::SchedMoe1 S{(const char*)XN2, (const char*)(W1T + (size_t)l * NEXP * 2048 * DM), lblk, idx, nU, G, vcu};
                pg8::EpiMoe1 E{HID, args.b1 + (size_t)l * NEXP * 2048, (LAS float*)(L + BIAS_OFF)};
                pg8::gemm_phase<pg8::EpiMoe1, pg8::SchedMoe1, true, true>(L, DM, S, E);
                } if (BOTH(pb + 4)) GRID_BAR();
            }
            if (ON(7) && IN(pb + 5)) {
        for (int rep_ = 0; rep_ < NREP(7); ++rep_) {
                const int nU = nrb * 4;
                __syncthreads();
                for (int i = 0; i * G + vcu < nU; ++i) { const int rb = (i * G + vcu) >> 2; const int e = pg8::find_expert(lblk, rb);
                    if (tid < 256) { const int r = (rb - lblk[e]) * 256 + tid; idx[i * 256 + tid] = (r < lcnt[e]) ? ROWL[(size_t)e * ROWCAP + r] : NTOK * TOPK; } }
                __syncthreads();
                pg8::SchedMoe2 S{(const char*)HID, (const char*)(W2T + (size_t)l * NEXP * DM * DM), lblk, nU, G, vcu};
                pg8::EpiMoe2 E{Y, args.b2 + (size_t)l * NEXP * DM, idx, (LAS float*)(L + BIAS_OFF)};
                pg8::gemm_phase<pg8::EpiMoe2, pg8::SchedMoe2, true, true>(L, DM, S, E);
                } if (BOTH(pb + 5)) GRID_BAR();
            }
        }
        if (ON(8) && IN(pb + 6)) {
            FRESH_IDS(); WSPTRS();
        for (int rep_ = 0; rep_ < NREP(8); ++rep_) {
            LAS float* wft = (LAS float*)L;
            if (l + 1 < DEPTH) { for (int i = tid; i < 8 * DM; i += NTHR) wft[i] = WFT[(size_t)(l + 1) * 8 * DM + i]; }
            __syncthreads();
            for (int ch = gw; ch < NTOK / 16; ch += NGW) {
                const int b = ch >> 8; const float* mod = modl + (size_t)b * 6144;
                f32x4 g2[4], gm[4], sh[4];
#pragma unroll
                for (int j = 0; j < 4; ++j) { const int c0 = 4 * lane + 256 * j; g2[j] = *(const f32x4*)(mod + 5 * 1024 + c0);
                    if (l + 1 < DEPTH) { const float* mod2 = MOD + ((size_t)(l + 1) * 8 + b) * 6144; const f32x4 g = *(const f32x4*)(args.norm_mix + (l + 1) * DM + c0), sc = *(const f32x4*)(mod2 + 1024 + c0); gm[j] = g * (sc + 1.0f); sh[j] = *(const f32x4*)(mod2 + c0); }
                    else { gm[j] = *(const f32x4*)(args.final_norm + c0); sh[j] = (f32x4){0.f, 0.f, 0.f, 0.f}; } }
                for (int rr = 0; rr < 16; ++rr) { const int mrow = ch * 16 + rr;
                    const f32x4 gt = *(const f32x4*)(GATES + (size_t)mrow * 4);
                    f32x4 v[4];
#pragma unroll
                    for (int j = 0; j < 4; ++j) { const int c0 = 4 * lane + 256 * j;
                        f32x4 a = {0.f, 0.f, 0.f, 0.f};
#pragma unroll
                        for (int k = 0; k < 4; ++k) { const u32x2 yw = *(const u32x2*)(Y + ((size_t)mrow * 4 + k) * DM + c0); const float gk = gt[k];
                            a[0] += gk * bf_lo(yw.x); a[1] += gk * bf_hi(yw.x); a[2] += gk * bf_lo(yw.y); a[3] += gk * bf_hi(yw.y); }
                        v[j] = *(const f32x4*)(X1 + (size_t)mrow * DM + c0) + g2[j] * a; }
                    if (l + 1 < DEPTH) {
#pragma unroll
                        for (int j = 0; j < 4; ++j) *(f32x4*)(X2 + (size_t)mrow * DM + 4 * lane + 256 * j) = v[j];
                        norm1_row(v, gm, sh, wft, args.b_forget + (l + 1) * 8, XN + (size_t)mrow * DM, LF, b, mrow & (SEQ - 1), lane);
                    } else {
                        float ss = 0.f;
#pragma unroll
                        for (int j = 0; j < 4; ++j) ss += (v[j][0] * v[j][0] + v[j][1] * v[j][1]) + (v[j][2] * v[j][2] + v[j][3] * v[j][3]);
                        const float rstd = __builtin_amdgcn_rsqf(wave_sum(ss) * (1.0f / DM) + NORM_EPS);
#pragma unroll
                        for (int j = 0; j < 4; ++j) *(f32x4*)(args.out + (size_t)mrow * DM + 4 * lane + 256 * j) = v[j] * rstd * gm[j];
                    }
                }
            }
            __syncthreads();
            } if (BOTH(pb + 6)) GRID_BAR();
        }
    }
#undef IN
#undef BOTH
}

extern "C" void kernel_launch(void* const* d_in, const int* in_sizes, int n_in, void* d_out, int out_size, void* d_ws, size_t ws_size, hipStream_t stream) {
    static int grid = 0;
    if (grid == 0) {
        if (n_in != 22 || in_sizes[0] != NTOK * DM || out_size != NTOK * DM || ws_size < WS_END) {
            fprintf(stderr, "kernel_launch: unexpected shapes: n_in %d in0 %d out %d ws %zu (need %zu)\n", n_in, n_in > 0 ? in_sizes[0] : -1, out_size, ws_size, (size_t)WS_END); grid = -1; return; }
        int dev = 0, cus = 0, per_cu = 0;
        if (hipGetDevice(&dev) != hipSuccess || hipDeviceGetAttribute(&cus, hipDeviceAttributeMultiprocessorCount, dev) != hipSuccess) { grid = -1; return; }
        if (hipFuncSetAttribute((const void*)fwd_kernel, hipFuncAttributeMaxDynamicSharedMemorySize, LDS_BYTES) != hipSuccess) { fprintf(stderr, "kernel_launch: hipFuncSetAttribute failed\n"); grid = -1; return; }
        if (hipOccupancyMaxActiveBlocksPerMultiprocessor(&per_cu, (const void*)fwd_kernel, NTHR, LDS_BYTES) != hipSuccess || per_cu < 1)
            fprintf(stderr, "kernel_launch: occupancy query reports %d blocks per CU\n", per_cu);
        (void)hipGetLastError();
        grid = cus;
    }
    if (grid < 0) return;
    (void)hipMemsetAsync((char*)d_ws + WS_CTL, 0, CTL_ZERO_BYTES, stream);
    Args a{};
    a.x = (const float*)d_in[0]; a.c = (const float*)d_in[1]; a.pos = (const int*)d_in[2]; a.ada_w = (const float*)d_in[3]; a.ada_b = (const float*)d_in[4];
    a.norm_mix = (const float*)d_in[5]; a.norm_ffn = (const float*)d_in[6]; a.w_in = (const float*)d_in[7]; a.b_forget = (const float*)d_in[8];
    a.lq1 = (const float*)d_in[9]; a.lk1 = (const float*)d_in[10]; a.lq2 = (const float*)d_in[11]; a.lk2 = (const float*)d_in[12]; a.subln = (const float*)d_in[13];
    a.w_out = (const float*)d_in[14]; a.router_w = (const float*)d_in[15]; a.router_b = (const float*)d_in[16]; a.w1 = (const float*)d_in[17]; a.b1 = (const float*)d_in[18];
    a.w2 = (const float*)d_in[19]; a.b2 = (const float*)d_in[20]; a.final_norm = (const float*)d_in[21];
    a.out = (float*)d_out; a.ws = (unsigned char*)d_ws;
    constexpr int NPH = 2 + 7 * DEPTH;
#if MK_MULTI
    for (int p = 0; p < NPH; ++p) { a.ph_lo = p; a.ph_hi = p + 1; hipLaunchKernelGGL(fwd_kernel, dim3(grid), dim3(NTHR), LDS_BYTES, stream, a); }
#else
    a.ph_lo = 0; a.ph_hi = NPH;
    hipLaunchKernelGGL(fwd_kernel, dim3(grid), dim3(NTHR), LDS_BYTES, stream, a);
#endif
    const hipError_t le = hipPeekAtLastError();
    if (le != hipSuccess) fprintf(stderr, "kernel_launch: launch failed: %s\n", hipGetErrorName(le));
}
```

```cpp
#include <hip/hip_runtime.h>
#include <hip/hip_bf16.h>
#include <cstdio>
#include <cstdint>
#include <cmath>

#ifndef MK_MULTI
#define MK_MULTI 0
#endif

constexpr int BATCH = 8, SEQ = 4096, DM = 1024, NTOK = BATCH * SEQ, DEPTH = 2, NEXP = 32, TOPK = 4;
constexpr int INCOLS = 3080, DFF = 1024;
constexpr int NWAVES = 8, NTHR = 512;
constexpr float NORM_EPS = 1e-6f;
constexpr float LOG2E = 1.4426950408889634f;
constexpr float QSCALE = 0.125f * LOG2E;
constexpr int ROWCAP = NTOK;
constexpr int MAXRB = (NTOK * TOPK) / 256 + NEXP;

constexpr size_t MiB = 1u << 20;
constexpr size_t WS_CTL = 0, CTL_ZERO_BYTES = 2 * MiB;
constexpr size_t WS_MOD = 2 * MiB;
constexpr size_t WS_RWT = 3 * MiB;
constexpr size_t WS_WFT = 3 * MiB + 512 * 1024;
constexpr size_t WS_ROPE = 4 * MiB;
constexpr size_t WS_NCK = 6 * MiB;
constexpr size_t WS_LF = 7 * MiB;
constexpr size_t WS_GATES = 8 * MiB;
constexpr size_t WS_ROWL = 9 * MiB;
constexpr size_t WS_WQ = 13 * MiB;
constexpr size_t WS_BQ = 15 * MiB;
constexpr size_t WS_WIN = 16 * MiB;
constexpr size_t WS_WOUT = 28 * MiB;
constexpr size_t WS_W1 = 32 * MiB;
constexpr size_t WS_W2 = 288 * MiB;
constexpr size_t WS_XN = 416 * MiB;
constexpr size_t WS_QKV = 480 * MiB;
constexpr size_t WS_AO = 672 * MiB;
constexpr size_t WS_X1 = 736 * MiB;
constexpr size_t WS_X2 = 864 * MiB;
constexpr size_t WS_XN2 = 992 * MiB;
constexpr size_t WS_HID = 1056 * MiB;
constexpr size_t WS_Y = 1328 * MiB;
constexpr size_t WS_END = 1585 * MiB;
constexpr int CW_BAR = 4096;
constexpr int CW_KN = 12288;
constexpr int CW_CNT = 16384;

constexpr int RING_BYTES = 131072;
constexpr int MISC_OFF = RING_BYTES;
constexpr int L_XBST = MISC_OFF;
constexpr int L_CNT = MISC_OFF + 64;
constexpr int L_BLK = MISC_OFF + 192;
constexpr int L_HIST = MISC_OFF + 384;
constexpr int L_BASE = MISC_OFF + 512;
constexpr int L_SCAN = MISC_OFF + 640;
constexpr int L_VOTE = MISC_OFF + 704;
constexpr int IDX_OFF = MISC_OFF + 1024;
constexpr int IDX_BYTES = 18432;
constexpr int BIAS_OFF = IDX_OFF + IDX_BYTES;
constexpr int LDS_BYTES = BIAS_OFF + 8192;

#define GAS __attribute__((address_space(1)))
#define LAS __attribute__((address_space(3)))
typedef unsigned short bf16_t;
typedef short bf16x8 __attribute__((ext_vector_type(8)));
typedef short s16x4 __attribute__((ext_vector_type(4)));
typedef float f32x4 __attribute__((ext_vector_type(4)));
typedef float f32x2 __attribute__((ext_vector_type(2)));
typedef float f32x16 __attribute__((ext_vector_type(16)));
typedef unsigned u32x4 __attribute__((ext_vector_type(4)));
typedef unsigned u32x2 __attribute__((ext_vector_type(2)));

__device__ __forceinline__ unsigned cvt_pk_bf16(float lo, float hi) { unsigned r; asm volatile("v_cvt_pk_bf16_f32 %0, %1, %2" : "=v"(r) : "v"(lo), "v"(hi)); return r; }
__device__ __forceinline__ int fresh_tid() { int t = threadIdx.x; asm volatile("" : "+v"(t)); return t; }
__device__ __forceinline__ unsigned pack4_fp8(float a, float b, float c, float d) {
    int w = __builtin_amdgcn_cvt_pk_fp8_f32(a, b, 0, false); w = __builtin_amdgcn_cvt_pk_fp8_f32(c, d, w, true); return (unsigned)w; }
__device__ __forceinline__ float bf_lo(unsigned w) { return __uint_as_float(w << 16); }
__device__ __forceinline__ float bf_hi(unsigned w) { return __uint_as_float(w & 0xffff0000u); }
__device__ __forceinline__ float wave_sum(float v) {
#pragma unroll
    for (int o = 1; o < 64; o <<= 1) v += __shfl_xor(v, o);
    return v;
}

#define XB_TMO      128
#define XB_XCNT(j)  (256  + 64 * (j))
#define XB_XSUB(j)  (1280 + 64 * (j))
#define XB_XGEN(j)  (2304 + 64 * (j))
#define XB_TOP      3328
#define XB_TOPGEN   3392
#define XCD_BAR_WORDS 3456
#define XB_SPIN_CAP (1u << 18)
__device__ __forceinline__ unsigned xb_ld(unsigned* p)              { return __hip_atomic_load(p, __ATOMIC_RELAXED, __HIP_MEMORY_SCOPE_AGENT); }
__device__ __forceinline__ unsigned xb_add(unsigned* p, unsigned v) { return __hip_atomic_fetch_add(p, v, __ATOMIC_RELAXED, __HIP_MEMORY_SCOPE_AGENT); }
__device__ __forceinline__ unsigned xb_xcc_id() { return (unsigned)__builtin_amdgcn_s_getreg((3 << 11) | 20) & 0xFu; }
#define XB_SPIN(cond, bar) do { unsigned _sp = 0; while (cond) { __builtin_amdgcn_s_sleep(1); \
    if ((++_sp & 255u) == 0u) { if (xb_ld(&(bar)[XB_TMO])) break; if (_sp > XB_SPIN_CAP) { atomicAdd(&(bar)[XB_TMO], 1u); break; } } } } while (0)
struct XcdBarrier { unsigned* bar; unsigned x; volatile LAS unsigned* st; };
__device__ __forceinline__ XcdBarrier xcd_barrier_post(unsigned* bar, volatile LAS unsigned* st) {
    XcdBarrier b; b.bar = bar; b.x = xb_xcc_id(); b.st = st;
    if (threadIdx.x == 0) (void)xb_add(&bar[XB_XCNT(b.x)], 1u);
    return b;
}
__device__ __forceinline__ void xcd_barrier_complete(unsigned* bar, unsigned x, unsigned& nloc, unsigned& nx) {
    const unsigned G = gridDim.x * gridDim.y * gridDim.z;
    unsigned sum, cnt, mine, sp = 0u;
    for (;;) {
        sum = 0u; cnt = 0u; mine = 0u;
#pragma unroll
        for (unsigned j = 0; j < 16; ++j) { const unsigned c = xb_ld(&bar[XB_XCNT(j)]); sum += c; cnt += (c > 0u) ? 1u : 0u; mine = (j == x) ? c : mine; }
        if (sum == G) break;
        __builtin_amdgcn_s_sleep(1);
        if ((++sp & 255u) == 0u) { if (xb_ld(&bar[XB_TMO])) break; if (sp > XB_SPIN_CAP) { atomicAdd(&bar[XB_TMO], 1u); break; } }
    }
    nloc = mine > 0u ? mine : 1u; nx = cnt > 0u ? cnt : 1u;
}
__device__ __forceinline__ void xcd_barrier(const XcdBarrier& b) {
    asm volatile("s_waitcnt vmcnt(0)" ::: "memory");
    __syncthreads();
    if (threadIdx.x == 0) {
        unsigned* bar = b.bar;
        __builtin_amdgcn_s_waitcnt(0);
        unsigned nloc = b.st[0], nx = b.st[1];
        if (nloc == 0u) { xcd_barrier_complete(bar, b.x, nloc, nx); b.st[0] = nloc; b.st[1] = nx; }
        const unsigned old = xb_add(&bar[XB_XSUB(b.x)], 1u);
        const unsigned gen = old / nloc;
        if (old + 1u == (gen + 1u) * nloc) {
            __builtin_amdgcn_fence(__ATOMIC_RELEASE, "agent");
            asm volatile("s_waitcnt vmcnt(0)" ::: "memory");
            const unsigned og = xb_add(&bar[XB_TOP], 1u);
            const unsigned tg = og / nx;
            if (og + 1u == (tg + 1u) * nx) xb_add(&bar[XB_TOPGEN], 1u);
            else XB_SPIN(xb_ld(&bar[XB_TOPGEN]) == tg, bar);
            __builtin_amdgcn_fence(__ATOMIC_ACQUIRE, "agent");
            xb_add(&bar[XB_XGEN(b.x)], 1u);
            asm volatile("s_waitcnt vmcnt(0)" ::: "memory");
        } else {
            XB_SPIN(xb_ld(&bar[XB_XGEN(b.x)]) == gen, bar);
            __builtin_amdgcn_fence(__ATOMIC_ACQUIRE, "agent");
            asm volatile("s_waitcnt vmcnt(0)" ::: "memory");
        }
    }
    __syncthreads();
}

#ifndef TPROBE
#define TPROBE 0
#endif
#define TP_MULT 4
#define TP_BEGIN(id) long tp_t0_##id = 0; if (TPROBE == (id)) { tp_t0_##id = (long)__builtin_amdgcn_s_memtime(); }
#define TP_END(id) if (TPROBE == (id)) { tacc += (long)__builtin_amdgcn_s_memtime() - tp_t0_##id; }
namespace pg8 {
constexpr int BM = 256, BK = 64, HALF = 128, HTB = HALF * BK * 2, STAGE_BYTES = 8 * HTB;
__host__ __device__ __forceinline__ int lds_byte(int r, int c) { const int st = (r >> 4) * 2 + (c >> 5), rr = r & 15, cc = c & 31, ob = rr * 64 + cc * 2; return st * 1024 + (ob ^ (((ob >> 9) & 1) << 5)); }
__host__ __device__ __forceinline__ void stage_rc(int b, int& R, int& C) { const int st = b / 1024, sb = b % 1024, swz = sb ^ (((sb >> 9) & 1) << 5); R = (st >> 1) * 16 + swz / 64; C = (st & 1) * 32 + (swz % 64) / 2; }
__host__ __device__ __forceinline__ int perm32(int rho) { const int n = rho >> 4, i = rho & 15; return 8 * (i >> 2) + 4 * n + (i & 3); }

typedef int i32x8 __attribute__((ext_vector_type(8)));
typedef int i32x4 __attribute__((ext_vector_type(4)));
__device__ __forceinline__ i32x8 cat8(bf16x8 lo, bf16x8 hi) { const i32x4 a = __builtin_bit_cast(i32x4, lo), b = __builtin_bit_cast(i32x4, hi); return (i32x8){a[0], a[1], a[2], a[3], b[0], b[1], b[2], b[3]}; }
struct Unit { int pm, pn, e; };

template <class Epi, class Sched, bool ALIGN_EPI, bool F8 = false>
__device__ __forceinline__ void gemm_phase(LAS unsigned char* lds, const int K, const Sched& S, const Epi& E, long& tacc) {
    const int tid = fresh_tid(), wid = __builtin_amdgcn_readfirstlane(tid >> 6), lane = tid & 63, wr = wid >> 2, wc = wid & 3, fr = lane & 15, fq = lane >> 4;
    const int nt = F8 ? K / (2 * BK) : K / BK;
    const int rowb = F8 ? K : 2 * K;
    int Rp[2]; unsigned voffA[2], voffB[2];
#pragma unroll
    for (int i = 0; i < 2; ++i) { int R, C; stage_rc(tid * 16 + i * 8192, R, C); Rp[i] = R; const int Rb = Epi::PERM ? ((R & ~31) + perm32(R & 31)) : R;
        voffA[i] = Sched::GATHER ? (unsigned)C * 2u : (unsigned)(R * rowb + C * 2); voffB[i] = (unsigned)(Rb * rowb + C * 2); }
    const size_t kstep = (size_t)(BK * 2);
    const size_t hstep = (size_t)HALF * rowb;
    const unsigned ldsw = (unsigned)wid * 1024u;
    const int aoff = lds_byte(wr * 64 + fr, fq * 8), boff = lds_byte(wc * 32 + fr, fq * 8);
#define PG8_SA(b, h) (((b) * 2 + (h)) * HTB)
#define PG8_SB(b, h) ((4 + (b) * 2 + (h)) * HTB)
#define PG8_STAGE(bufoff, gbase, v0, v1) do { \
        __builtin_amdgcn_global_load_lds((const unsigned*)((const char*)(gbase) + (v0)), (LAS unsigned*)(lds + (bufoff) + ldsw), 16, 0, 0); \
        __builtin_amdgcn_global_load_lds((const unsigned*)((const char*)(gbase) + (v1)), (LAS unsigned*)(lds + (bufoff) + ldsw + 8192), 16, 0, 0); } while (0)
#define PG8_STAGE_A(bufoff, gbase, h) do { if constexpr (Sched::GATHER) { PG8_STAGE(bufoff, gbase, (unsigned)tok[h][0] * (unsigned)rowb + voffA[0], (unsigned)tok[h][1] * (unsigned)rowb + voffA[1]); } \
        else { PG8_STAGE(bufoff, (gbase) + (h) * hstep, voffA[0], voffA[1]); } } while (0)
#define PG8_LDA_(dst, b, h) do { if constexpr (F8) { _Pragma("unroll") for (int m = 0; m < 4; ++m) { const i32x4 lo_ = *(const LAS i32x4*)(lds + PG8_SA(b, h) + aoff + m * 2048), hi_ = *(const LAS i32x4*)(lds + PG8_SA(b, h) + aoff + m * 2048 + 1024); \
            dst##8[m] = __builtin_shufflevector(lo_, hi_, 0, 1, 2, 3, 4, 5, 6, 7); } } \
        else { _Pragma("unroll") for (int m = 0; m < 4; ++m) _Pragma("unroll") for (int k = 0; k < 2; ++k) dst[m][k] = *(const LAS bf16x8*)(lds + PG8_SA(b, h) + aoff + m * 2048 + k * 1024); } } while (0)
#define PG8_LDB_(dst, b, h) do { if constexpr (F8) { _Pragma("unroll") for (int n = 0; n < 2; ++n) { const i32x4 lo_ = *(const LAS i32x4*)(lds + PG8_SB(b, h) + boff + n * 2048), hi_ = *(const LAS i32x4*)(lds + PG8_SB(b, h) + boff + n * 2048 + 1024); \
            dst##8[n] = __builtin_shufflevector(lo_, hi_, 0, 1, 2, 3, 4, 5, 6, 7); } } \
        else { _Pragma("unroll") for (int n = 0; n < 2; ++n) _Pragma("unroll") for (int k = 0; k < 2; ++k) dst[n][k] = *(const LAS bf16x8*)(lds + PG8_SB(b, h) + boff + n * 2048 + k * 1024); } } while (0)
#define PG8_LDA(dst, b, h) PG8_LDA_(dst, b, h)
#define PG8_LDB(dst, b, h) PG8_LDB_(dst, b, h)
#define PG8_MMA(ai, bj, At, Bt) do { __builtin_amdgcn_s_setprio(1); \
        if constexpr (F8) { _Pragma("unroll") for (int m = 0; m < 4; ++m) _Pragma("unroll") for (int n = 0; n < 2; ++n) \
            acc[ai][bj][m][n] = __builtin_amdgcn_mfma_scale_f32_16x16x128_f8f6f4(Bt##8[n], At##8[m], acc[ai][bj][m][n], 0, 0, 0, 0x7f7f7f7f, 0, 0x7f7f7f7f); } \
        else { _Pragma("unroll") for (int m = 0; m < 4; ++m) _Pragma("unroll") for (int n = 0; n < 2; ++n) _Pragma("unroll") for (int k = 0; k < 2; ++k) \
            acc[ai][bj][m][n] = __builtin_amdgcn_mfma_f32_16x16x32_bf16(Bt[n][k], At[m][k], acc[ai][bj][m][n], 0, 0, 0); } \
        __builtin_amdgcn_s_setprio(0); } while (0)
#define PG8_WAIT_V(n) asm volatile("s_waitcnt vmcnt(" #n ")" ::: "memory")
#define PG8_WAIT_V8X(nrm) do { \
        if constexpr (Epi::NST == 8) asm volatile("v_cmp_ne_u32_e32 vcc, 0, %0\n\ts_cbranch_vccnz 1f\n\ts_waitcnt vmcnt(16)\n\ts_branch 2f\n1:\n\ts_waitcnt vmcnt(8)\n2:" :: "v"(nrm) : "memory", "vcc"); \
        else if constexpr (Epi::NST == 16) asm volatile("v_cmp_ne_u32_e32 vcc, 0, %0\n\ts_cbranch_vccnz 1f\n\ts_waitcnt vmcnt(24)\n\ts_branch 2f\n1:\n\ts_waitcnt vmcnt(8)\n2:" :: "v"(nrm) : "memory", "vcc"); \
        else { static_assert(Epi::NST == 32, "NST"); asm volatile("v_cmp_ne_u32_e32 vcc, 0, %0\n\ts_cbranch_vccnz 1f\n\ts_waitcnt vmcnt(40)\n\ts_branch 2f\n1:\n\ts_waitcnt vmcnt(8)\n2:" :: "v"(nrm) : "memory", "vcc"); } } while (0)
#define PG8_WAIT_L(n) asm volatile("s_waitcnt lgkmcnt(" #n ")" ::: "memory")
#define PG8_BAR __builtin_amdgcn_s_barrier()
#define PG8_SCHED __builtin_amdgcn_sched_barrier(0)
    Unit cur, nxt; int ui = 0;
    if (!S.next(0, cur)) return;
    f32x4 acc[2][2][4][2];
#pragma unroll
    for (int a = 0; a < 2; ++a)
#pragma unroll
        for (int b = 0; b < 2; ++b)
#pragma unroll
            for (int m = 0; m < 4; ++m)
#pragma unroll
                for (int n = 0; n < 2; ++n) acc[a][b][m][n] = (f32x4){0.f, 0.f, 0.f, 0.f};
    bf16x8 At[4][2], B0[2][2], B1[2][2]; i32x8 At8[4], B08[2], B18[2];
    int tok[2][2] = {{0, 0}, {0, 0}};
    if constexpr (Sched::GATHER) S.load_tok(cur, 0, Rp, tok);
    const char* cA = S.a_ptr(cur); const char* cB = S.b_ptr(cur);
    PG8_STAGE(PG8_SB(0, 0), cB, voffB[0], voffB[1]); PG8_STAGE(PG8_SB(0, 1), cB + hstep, voffB[0], voffB[1]); PG8_STAGE_A(PG8_SA(0, 0), cA, 0); PG8_STAGE_A(PG8_SA(0, 1), cA, 1);
    if (wr == 1) PG8_BAR;
    PG8_WAIT_V(2); PG8_BAR;
    PG8_STAGE(PG8_SB(1, 0), cB + kstep, voffB[0], voffB[1]); PG8_STAGE_A(PG8_SA(1, 0), cA + kstep, 0); PG8_STAGE(PG8_SB(1, 1), cB + hstep + kstep, voffB[0], voffB[1]);
    PG8_WAIT_V(6); PG8_BAR;
    for (;;) {
        if constexpr (Epi::PRE) E.pre(cur, wid, lane);
        const bool has_next = S.next(ui + 1, nxt);
        const char* nA = has_next ? S.a_ptr(nxt) : cA; const char* nB = has_next ? S.b_ptr(nxt) : cB;
        TP_BEGIN(40) long tpk_ = 0; if (TPROBE == Epi::TPK) tpk_ = (long)__builtin_amdgcn_s_memtime();
#pragma unroll 1
        for (int t = 0; t < nt; t += 2) {
            const bool last = (t == nt - 2); const int nrm = (t != 0 || ui == 0) ? 1 : 0;
            const char* a1 = cA + (size_t)(t + 1) * kstep;
            const char* a2 = last ? nA : cA + (size_t)(t + 2) * kstep; const char* b2 = last ? nB : cB + (size_t)(t + 2) * kstep;
            const char* a3 = a2 + kstep; const char* b3 = b2 + kstep;
            PG8_LDB(B0, 0, 0); PG8_LDB(B1, 0, 1); PG8_SCHED; PG8_LDA(At, 0, 0); PG8_STAGE_A(PG8_SA(1, 1), a1, 1);
            if constexpr (Sched::GATHER) { if (last && has_next) S.load_tok(nxt, ui + 1, Rp, tok); }
            PG8_WAIT_V8X(nrm); PG8_WAIT_L(0); PG8_BAR; PG8_MMA(0, 0, At, B0); PG8_MMA(0, 1, At, B1); PG8_BAR; PG8_SCHED;
            PG8_LDA(At, 0, 1); PG8_STAGE(PG8_SB(0, 0), b2, voffB[0], voffB[1]); PG8_STAGE(PG8_SB(0, 1), b2 + hstep, voffB[0], voffB[1]); PG8_STAGE_A(PG8_SA(0, 0), a2, 0);
            PG8_WAIT_V8X(nrm); PG8_WAIT_L(0); PG8_BAR; PG8_MMA(1, 0, At, B0); PG8_MMA(1, 1, At, B1); PG8_BAR; PG8_SCHED;
            PG8_LDB(B0, 1, 0); PG8_LDB(B1, 1, 1); PG8_SCHED; PG8_LDA(At, 1, 0); PG8_STAGE_A(PG8_SA(0, 1), a2, 1);
            PG8_WAIT_V(8); PG8_WAIT_L(0); PG8_BAR; PG8_MMA(0, 0, At, B0); PG8_MMA(0, 1, At, B1); PG8_BAR; PG8_SCHED;
            PG8_LDA(At, 1, 1); PG8_STAGE(PG8_SB(1, 0), b3, voffB[0], voffB[1]); PG8_STAGE(PG8_SB(1, 1), b3 + hstep, voffB[0], voffB[1]); PG8_STAGE_A(PG8_SA(1, 0), a3, 0);
            PG8_WAIT_V(8); PG8_WAIT_L(0); PG8_BAR; PG8_MMA(1, 0, At, B0); PG8_MMA(1, 1, At, B1); PG8_BAR; PG8_SCHED;
        }
        TP_END(40) if (TPROBE == Epi::TPK) tacc += (long)__builtin_amdgcn_s_memtime() - tpk_;
        TP_BEGIN(41) long tpe_ = 0; if (TPROBE == Epi::TPE) tpe_ = (long)__builtin_amdgcn_s_memtime();
        if constexpr (ALIGN_EPI) { if (wr == 0) PG8_BAR; }
        { int fr_ = fr, fq_ = fq; asm volatile("" : "+v"(fr_), "+v"(fq_));
          E(acc, cur, ui, wr, wc, fr_, fq_); }
        TP_END(41) if (TPROBE == Epi::TPE) tacc += (long)__builtin_amdgcn_s_memtime() - tpe_;
        if (!has_next) break;
#pragma unroll
        for (int a = 0; a < 2; ++a)
#pragma unroll
            for (int b = 0; b < 2; ++b)
#pragma unroll
                for (int m = 0; m < 4; ++m)
#pragma unroll
                    for (int n = 0; n < 2; ++n) acc[a][b][m][n] = (f32x4){0.f, 0.f, 0.f, 0.f};
        cur = nxt; cA = nA; cB = nB; ++ui;
        if constexpr (ALIGN_EPI) { if (wr == 1) PG8_BAR; }
    }
    PG8_WAIT_V(0);
    if constexpr (!ALIGN_EPI) { if (wr == 0) PG8_BAR; }
    PG8_BAR;
#undef PG8_SA
#undef PG8_SB
#undef PG8_STAGE
#undef PG8_STAGE_A
#undef PG8_LDA
#undef PG8_LDB
#undef PG8_LDA_
#undef PG8_LDB_
#undef PG8_MMA
#undef PG8_WAIT_V
#undef PG8_WAIT_V8X
#undef PG8_WAIT_L
#undef PG8_BAR
#undef PG8_SCHED
}

struct SchedDense {
    const char* A; const char* B; int nN, nUnits, G, vcu, K;
    __device__ __forceinline__ bool next(int i, Unit& u) const { const int L = i * G + vcu; if (L >= nUnits) return false; u.pm = L / nN; u.pn = L - u.pm * nN; u.e = 0; return true; }
    __device__ __forceinline__ const char* a_ptr(const Unit& u) const { return A + (size_t)u.pm * BM * K * 2; }
    __device__ __forceinline__ const char* b_ptr(const Unit& u) const { return B + (size_t)u.pn * BM * K * 2; }
    static constexpr bool GATHER = false;
    __device__ __forceinline__ void load_tok(const Unit&, int, const int (&)[2], int (&)[2][2]) const {}
};
struct SchedDenseG {
    const char* A; const char* B; int nN, nUnits, G, vcu, K;
    __device__ __forceinline__ bool next(int i, Unit& u) const { const int L = i * G + vcu; if (L >= nUnits) return false; u.pm = L / nN; u.pn = L - u.pm * nN; u.e = 0; return true; }
    __device__ __forceinline__ const char* a_ptr(const Unit&) const { return A; }
    __device__ __forceinline__ const char* b_ptr(const Unit& u) const { return B + (size_t)u.pn * BM * K; }
    static constexpr bool GATHER = true;
    __device__ __forceinline__ void load_tok(const Unit& u, int, const int (&Rp)[2], int (&tok)[2][2]) const {
#pragma unroll
        for (int h = 0; h < 2; ++h)
#pragma unroll
            for (int i = 0; i < 2; ++i) tok[h][i] = u.pm * BM + h * HALF + Rp[i];
    }
};
__device__ __forceinline__ int find_expert(const LAS int* blk, int rb) { int e = 0;
#pragma unroll
    for (int j = 1; j < NEXP; ++j) e += (rb >= blk[j]) ? 1 : 0;
    return e; }
struct SchedMoe1 {
    const char* A; const char* W; const LAS int* blk; const LAS int* idx; int nUnits, G, vcu;
    __device__ __forceinline__ bool next(int i, Unit& u) const { const int L = i * G + vcu; if (L >= nUnits) return false; u.pm = L >> 3; u.pn = L & 7; u.e = find_expert(blk, u.pm); return true; }
    __device__ __forceinline__ const char* a_ptr(const Unit&) const { return A; }
    __device__ __forceinline__ const char* b_ptr(const Unit& u) const { return W + ((size_t)u.e * 2048 + (size_t)u.pn * 256) * DM; }
    static constexpr bool GATHER = true;
    __device__ __forceinline__ void load_tok(const Unit&, int ui, const int (&Rp)[2], int (&tok)[2][2]) const {
#pragma unroll
        for (int h = 0; h < 2; ++h)
#pragma unroll
            for (int i = 0; i < 2; ++i) tok[h][i] = idx[ui * 256 + h * HALF + Rp[i]];
    }
};
struct SchedMoe2 {
    const char* A; const char* W; const LAS int* blk; int nUnits, G, vcu;
    __device__ __forceinline__ bool next(int i, Unit& u) const { const int L = i * G + vcu; if (L >= nUnits) return false; u.pm = L >> 2; u.pn = L & 3; u.e = find_expert(blk, u.pm); return true; }
    __device__ __forceinline__ const char* a_ptr(const Unit&) const { return A; }
    __device__ __forceinline__ const char* b_ptr(const Unit& u) const { return W + ((size_t)u.e * 1024 + (size_t)u.pn * 256) * DM; }
    static constexpr bool GATHER = true;
    __device__ __forceinline__ void load_tok(const Unit& u, int, const int (&Rp)[2], int (&tok)[2][2]) const {
#pragma unroll
        for (int h = 0; h < 2; ++h)
#pragma unroll
            for (int i = 0; i < 2; ++i) tok[h][i] = u.pm * BM + h * HALF + Rp[i];
    }
};

struct EpiInProj {
    static constexpr bool PERM = true, PRE = false; static constexpr int NST = 16; static constexpr int TPK = 46, TPE = 47;
    bf16_t* QKV; const float* rope; unsigned* kn; float ws;
    __device__ __forceinline__ void operator()(const f32x4 (&acc)[2][2][4][2], const Unit& u, int, int wr, int wc, int fr, int fq) const {
        const int t = u.pn >> 1; bf16_t* base = QKV + (size_t)t * NTOK * 512;
        const float sc = (t == 0 || t == 3) ? QSCALE : 1.0f;
        const bool dorope = (t < 2) && ((wc & 1) == 0);
        const int col0 = (u.pn & 1) * 256 + wc * 32 + 8 * fq;
        const float sgn = (fq == 0) ? -1.0f : 1.0f; const bool rl = fq < 2;
        float kmx0 = 0.f, kmx1 = 0.f;
#pragma unroll
        for (int ai = 0; ai < 2; ++ai)
#pragma unroll
            for (int m = 0; m < 4; ++m) {
                const int row = u.pm * BM + ai * HALF + wr * 64 + m * 16 + fr;
                f32x4 cs0 = {1.f, 1.f, 1.f, 1.f}, cs1 = cs0, sn0 = {0.f, 0.f, 0.f, 0.f}, sn1 = sn0;
                if (dorope) { const f32x4* rp = (const f32x4*)(rope + (size_t)row * 16); cs0 = rp[0]; cs1 = rp[1]; sn0 = rp[2]; sn1 = rp[3]; }
#pragma unroll
                for (int bj = 0; bj < 2; ++bj) {
                    f32x4 v0 = acc[ai][bj][m][0] * ws, v1 = acc[ai][bj][m][1] * ws;
                    if (dorope) {
#pragma unroll
                        for (int i = 0; i < 4; ++i) { const float p0 = __shfl_xor(v0[i], 16), p1 = __shfl_xor(v1[i], 16);
                            const float r0 = v0[i] * cs0[i] + sgn * p0 * sn0[i], r1 = v1[i] * cs1[i] + sgn * p1 * sn1[i];
                            v0[i] = rl ? r0 : v0[i]; v1[i] = rl ? r1 : v1[i]; }
                    }
                    v0 = v0 * sc; v1 = v1 * sc;
                    if (t == 4) { float ss = (v0[0] * v0[0] + v0[1] * v0[1]) + (v0[2] * v0[2] + v0[3] * v0[3]) + (v1[0] * v1[0] + v1[1] * v1[1]) + (v1[2] * v1[2] + v1[3] * v1[3]);
                        ss += __shfl_xor(ss, 16); ss += __shfl_xor(ss, 32); if (bj == 0) kmx0 = fmaxf(kmx0, ss); else kmx1 = fmaxf(kmx1, ss); }
                    u32x4 w; w.x = cvt_pk_bf16(v0[0], v0[1]); w.y = cvt_pk_bf16(v0[2], v0[3]); w.z = cvt_pk_bf16(v1[0], v1[1]); w.w = cvt_pk_bf16(v1[2], v1[3]);
                    *(u32x4*)(base + (size_t)row * 512 + col0 + bj * HALF) = w;
                }
            }
        if (t == 4) {
#pragma unroll
            for (int bj = 0; bj < 2; ++bj) { float v = (bj == 0) ? kmx0 : kmx1;
#pragma unroll
                for (int o = 1; o < 16; o <<= 1) v = fmaxf(v, __shfl_xor(v, o));
                unsigned* const kp = kn + (((u.pm >> 4) * 8 + (u.pn & 1) * 4 + bj * 2 + (wc >> 1)) * 2 + (wc & 1));
                if (fr == 0 && fq == 0) __hip_atomic_fetch_max(kp, __float_as_uint(v), __ATOMIC_RELAXED, __HIP_MEMORY_SCOPE_AGENT); }
        }
    }
};
struct EpiOutProj {
    static constexpr bool PERM = false, PRE = false; static constexpr int NST = 32; static constexpr int TPK = 48, TPE = 49;
    const float* xin; float* xout; const float* g1; float ws;
    __device__ __forceinline__ void operator()(const f32x4 (&acc)[2][2][4][2], const Unit& u, int, int wr, int wc, int fr, int fq) const {
        const int b = u.pm >> 4; const int col0 = u.pn * BM + wc * 32 + 4 * fq;
        f32x4 gv[2][2];
#pragma unroll
        for (int bj = 0; bj < 2; ++bj)
#pragma unroll
            for (int n = 0; n < 2; ++n) gv[bj][n] = *(const f32x4*)(g1 + (size_t)b * 6144 + col0 + bj * HALF + n * 16) * ws;
#pragma unroll
        for (int ai = 0; ai < 2; ++ai)
#pragma unroll
            for (int m = 0; m < 4; ++m) { const size_t off = (size_t)(u.pm * BM + ai * HALF + wr * 64 + m * 16 + fr) * DM + col0;
#pragma unroll
                for (int bj = 0; bj < 2; ++bj)
#pragma unroll
                    for (int n = 0; n < 2; ++n) { const f32x4 xi = *(const f32x4*)(xin + off + bj * HALF + n * 16); *(f32x4*)(xout + off + bj * HALF + n * 16) = xi + gv[bj][n] * acc[ai][bj][m][n]; }
            }
    }
};
struct EpiMoe1 {
    static constexpr bool PERM = true, PRE = true; static constexpr int NST = 8; static constexpr int TPK = 44, TPE = 45;
    unsigned char* HID; const float* b1; LAS float* biasl;
    __device__ __forceinline__ void pre(const Unit& u, int wid, int lane) const {
        const float* g = b1 + (size_t)u.e * 2048 + u.pn * HALF + ((lane < 32) ? 4 * lane : 1024 + 4 * (lane - 32));
        __builtin_amdgcn_global_load_lds((const unsigned*)g, (LAS unsigned*)(biasl + wid * 256), 16, 0, 0);
    }
    __device__ __forceinline__ void operator()(const f32x4 (&acc)[2][2][4][2], const Unit& u, int, int wr, int wc, int fr, int fq) const {
        const int wid = wr * 4 + wc; const int hl = wc * 32 + 8 * fq; const int hc = u.pn * HALF + hl; const LAS float* bb = biasl + wid * 256 + hl;
        const f32x4 bg0 = *(const LAS f32x4*)(bb), bg1 = *(const LAS f32x4*)(bb + 4), bu0 = *(const LAS f32x4*)(bb + 128), bu1 = *(const LAS f32x4*)(bb + 132);
#pragma unroll
        for (int ai = 0; ai < 2; ++ai)
#pragma unroll
            for (int m = 0; m < 4; ++m) {
                const size_t row = (size_t)u.pm * BM + ai * HALF + wr * 64 + m * 16 + fr;
                float o[8];
#pragma unroll
                for (int n = 0; n < 2; ++n) { const f32x4 g = acc[ai][0][m][n] * 0.03125f + (n ? bg1 : bg0), up = acc[ai][1][m][n] * 0.03125f + (n ? bu1 : bu0);
#pragma unroll
                    for (int i = 0; i < 4; ++i) { const float gt = fminf(g[i], 7.0f), uu = fminf(fmaxf(up[i], -7.0f), 7.0f);
                        const float sg = __builtin_amdgcn_rcpf(1.0f + __builtin_amdgcn_exp2f(-1.702f * LOG2E * gt)); o[n * 4 + i] = (uu + 1.0f) * gt * sg; } }
                u32x2 w; w.x = pack4_fp8(o[0], o[1], o[2], o[3]); w.y = pack4_fp8(o[4], o[5], o[6], o[7]);
                *(u32x2*)(HID + row * DM + hc) = w;
            }
    }
};
struct EpiMoe2 {
    static constexpr bool PERM = true, PRE = true; static constexpr int NST = 16; static constexpr int TPK = 42, TPE = 43;
    bf16_t* Y; const float* b2; const LAS int* aidx; LAS float* biasl;
    __device__ __forceinline__ void pre(const Unit& u, int wid, int lane) const {
        __builtin_amdgcn_global_load_lds((const unsigned*)(b2 + (size_t)u.e * 1024 + u.pn * BM + 4 * lane), (LAS unsigned*)(biasl + wid * 256), 16, 0, 0);
    }
    __device__ __forceinline__ void operator()(const f32x4 (&acc)[2][2][4][2], const Unit& u, int ui, int wr, int wc, int fr, int fq) const {
        const int wid = wr * 4 + wc; const int cl = wc * 32 + 8 * fq; const int col0 = u.pn * BM + cl; const LAS float* bb = biasl + wid * 256 + cl;
        f32x4 bv[2][2];
#pragma unroll
        for (int bj = 0; bj < 2; ++bj)
#pragma unroll
            for (int n = 0; n < 2; ++n) bv[bj][n] = *(const LAS f32x4*)(bb + bj * HALF + 4 * n);
#pragma unroll
        for (int ai = 0; ai < 2; ++ai)
#pragma unroll
            for (int m = 0; m < 4; ++m) {
                const int aid = aidx[ui * 256 + ai * HALF + wr * 64 + m * 16 + fr];
#pragma unroll
                for (int bj = 0; bj < 2; ++bj) { const f32x4 v0 = acc[ai][bj][m][0] * 0.03125f + bv[bj][0], v1 = acc[ai][bj][m][1] * 0.03125f + bv[bj][1];
                    u32x4 w; w.x = cvt_pk_bf16(v0[0], v0[1]); w.y = cvt_pk_bf16(v0[2], v0[3]); w.z = cvt_pk_bf16(v1[0], v1[1]); w.w = cvt_pk_bf16(v1[2], v1[3]);
                    *(u32x4*)(Y + (size_t)aid * DM + col0 + bj * HALF) = w; }
            }
    }
};
}

namespace att {
constexpr int STG_F = 16384, STG_D = 32768;
constexpr int LDS_NCK = 98304;
typedef LAS const char* lds_cptr;
typedef short v4i16_t __attribute__((ext_vector_type(4)));
typedef __bf16 bf16x2_t __attribute__((ext_vector_type(2)));
__device__ __forceinline__ void glds16(const void* gsrc, unsigned lds_dst) { unsigned keep;
    asm volatile("s_mov_b32 %0, m0\n\ts_mov_b32 m0, %2\n\ts_nop 0\n\tglobal_load_lds_dwordx4 %1, off\n\ts_mov_b32 m0, %0" : "=&s"(keep) : "v"(gsrc), "s"(lds_dst) : "memory"); }
__device__ __forceinline__ unsigned cvtpk(float lo, float hi) { f32x2 v = {lo, hi}; bf16x2_t b = __builtin_convertvector(v, bf16x2_t); return __builtin_bit_cast(unsigned, b); }
__device__ __forceinline__ s16x4 vtr(lds_cptr p) { return __builtin_bit_cast(s16x4, __builtin_amdgcn_ds_read_tr16_b64_v4i16((LAS v4i16_t*)p)); }
__device__ __forceinline__ float swapmax(float m) { auto rr = __builtin_amdgcn_permlane32_swap(__float_as_uint(m), __float_as_uint(m), false, false); return fmaxf(__uint_as_float(rr[0]), __uint_as_float(rr[1])); }
__device__ __forceinline__ float swapsum(float m) { auto rr = __builtin_amdgcn_permlane32_swap(__float_as_uint(m), __float_as_uint(m), false, false); return __uint_as_float(rr[0]) + __uint_as_float(rr[1]); }
__device__ __forceinline__ u32x4 widen_pair(u32x2 a, u32x2 b) {
    auto r0 = __builtin_amdgcn_permlane32_swap(a.x, b.x, false, false); auto r1 = __builtin_amdgcn_permlane32_swap(a.y, b.y, false, false);
    return (u32x4){r0[0], r1[0], r0[1], r1[1]};
}
#define ATT_WAIT_BAR(N) asm volatile("s_waitcnt vmcnt(" #N ") lgkmcnt(0)\n\ts_barrier" ::: "memory")
#define ATT_BAR() asm volatile("s_waitcnt lgkmcnt(0)\n\ts_barrier" ::: "memory")

__device__ __forceinline__ float max3f(float a, float b, float c) { float r; asm("v_max3_f32 %0, %1, %2, %3" : "=v"(r) : "v"(a), "v"(b), "v"(c)); return r; }
template <int NO, bool REL>
__device__ __forceinline__ void softmax_tile(f32x16& p0, f32x16& p1, float& m, float& l, f32x16 (&o)[NO], u32x4 (&pw)[4], f32x16& negm, bool first) {
    float mx = max3f(p0[0], p1[0], p0[1]);
    mx = max3f(mx, p1[1], p0[2]); mx = max3f(mx, p1[2], p0[3]); mx = max3f(mx, p1[3], p0[4]); mx = max3f(mx, p1[4], p0[5]); mx = max3f(mx, p1[5], p0[6]); mx = max3f(mx, p1[6], p0[7]);
    float my = max3f(p1[7], p0[8], p1[8]);
    my = max3f(my, p0[9], p1[9]); my = max3f(my, p0[10], p1[10]); my = max3f(my, p0[11], p1[11]); my = max3f(my, p0[12], p1[12]); my = max3f(my, p0[13], p1[13]); my = max3f(my, p0[14], p1[14]);
    mx = max3f(mx, my, p0[15]); mx = fmaxf(mx, p1[15]);
    mx = swapmax(mx);
    if constexpr (REL) {
        if (first || __any(mx > 8.0f)) {
            const float dl = first ? mx : fmaxf(mx, 0.f); const float al = __builtin_amdgcn_exp2f(-dl); m += dl; l *= al;
#pragma unroll
            for (int r = 0; r < 16; ++r) { p0[r] -= dl; p1[r] -= dl; negm[r] = -m; }
#pragma unroll
            for (int d = 0; d < NO; ++d)
#pragma unroll
                for (int r = 0; r < 16; ++r) o[d][r] *= al;
        }
    } else {
        if (__any(mx > m + 8.0f)) {
            const float mn = fmaxf(m, mx); const float al = __builtin_amdgcn_exp2f(m - mn); m = mn; l *= al;
#pragma unroll
            for (int d = 0; d < NO; ++d)
#pragma unroll
                for (int r = 0; r < 16; ++r) o[d][r] *= al;
        }
#pragma unroll
        for (int r = 0; r < 16; ++r) { p0[r] -= m; p1[r] -= m; }
    }
    float ls0 = 0.f, ls1 = 0.f;
#pragma unroll
    for (int r = 0; r < 16; ++r) { p0[r] = __builtin_amdgcn_exp2f(p0[r]); p1[r] = __builtin_amdgcn_exp2f(p1[r]); ls0 += p0[r]; ls1 += p1[r]; }
    l += ls0 + ls1;
    pw[0] = (u32x4){cvtpk(p0[0], p0[1]), cvtpk(p0[2], p0[3]), cvtpk(p0[4], p0[5]), cvtpk(p0[6], p0[7])};
    pw[1] = (u32x4){cvtpk(p0[8], p0[9]), cvtpk(p0[10], p0[11]), cvtpk(p0[12], p0[13]), cvtpk(p0[14], p0[15])};
    pw[2] = (u32x4){cvtpk(p1[0], p1[1]), cvtpk(p1[2], p1[3]), cvtpk(p1[4], p1[5]), cvtpk(p1[6], p1[7])};
    pw[3] = (u32x4){cvtpk(p1[8], p1[9]), cvtpk(p1[10], p1[11]), cvtpk(p1[12], p1[13]), cvtpk(p1[14], p1[15])};
}
#define ATT_SBAR() __builtin_amdgcn_sched_barrier(0)
struct VFrag { s16x4 lo[4], hi[4]; };
__device__ __forceinline__ void vload(VFrag& f, lds_cptr vp, int d) {
#pragma unroll
    for (int ks = 0; ks < 4; ++ks) { f.lo[ks] = vtr(vp + d * 4096 + ks * 1024); f.hi[ks] = vtr(vp + d * 4096 + ks * 1024 + 512); }
}
__device__ __forceinline__ void pv_block(f32x16& o, const VFrag& f, const u32x4 (&pw)[4]) {
#pragma unroll
    for (int ks = 0; ks < 4; ++ks) {
        const bf16x8 vf = (bf16x8){f.lo[ks][0], f.lo[ks][1], f.lo[ks][2], f.lo[ks][3], f.hi[ks][0], f.hi[ks][1], f.hi[ks][2], f.hi[ks][3]};
        o = __builtin_amdgcn_mfma_f32_32x32x16_bf16(vf, __builtin_bit_cast(bf16x8, pw[ks]), o, 0, 0, 0);
    }
}
__device__ __forceinline__ void kload(bf16x8 (&kf)[8], lds_cptr kb, int hi, int sw) {
#pragma unroll
    for (int d0 = 0; d0 < 4; ++d0) { kf[2 * d0] = *(const LAS bf16x8*)(kb + d0 * 2048); kf[2 * d0 + 1] = *(const LAS bf16x8*)(kb + d0 * 2048 + 512); }
}
__device__ __forceinline__ void qk_mma(f32x16& p0, f32x16& p1, const bf16x8 (&kf)[8], const bf16x8 (&qr)[4]) {
#pragma unroll
    for (int d0 = 0; d0 < 4; ++d0) {
        p0 = __builtin_amdgcn_mfma_f32_32x32x16_bf16(kf[2 * d0], qr[d0], p0, 0, 0, 0);
        p1 = __builtin_amdgcn_mfma_f32_32x32x16_bf16(kf[2 * d0 + 1], qr[d0], p1, 0, 0, 0);
    }
}

template <int PV, bool F8O>
__device__ __forceinline__ void fox_unit(int b, int h, int qb, const bf16_t* FQ, const bf16_t* FK, const bf16_t* FV, const float* NCK, const unsigned* KN, bf16_t* AO, char* shm) {
    const int tid = fresh_tid(), lane = tid & 63, r32 = lane & 31, hi = lane >> 5; const int wid = __builtin_amdgcn_readfirstlane(tid >> 6);
    const long rowbase = (long)b * SEQ; const int q0 = qb * 256;
    const int NT = 4 * (qb + 1), tl = 4 * qb + (wid >> 1), i0 = NT - 1 - tl;
    const unsigned lds0 = (unsigned)(uintptr_t)shm;
    const lds_cptr shm3 = (lds_cptr)shm;
    LAS float* nckl = (LAS float*)(shm3 + LDS_NCK);
    LAS unsigned* vote = (LAS unsigned*)(shm3 + L_VOTE);
    const int krow = wid * 8 + (lane >> 3);
    const bf16_t* ksrc = FK + (rowbase + lane) * 512 + h * 64 + wid * 8;
    const bf16_t* vsrc = FV + (rowbase + 16 * (wid & 3) + (lane >> 2)) * 512 + h * 64 + (wid >> 2) * 32 + (lane & 3) * 8;
    const unsigned kdst = lds0 + wid * 1024, vdst = lds0 + 8192 + wid * 1024;
#define FOX_DMA(t, so) do { glds16(ksrc + (long)(t) * 64 * 512, (unsigned)__builtin_amdgcn_readfirstlane(kdst + (so))); glds16(vsrc + (long)(t) * 64 * 512, (unsigned)__builtin_amdgcn_readfirstlane(vdst + (so))); } while (0)
    FOX_DMA(NT - 1, 0); FOX_DMA(NT - 2, STG_F);
    { const f32x4* src = (const f32x4*)(NCK + (size_t)(b * 8 + h) * SEQ); const int n4 = 16 * NT;
      f32x4 c0 = {0.f, 0.f, 0.f, 0.f}, c1 = c0; if (tid < n4) c0 = src[tid]; if (tid + NTHR < n4) c1 = src[tid + NTHR];
      if (tid < n4) ((LAS f32x4*)nckl)[tid] = c0; if (tid + NTHR < n4) ((LAS f32x4*)nckl)[tid + NTHR] = c1; }
    const bf16_t* Qw = FQ + (rowbase + q0 + wid * 32 + r32) * 512 + h * 64;
    bf16x8 qr[4];
#pragma unroll
    for (int d0 = 0; d0 < 4; ++d0) qr[d0] = *(const bf16x8*)(Qw + d0 * 16 + hi * 8);
    const float kn2 = __uint_as_float(KN[(b * 8 + h) * 2]) + __uint_as_float(KN[(b * 8 + h) * 2 + 1]);
    asm volatile("" : "+v"(qr[0]), "+v"(qr[1]), "+v"(qr[2]), "+v"(qr[3]));
    float qn2 = 0.f;
#pragma unroll
    for (int d0 = 0; d0 < 4; ++d0) { const u32x4 w = __builtin_bit_cast(u32x4, qr[d0]);
#pragma unroll
        for (int j = 0; j < 4; ++j) { const float a = bf_lo(w[j]), c = bf_hi(w[j]); qn2 += a * a + c * c; } }
    qn2 = swapsum(qn2);
    const float Bq = sqrtf(qn2 * kn2) * 1.02f + 0.01f;
    const lds_cptr kp0 = shm3 + hi * 1024 + r32 * 16; const int ksw = 0;
    const lds_cptr vp0 = shm3 + 8192 + ((lane >> 4) & 1) * 32 + (lane & 3) * 8 + (4 * hi + ((lane & 15) >> 2)) * 64;
    float m = -1e30f, l = 0.f; f32x16 o[2]; o[0] = f32x16{}; o[1] = f32x16{};
    const int qrow = q0 + wid * 32 + r32;
    int so = 0, so2 = 2 * STG_F;
    for (int i = 0; i < NT; ++i) {
        const int t = NT - 1 - i;
        if (i + 1 < NT) ATT_WAIT_BAR(2); else ATT_WAIT_BAR(0);
        if (i > 0) {
            const LAS unsigned* vv = vote + ((i - 1) & 1) * 8; const u32x4 va4 = *(const LAS u32x4*)vv, vb4 = *(const LAS u32x4*)(vv + 4);
            if (((va4[0] | va4[1]) | (va4[2] | va4[3]) | (vb4[0] | vb4[1]) | (vb4[2] | vb4[3])) == 0u) break;
        }
        bf16x8 kf[8];
        if (i >= i0) kload(kf, kp0 + so, hi, ksw);
        if (i + 2 < NT) FOX_DMA(t - 2, so2);
        unsigned myvote = 1u;
        if (i >= i0) {
            f32x16 p0, p1; VFrag va, vb;
            const LAS float* nk = nckl + 64 * t + 4 * hi;
#pragma unroll
            for (int g = 0; g < 4; ++g) { const f32x4 a = *(const LAS f32x4*)(nk + 8 * g), c = *(const LAS f32x4*)(nk + 32 + 8 * g);
                p0[4 * g] = a[0]; p0[4 * g + 1] = a[1]; p0[4 * g + 2] = a[2]; p0[4 * g + 3] = a[3]; p1[4 * g] = c[0]; p1[4 * g + 1] = c[1]; p1[4 * g + 2] = c[2]; p1[4 * g + 3] = c[3]; }
            vload(va, vp0 + so, 0);
            ATT_SBAR();
            qk_mma(p0, p1, kf, qr);
            asm volatile("s_nop 15\n\ts_nop 7" : "+v"(p0), "+v"(p1));
            ATT_SBAR();
            if (i == i0) { const int kb = 64 * t + 4 * hi;
#pragma unroll
                for (int r = 0; r < 16; ++r) { const int kv = kb + (r & 3) + 8 * (r >> 2); if (kv > qrow) p0[r] = -INFINITY; if (kv + 32 > qrow) p1[r] = -INFINITY; } }
            u32x4 pw[4];
            softmax_tile<2, false>(p0, p1, m, l, o, pw, p0, false);
            ATT_SBAR();
            vload(vb, vp0 + so, 1);
            pv_block(o[0], va, pw);
            ATT_SBAR();
            pv_block(o[1], vb, pw);
            ATT_SBAR();
            myvote = (t > 0 && __any(Bq + nckl[64 * t - 1] - m > -48.0f)) ? 1u : 0u;
        }
        if (lane == 0) vote[(i & 1) * 8 + wid] = myvote;
        so = (so == 2 * STG_F) ? 0 : so + STG_F; so2 = (so2 == 2 * STG_F) ? 0 : so2 + STG_F;
    }
#undef FOX_DMA
    asm volatile("s_waitcnt vmcnt(0)" ::: "memory");
    ATT_BAR();
    l = swapsum(l);
    const float inv = __builtin_amdgcn_rcpf(l);
    if constexpr (F8O) {
        unsigned char* Ow = (unsigned char*)AO + (rowbase + qrow) * 1024 + 512 + h * 64 + 8 * hi;
#pragma unroll
        for (int d = 0; d < 2; ++d)
#pragma unroll
            for (int g = 0; g < 4; g += 2) {
                const unsigned wa = pack4_fp8(o[d][4 * g] * inv, o[d][4 * g + 1] * inv, o[d][4 * g + 2] * inv, o[d][4 * g + 3] * inv), wb = pack4_fp8(o[d][4 * g + 4] * inv, o[d][4 * g + 5] * inv, o[d][4 * g + 6] * inv, o[d][4 * g + 7] * inv);
                auto r = __builtin_amdgcn_permlane32_swap(wa, wb, false, false);
                *(u32x2*)(Ow + d * 32 + 8 * g) = (u32x2){r[0], r[1]}; }
    } else {
    bf16_t* Ow = AO + (rowbase + qrow) * 1024 + 512 + h * 64 + 8 * hi;
#pragma unroll
    for (int d = 0; d < 2; ++d)
#pragma unroll
        for (int g = 0; g < 4; g += 2) { u32x2 wa, wb;
            wa.x = cvt_pk_bf16(o[d][4 * g] * inv, o[d][4 * g + 1] * inv); wa.y = cvt_pk_bf16(o[d][4 * g + 2] * inv, o[d][4 * g + 3] * inv);
            wb.x = cvt_pk_bf16(o[d][4 * g + 4] * inv, o[d][4 * g + 5] * inv); wb.y = cvt_pk_bf16(o[d][4 * g + 6] * inv, o[d][4 * g + 7] * inv);
            *(u32x4*)(Ow + d * 32 + 8 * g) = widen_pair(wa, wb); }
    }
}

template <int PV, bool F8O>
__device__ __forceinline__ void diff_unit(int b, int h, int qb, const bf16_t* DQ, const bf16_t* DK, const bf16_t* DV, const float* subg, float lam, float post, bf16_t* AO, char* shm) {
    const int tid = fresh_tid(), lane = tid & 63, r32 = lane & 31, hi = lane >> 5; const int wid = __builtin_amdgcn_readfirstlane(tid >> 6);
    const int map = wid >> 2, wq = wid & 3;
    const long rowbase = (long)b * SEQ; const int q0 = qb * 128;
    const int NT = 2 * (qb + 1), tl = 2 * qb + (wq >> 1);
    const unsigned lds0 = (unsigned)(uintptr_t)shm;
    const lds_cptr shm3 = (lds_cptr)shm;
    const int qrow = q0 + wq * 32 + r32;
    const int krow = wid * 8 + (lane >> 3);
    const bf16_t* ksrc = DK + (rowbase + lane) * 512 + h * 128 + wid * 8;
    const bf16_t* vsrc = DV + (rowbase + 16 * (wid & 3) + (lane >> 2)) * 512 + h * 128 + (wid >> 2) * 32 + (lane & 3) * 8;
    const unsigned kdst = lds0 + wid * 1024, vdst = lds0 + 16384 + wid * 1024;
#define DIFF_DMA(t, so) do { glds16(ksrc + (long)(t) * 64 * 512, (unsigned)__builtin_amdgcn_readfirstlane(kdst + (so))); glds16(ksrc + (long)(t) * 64 * 512 + 64, (unsigned)__builtin_amdgcn_readfirstlane(kdst + 8192 + (so))); \
        glds16(vsrc + (long)(t) * 64 * 512, (unsigned)__builtin_amdgcn_readfirstlane(vdst + (so))); glds16(vsrc + (long)(t) * 64 * 512 + 64, (unsigned)__builtin_amdgcn_readfirstlane(vdst + 8192 + (so))); } while (0)
    if ((PV & 8) == 0) { DIFF_DMA(0, 0); DIFF_DMA(1, STG_D); }
    const bf16_t* Qw = DQ + (rowbase + qrow) * 512 + h * 128 + map * 64;
    bf16x8 qr[4];
#pragma unroll
    for (int d0 = 0; d0 < 4; ++d0) qr[d0] = *(const bf16x8*)(Qw + d0 * 16 + hi * 8);
    asm volatile("" : "+v"(qr[0]), "+v"(qr[1]), "+v"(qr[2]), "+v"(qr[3]));
    const lds_cptr kp0 = shm3 + map * 8192 + hi * 1024 + r32 * 16; const int ksw = 0;
    const lds_cptr vp0 = shm3 + 16384 + ((lane >> 4) & 1) * 32 + (lane & 3) * 8 + (4 * hi + ((lane & 15) >> 2)) * 64;
    float m = 0.f, l = 0.f; f32x16 o[4]; o[0] = f32x16{}; o[1] = f32x16{}; o[2] = f32x16{}; o[3] = f32x16{};
    f32x16 negm = f32x16{}; asm volatile("" : "+v"(negm));
    int so = 0, so2 = 2 * STG_D;
    for (int t = 0; t < NT; ++t) {
        if ((PV & 8) == 0) { if (t + 1 < NT) ATT_WAIT_BAR(4); else ATT_WAIT_BAR(0); } else ATT_BAR();
        bf16x8 kf[8];
        if ((PV & 4) == 0 && t <= tl) kload(kf, kp0 + so, hi, ksw);
        if ((PV & 8) == 0 && t + 2 < NT) DIFF_DMA(t + 2, so2);
        if (t <= tl) {
            f32x16 p0 = negm, p1 = negm; VFrag va, vb;
            if ((PV & 1) == 0) vload(va, vp0 + so, 0);
            ATT_SBAR();
            if ((PV & 4) == 0) qk_mma(p0, p1, kf, qr);
            asm volatile("s_nop 15\n\ts_nop 7" : "+v"(p0), "+v"(p1));
            ATT_SBAR();
            u32x4 pw[4];
            if ((PV & 2) == 0) softmax_tile<4, true>(p0, p1, m, l, o, pw, negm, t == 0); else { pw[0] = (u32x4){__float_as_uint(p0[0]), __float_as_uint(p0[1]), __float_as_uint(p1[0]), __float_as_uint(p1[1])}; pw[1] = pw[0]; pw[2] = pw[0]; pw[3] = pw[0]; }
            ATT_SBAR();
            if ((PV & 1) == 0) { vload(vb, vp0 + so, 1);
            pv_block(o[0], va, pw);
            ATT_SBAR();
            vload(va, vp0 + so, 2);
            pv_block(o[1], vb, pw);
            ATT_SBAR();
            vload(vb, vp0 + so, 3);
            pv_block(o[2], va, pw);
            ATT_SBAR();
            pv_block(o[3], vb, pw); } else { o[0][0] += __uint_as_float(pw[0][0]); o[1][0] += __uint_as_float(pw[1][1]); }
            ATT_SBAR();
        }
        so = (so == 2 * STG_D) ? 0 : so + STG_D; so2 = (so2 == 2 * STG_D) ? 0 : so2 + STG_D;
    }
#undef DIFF_DMA
    l = swapsum(l);
    const float inv = __builtin_amdgcn_rcpf(l);
    ATT_BAR();
    LAS float* xch = (LAS float*)shm3 + (wq * 64) * 64 + lane;
    if (map == 1) {
#pragma unroll
        for (int d = 0; d < 4; ++d)
#pragma unroll
            for (int r = 0; r < 16; ++r) xch[(d * 16 + r) * 64] = o[d][r] * inv;
    }
    ATT_BAR();
    if (map == 0) {
        float ss = 0.f;
#pragma unroll
        for (int d = 0; d < 4; ++d)
#pragma unroll
            for (int r = 0; r < 16; ++r) { const float a = o[d][r] * inv - lam * xch[(d * 16 + r) * 64]; o[d][r] = a; ss += a * a; }
        ss = swapsum(ss);
        const float rn = __builtin_amdgcn_rsqf(ss * (1.0f / 128.0f) + NORM_EPS) * post;
        if constexpr (F8O) {
            unsigned char* Ow = (unsigned char*)AO + (rowbase + qrow) * 1024 + h * 128 + 8 * hi;
#pragma unroll
            for (int d = 0; d < 4; ++d)
#pragma unroll
                for (int g = 0; g < 4; g += 2) { const f32x4 sa = *(const f32x4*)(subg + d * 32 + 8 * g + 4 * hi), sb = *(const f32x4*)(subg + d * 32 + 8 * g + 8 + 4 * hi);
                    const unsigned wa = pack4_fp8(o[d][4 * g] * rn * sa[0], o[d][4 * g + 1] * rn * sa[1], o[d][4 * g + 2] * rn * sa[2], o[d][4 * g + 3] * rn * sa[3]);
                    const unsigned wb = pack4_fp8(o[d][4 * g + 4] * rn * sb[0], o[d][4 * g + 5] * rn * sb[1], o[d][4 * g + 6] * rn * sb[2], o[d][4 * g + 7] * rn * sb[3]);
                    auto r = __builtin_amdgcn_permlane32_swap(wa, wb, false, false);
                    *(u32x2*)(Ow + d * 32 + 8 * g) = (u32x2){r[0], r[1]}; }
        } else {
        bf16_t* Ow = AO + (rowbase + qrow) * 1024 + h * 128 + 8 * hi;
#pragma unroll
        for (int d = 0; d < 4; ++d)
#pragma unroll
            for (int g = 0; g < 4; g += 2) { const f32x4 sa = *(const f32x4*)(subg + d * 32 + 8 * g + 4 * hi), sb = *(const f32x4*)(subg + d * 32 + 8 * g + 8 + 4 * hi);
                u32x2 wa, wb;
                wa.x = cvt_pk_bf16(o[d][4 * g] * rn * sa[0], o[d][4 * g + 1] * rn * sa[1]); wa.y = cvt_pk_bf16(o[d][4 * g + 2] * rn * sa[2], o[d][4 * g + 3] * rn * sa[3]);
                wb.x = cvt_pk_bf16(o[d][4 * g + 4] * rn * sb[0], o[d][4 * g + 5] * rn * sb[1]); wb.y = cvt_pk_bf16(o[d][4 * g + 6] * rn * sb[2], o[d][4 * g + 7] * rn * sb[3]);
                *(u32x4*)(Ow + d * 32 + 8 * g) = widen_pair(wa, wb); }
        }
    }
    ATT_BAR();
}
}

struct Args {
    const float* x; const float* c; const int* pos; const float* ada_w; const float* ada_b; const float* norm_mix; const float* norm_ffn; const float* w_in;
    const float* b_forget; const float* lq1; const float* lk1; const float* lq2; const float* lk2; const float* subln; const float* w_out; const float* router_w;
    const float* router_b; const float* w1; const float* b1; const float* w2; const float* b2; const float* final_norm;
    float* out; unsigned char* ws; int ph_lo, ph_hi;
};

__device__ __forceinline__ void transpose_item(const float* W, int ldw, int K, bf16_t* WT, int k0, int n0, int drow, LAS float* scr, int lane) {
    float ld_[32];
#pragma unroll
    for (int i = 0; i < 32; ++i) ld_[i] = W[(size_t)(k0 + 2 * i + (lane >> 5)) * ldw + n0 + (lane & 31)];
#pragma unroll
    for (int i = 0; i < 32; ++i) scr[(2 * i + (lane >> 5)) * 33 + (lane & 31)] = ld_[i];
    asm volatile("s_waitcnt lgkmcnt(0)" ::: "memory");
    const int c = lane & 7;
#pragma unroll
    for (int j = 0; j < 4; ++j) { const int n = (lane >> 3) + 8 * j; const LAS float* s = scr + (8 * c) * 33 + n;
        u32x4 o; o.x = cvt_pk_bf16(s[0 * 33], s[1 * 33]); o.y = cvt_pk_bf16(s[2 * 33], s[3 * 33]); o.z = cvt_pk_bf16(s[4 * 33], s[5 * 33]); o.w = cvt_pk_bf16(s[6 * 33], s[7 * 33]);
        *(u32x4*)(WT + (size_t)(drow + n) * K + k0 + 8 * c) = o; }
    asm volatile("s_waitcnt lgkmcnt(0)" ::: "memory");
}

__device__ __forceinline__ void transpose_item_f8(const float* W, int ldw, int K, unsigned char* WT, int k0, int n0, int drow, LAS float* scr, int lane) {
    float ld_[32];
#pragma unroll
    for (int i = 0; i < 32; ++i) ld_[i] = W[(size_t)(k0 + 2 * i + (lane >> 5)) * ldw + n0 + (lane & 31)];
#pragma unroll
    for (int i = 0; i < 32; ++i) scr[(2 * i + (lane >> 5)) * 33 + (lane & 31)] = ld_[i];
    asm volatile("s_waitcnt lgkmcnt(0)" ::: "memory");
    const int c = lane & 7;
#pragma unroll
    for (int j = 0; j < 4; ++j) { const int n = (lane >> 3) + 8 * j; const LAS float* s = scr + (8 * c) * 33 + n;
        u32x2 o; o.x = pack4_fp8(s[0 * 33] * 32.f, s[1 * 33] * 32.f, s[2 * 33] * 32.f, s[3 * 33] * 32.f); o.y = pack4_fp8(s[4 * 33] * 32.f, s[5 * 33] * 32.f, s[6 * 33] * 32.f, s[7 * 33] * 32.f);
        *(u32x2*)(WT + (size_t)(drow + n) * K + k0 + 8 * c) = o; }
    asm volatile("s_waitcnt lgkmcnt(0)" ::: "memory");
}

#define CB(j) (512 * ((j) >> 1) + 8 * lane + 4 * ((j) & 1))
template <bool F8OUT>
__device__ __forceinline__ void norm1_row(const f32x4 (&v)[4], const f32x4 (&gm)[4], const f32x4 (&sh)[4], const LAS float* wft, const float* bfor, bf16_t* xnrow, float* LF, int b, int s, int lane) {
    float ss = 0.f;
#pragma unroll
    for (int j = 0; j < 4; ++j) ss += (v[j][0] * v[j][0] + v[j][1] * v[j][1]) + (v[j][2] * v[j][2] + v[j][3] * v[j][3]);
    const float rstd = __builtin_amdgcn_rsqf(wave_sum(ss) * (1.0f / DM) + NORM_EPS);
    f32x4 hv[4];
#pragma unroll
    for (int j = 0; j < 4; ++j) hv[j] = v[j] * rstd * gm[j] + sh[j];
#pragma unroll
    for (int jj = 0; jj < 2; ++jj) { const f32x4 a = hv[2 * jj], c = hv[2 * jj + 1];
        if constexpr (F8OUT) { u32x2 w; w.x = pack4_fp8(a[0], a[1], a[2], a[3]); w.y = pack4_fp8(c[0], c[1], c[2], c[3]); *(u32x2*)((unsigned char*)xnrow + 512 * jj + 8 * lane) = w; }
        else { u32x4 w; w.x = cvt_pk_bf16(a[0], a[1]); w.y = cvt_pk_bf16(a[2], a[3]); w.z = cvt_pk_bf16(c[0], c[1]); w.w = cvt_pk_bf16(c[2], c[3]); *(u32x4*)(xnrow + 512 * jj + 8 * lane) = w; } }
    float a8[8];
#pragma unroll
    for (int hh = 0; hh < 8; ++hh) { float a = 0.f;
#pragma unroll
        for (int j = 0; j < 4; ++j) { const f32x4 w = *(const LAS f32x4*)(wft + hh * DM + CB(j)); a += (hv[j][0] * w[0] + hv[j][1] * w[1]) + (hv[j][2] * w[2] + hv[j][3] * w[3]); }
        a8[hh] = a; }
    float a4[4], a2[2], a1;
    { const bool up = (lane & 32) != 0;
#pragma unroll
      for (int i = 0; i < 4; ++i) { const float snd = up ? a8[i] : a8[i + 4], kp = up ? a8[i + 4] : a8[i]; a4[i] = kp + __shfl_xor(snd, 32); } }
    { const bool up = (lane & 16) != 0;
#pragma unroll
      for (int i = 0; i < 2; ++i) { const float snd = up ? a4[i] : a4[i + 2], kp = up ? a4[i + 2] : a4[i]; a2[i] = kp + __shfl_xor(snd, 16); } }
    { const bool up = (lane & 8) != 0; const float snd = up ? a2[0] : a2[1], kp = up ? a2[1] : a2[0]; a1 = kp + __shfl_xor(snd, 8); }
    a1 += __shfl_xor(a1, 4); a1 += __shfl_xor(a1, 2); a1 += __shfl_xor(a1, 1);
    if ((lane & 7) == 0) { const int hd = lane >> 3; const float z = a1 + bfor[hd];
        const float lf = (z >= 0.f) ? -log1pf(__expf(-z)) : (z - log1pf(__expf(z)));
        LF[(size_t)(b * 8 + hd) * SEQ + s] = lf; }
}

__global__ void __launch_bounds__(NTHR, 2) fwd_kernel(Args args) {
    extern __shared__ __attribute__((aligned(16))) unsigned char lds[];
    LAS unsigned char* L = (LAS unsigned char*)lds;
    int tid = threadIdx.x, lane = tid & 63, wave = __builtin_amdgcn_readfirstlane(tid >> 6);
#define FRESH_IDS() do { tid = fresh_tid(); lane = tid & 63; wave = __builtin_amdgcn_readfirstlane(tid >> 6); gw = vcu * NWAVES + wave; } while (0)
    const int G = gridDim.x; const int bx = blockIdx.x; const int vcu = (G % 8 == 0) ? (bx % 8) * (G / 8) + bx / 8 : bx;
#define WSPTRS() unsigned char* ws = args.ws; asm volatile("" : "+s"(ws)); \
    unsigned* ctl = (unsigned*)(ws + WS_CTL); (void)ctl; \
    bf16_t* WQ = (bf16_t*)(ws + WS_WQ); float* BQ = (float*)(ws + WS_BQ); (void)WQ; (void)BQ; \
    float* MOD = (float*)(ws + WS_MOD); float* RWT = (float*)(ws + WS_RWT); float* WFT = (float*)(ws + WS_WFT); float* ROPE = (float*)(ws + WS_ROPE); \
    float* NCK = (float*)(ws + WS_NCK); float* LF = (float*)(ws + WS_LF); float* GATES = (float*)(ws + WS_GATES); int* ROWL = (int*)(ws + WS_ROWL); \
    bf16_t* WIN = (bf16_t*)(ws + WS_WIN); bf16_t* WOUT = (bf16_t*)(ws + WS_WOUT); unsigned char* W1T = ws + WS_W1; unsigned char* W2T = ws + WS_W2; \
    bf16_t* XN = (bf16_t*)(ws + WS_XN); bf16_t* QKV = (bf16_t*)(ws + WS_QKV); bf16_t* AO = (bf16_t*)(ws + WS_AO); \
    float* X1 = (float*)(ws + WS_X1); float* X2 = (float*)(ws + WS_X2); unsigned char* XN2 = ws + WS_XN2; unsigned char* HID = ws + WS_HID; bf16_t* Y = (bf16_t*)(ws + WS_Y); \
    (void)MOD; (void)RWT; (void)WFT; (void)ROPE; (void)NCK; (void)LF; (void)GATES; (void)ROWL; (void)WIN; (void)WOUT; (void)W1T; (void)W2T; (void)XN; (void)QKV; (void)AO; (void)X1; (void)X2; (void)XN2; (void)HID; (void)Y
    for (int u = tid; u < 256; u += NTHR) ((LAS unsigned*)(L + MISC_OFF))[u] = 0u;
    __syncthreads();
#if MK_MULTI
#define GRID_BAR() do { } while (0)
#else
    XcdBarrier bar = xcd_barrier_post((unsigned*)(args.ws + WS_CTL) + CW_BAR, (volatile LAS unsigned*)(L + L_XBST));
#define GRID_BAR() xcd_barrier(bar)
#endif
    long tacc = 0;
    TP_BEGIN(30)
    const int lo = args.ph_lo, hi_ = args.ph_hi;
#ifndef PH_MASK
#define PH_MASK 0x1ff
#endif
#define IN(k) (lo <= (k) && (k) < hi_)
#define ON(j) (((PH_MASK) >> (j)) & 1)
#ifndef REP_MASK
#define REP_MASK 0
#endif
#define NREP(j) (1 + (((REP_MASK) >> (j)) & 1))
#define BOTH(k) (IN(k) && IN((k) + 1))
    int gw = vcu * NWAVES + wave; const int NGW = G * NWAVES;

    if (ON(0) && IN(0)) { TP_BEGIN(20)
        FRESH_IDS(); WSPTRS();
        for (int rep_ = 0; rep_ < NREP(0); ++rep_) {
        TP_BEGIN(31)
        {
            LAS float* cact = (LAS float*)(L + 73728);
            LAS float* part = (LAS float*)(L + 73728 + 32768);
            for (int i = tid; i < 8 * DM; i += NTHR) { const float cv = args.c[i]; cact[i] = cv / (1.0f + __expf(-cv)); }
            __syncthreads();
            for (int it = vcu; it < 256; it += G) {
                const int l = it >> 7, j0 = (it & 127) * 48; const bool on = lane < 48;
                const float* aw = args.ada_w + (size_t)l * DM * 6144 + j0 + (on ? lane : 0);
                float a8[8] = {0.f, 0.f, 0.f, 0.f, 0.f, 0.f, 0.f, 0.f};
                for (int kc = 0; kc < 4; ++kc) { const int kb = wave * 128 + kc * 32; float av[32];
#pragma unroll
                    for (int i = 0; i < 32; ++i) av[i] = aw[(size_t)(kb + i) * 6144];
#pragma unroll
                    for (int i = 0; i < 32; ++i)
#pragma unroll
                        for (int b = 0; b < 8; ++b) a8[b] += cact[b * DM + kb + i] * av[i]; }
#pragma unroll
                for (int b = 0; b < 8; ++b) part[(wave * 8 + b) * 64 + lane] = a8[b];
                __syncthreads();
                { const int b = tid >> 6; float s = 0.f;
#pragma unroll
                  for (int w = 0; w < 8; ++w) s += part[(w * 8 + b) * 64 + lane];
                  if (on) MOD[((size_t)l * 8 + b) * 6144 + j0 + lane] = s + args.ada_b[l * 6144 + j0 + lane]; }
                __syncthreads();
            }
        }
        TP_END(31) TP_BEGIN(32)
        {
            const int gt = vcu * NTHR + tid, NGT = G * NTHR;
            const double invf[8] = {1.0, 0.1939227432012558, 0.03760603070259094, 0.007292664609849453, 0.0014142135623842478, 0.00027424818836152554, 5.3182957344688475e-05, 1.0313385246263351e-05};
            for (int i = gt; i < NTOK * 8; i += NGT) { const int tok = i >> 3, j = i & 7;
                double iv = invf[0];
#pragma unroll
                for (int q = 1; q < 8; ++q) iv = (j == q) ? invf[q] : iv;
                double rev = (double)args.pos[tok] * iv * 0.15915494309189535; rev -= rint(rev); const float fr_ = (float)rev;
                ROPE[(size_t)tok * 16 + j] = __builtin_amdgcn_cosf(fr_); ROPE[(size_t)tok * 16 + 8 + j] = __builtin_amdgcn_sinf(fr_); }
            for (int i = gt; i < DEPTH * NEXP * DM; i += NGT) { const int l = i / (NEXP * DM), r = i % (NEXP * DM), e = r / DM, k = r % DM; RWT[i] = args.router_w[((size_t)l * DM + k) * NEXP + e]; }
            for (int i = gt; i < DEPTH * 8 * DM; i += NGT) { const int l = i / (8 * DM), r = i % (8 * DM), hh = r / DM, k = r % DM; WFT[i] = args.w_in[((size_t)l * DM + k) * INCOLS + 3072 + hh]; }
        }
        TP_END(32) TP_BEGIN(33)
        {
            LAS float* tile = (LAS float*)L;
            constexpr int TS = 265;
            constexpr int I_IN = 16 * 12, I_OUT = 16 * 4, I_1 = 16 * 8, I_2 = 16 * 4;
            constexpr int T_IN = DEPTH * I_IN, T_OUT = DEPTH * I_OUT, T_1 = DEPTH * NEXP * I_1, T_2 = DEPTH * NEXP * I_2, T_ALL = T_IN + T_OUT + T_1 + T_2;
            struct Desc { const float* W; unsigned char* WT; int ldw, k0, n0, kind; };
            auto desc = [&](int it) { Desc d; int r = it;
                if (r < T_IN) { const int l = r / I_IN, q = r % I_IN, kb = q / 12, nb = q % 12;
                    d.W = args.w_in + (size_t)l * DM * INCOLS; d.ldw = INCOLS; d.k0 = kb * 64; d.n0 = nb * 256; d.kind = (l != 0) ? 1 : 0;
                    d.WT = (l == 0) ? (unsigned char*)WIN : (unsigned char*)(WIN + (size_t)3072 * DM); return d; }
                r -= T_IN;
                if (r < T_OUT) { const int l = r / I_OUT, q = r % I_OUT, kb = q / 4, nb = q % 4;
                    d.W = args.w_out + (size_t)l * DM * DM; d.ldw = DM; d.k0 = kb * 64; d.n0 = nb * 256; d.kind = (l != 0) ? 1 : 0; d.WT = (unsigned char*)(WOUT + (size_t)l * DM * DM); return d; }
                r -= T_OUT;
                if (r < T_1) { const int le = r / I_1, q = r % I_1, kb = q / 8, nb = q % 8;
                    d.W = args.w1 + (size_t)le * DM * 2048; d.ldw = 2048; d.k0 = kb * 64; d.n0 = nb * 256; d.kind = 2; d.WT = W1T + (size_t)le * 2048 * DM; return d; }
                r -= T_1;
                { const int le = r / I_2, q = r % I_2, kb = q / 4, nb = q % 4;
                    d.W = args.w2 + (size_t)le * DM * DM; d.ldw = DM; d.k0 = kb * 64; d.n0 = nb * 256; d.kind = 1; d.WT = W2T + (size_t)le * DM * DM; return d; } };
            f32x4 lda[8], ldb[8], ldq[8]; Desc da, db, dq;
#define P0_LOAD(ld_, d_, it_) do { d_ = desc((it_) < T_ALL ? (it_) : 0); if ((it_) < T_ALL) { _Pragma("unroll") for (int i = 0; i < 8; ++i) ld_[i] = *(const f32x4*)(d_.W + (size_t)(d_.k0 + 8 * wave + i) * d_.ldw + d_.n0 + 4 * lane); } } while (0)
#define P0_PROC(ld_, d_) do { \
                _Pragma("unroll") for (int i = 0; i < 8; ++i) { LAS float* tp = tile + (8 * wave + i) * TS + 4 * lane + (lane >> 3); tp[0] = ld_[i][0]; tp[1] = ld_[i][1]; tp[2] = ld_[i][2]; tp[3] = ld_[i][3]; } \
                __syncthreads(); \
                { const int c = lane & 7; \
                _Pragma("unroll") for (int r2 = 0; r2 < 4; ++r2) { const int nr = 32 * wave + 8 * r2 + (lane >> 3); const LAS float* sp = tile + (8 * c) * TS + nr + (nr >> 5); \
                    const int n = d_.n0 + nr; \
                    const int drow = (d_.kind == 2) ? ((n < 1024) ? ((n >> 7) * 256 + (n & 127)) : ((((n - 1024) >> 7) * 256) + 128 + ((n - 1024) & 127))) : n; \
                    if (d_.kind != 0) { u32x2 o; o.x = pack4_fp8(sp[0 * TS] * 32.f, sp[1 * TS] * 32.f, sp[2 * TS] * 32.f, sp[3 * TS] * 32.f); o.y = pack4_fp8(sp[4 * TS] * 32.f, sp[5 * TS] * 32.f, sp[6 * TS] * 32.f, sp[7 * TS] * 32.f); \
                        *(u32x2*)(d_.WT + (size_t)drow * DM + d_.k0 + 8 * c) = o; } \
                    else { u32x4 o; o.x = cvt_pk_bf16(sp[0 * TS], sp[1 * TS]); o.y = cvt_pk_bf16(sp[2 * TS], sp[3 * TS]); o.z = cvt_pk_bf16(sp[4 * TS], sp[5 * TS]); o.w = cvt_pk_bf16(sp[6 * TS], sp[7 * TS]); \
                        *(u32x4*)((bf16_t*)d_.WT + (size_t)drow * DM + d_.k0 + 8 * c) = o; } } } \
                __syncthreads(); } while (0)
            int it = vcu;
            P0_LOAD(lda, da, it); P0_LOAD(ldb, db, it + G);
            __syncthreads();
            for (; it < T_ALL; it += 3 * G) {
                P0_LOAD(ldq, dq, it + 2 * G);
                P0_PROC(lda, da);
                if (it + G >= T_ALL) break;
                P0_LOAD(lda, da, it + 3 * G);
                P0_PROC(ldb, db);
                if (it + 2 * G >= T_ALL) break;
                P0_LOAD(ldb, db, it + 4 * G);
                P0_PROC(ldq, dq);
            }
#undef P0_LOAD
#undef P0_PROC
        }
        TP_END(33)
        } if (BOTH(0)) GRID_BAR(); TP_END(20)
    }

    if (ON(1) && IN(1)) { TP_BEGIN(21)
        FRESH_IDS(); WSPTRS();
        for (int rep_ = 0; rep_ < NREP(1); ++rep_) {
        for (int i = vcu * NTHR + tid; i < DEPTH * 8 * 32 * 2 * 64; i += G * NTHR) {
            const int ln = i & 63, blk = (i >> 6) & 1, sq = (i >> 7) & 31, bb = (i >> 12) & 7, ll = i >> 15;
            const int e = 16 * blk + (ln & 15), k0 = 32 * sq + 8 * (ln >> 4);
            const float* md = MOD + ((size_t)ll * 8 + bb) * 6144 + 4 * 1024;
            float w[8]; unsigned hi4[4], lo4[4];
#pragma unroll
            for (int j = 0; j < 8; ++j) w[j] = args.router_w[((size_t)ll * DM + k0 + j) * NEXP + e] * args.norm_ffn[ll * DM + k0 + j] * (1.0f + md[k0 + j]);
#pragma unroll
            for (int j = 0; j < 4; ++j) { hi4[j] = cvt_pk_bf16(w[2 * j], w[2 * j + 1]); lo4[j] = cvt_pk_bf16(w[2 * j] - bf_lo(hi4[j]), w[2 * j + 1] - bf_hi(hi4[j])); }
            u32x4* dst = (u32x4*)(WQ + ((((size_t)(ll * 8 + bb) * 32 + sq) * 2 + blk) * 2) * 64 * 8);
            dst[ln] = (u32x4){hi4[0], hi4[1], hi4[2], hi4[3]}; dst[64 + ln] = (u32x4){lo4[0], lo4[1], lo4[2], lo4[3]};
        }
        for (int i = gw; i < DEPTH * 8 * 32; i += NGW) { const int e = i & 31, bb = (i >> 5) & 7, ll = i >> 8;
            const float* md = MOD + ((size_t)ll * 8 + bb) * 6144 + 3 * 1024; float a = 0.f;
#pragma unroll 4
            for (int j = 0; j < 16; ++j) { const int k = lane + 64 * j; a += md[k] * args.router_w[((size_t)ll * DM + k) * NEXP + e]; }
            a = wave_sum(a); if (lane == 0) BQ[i] = a + args.router_b[ll * NEXP + e]; }
        LAS float* wft = (LAS float*)L;
        for (int i = tid; i < 8 * DM; i += NTHR) wft[i] = WFT[i];
        __syncthreads();
        for (int ch = gw; ch < NTOK / 16; ch += NGW) {
            const int b = ch >> 8; const float* mod = MOD + (size_t)b * 6144;
            f32x4 gm[4], sh[4];
#pragma unroll
            for (int j = 0; j < 4; ++j) { const int c0 = CB(j); const f32x4 g = *(const f32x4*)(args.norm_mix + c0), sc = *(const f32x4*)(mod + 1024 + c0); gm[j] = g * (sc + 1.0f); sh[j] = *(const f32x4*)(mod + c0); }
#pragma unroll 2
            for (int rr = 0; rr < 16; ++rr) { const int mrow = ch * 16 + rr;
                f32x4 v[4];
#pragma unroll
                for (int j = 0; j < 4; ++j) v[j] = *(const f32x4*)(args.x + (size_t)mrow * DM + CB(j));
                norm1_row<false>(v, gm, sh, wft, args.b_forget, XN + (size_t)mrow * DM, LF, b, mrow & (SEQ - 1), lane); }
        }
        __syncthreads();
        } if (BOTH(1)) GRID_BAR(); TP_END(21)
    }

    for (int l = 0; l < DEPTH; ++l) {
        const int pb = 2 + 7 * l;
#define modl (MOD + (size_t)l * 8 * 6144)
#define xin ((l == 0) ? args.x : (const float*)X2)
        if (ON(2) && IN(pb + 0)) { TP_BEGIN(22)
            FRESH_IDS(); WSPTRS();
        for (int rep_ = 0; rep_ < NREP(2); ++rep_) {
            if (vcu < 64) {
                const float* src = LF + (size_t)vcu * SEQ + 8 * tid; float* dst = NCK + (size_t)vcu * SEQ + 8 * tid;
                f32x4 a = *(const f32x4*)src, c2 = *(const f32x4*)(src + 4);
                float e[8] = {a[0], a[1], a[2], a[3], c2[0], c2[1], c2[2], c2[3]};
#pragma unroll
                for (int i = 1; i < 8; ++i) e[i] += e[i - 1];
                float tot = e[7], inc = tot;
#pragma unroll
                for (int o = 1; o < 64; o <<= 1) { const float n = __shfl_up(inc, o); if (lane >= o) inc += n; }
                LAS float* sc = (LAS float*)(L + L_SCAN);
                if (lane == 63) sc[wave] = inc;
                __syncthreads();
                float pre = inc - tot;
                for (int w = 0; w < wave; ++w) pre += sc[w];
                f32x4 o0, o1;
                o0[0] = -(e[0] + pre) * LOG2E; o0[1] = -(e[1] + pre) * LOG2E; o0[2] = -(e[2] + pre) * LOG2E; o0[3] = -(e[3] + pre) * LOG2E;
                o1[0] = -(e[4] + pre) * LOG2E; o1[1] = -(e[5] + pre) * LOG2E; o1[2] = -(e[6] + pre) * LOG2E; o1[3] = -(e[7] + pre) * LOG2E;
                *(f32x4*)dst = o0; *(f32x4*)(dst + 4) = o1;
            }
            __syncthreads();
            if (l == 0) {
                pg8::SchedDense S{(const char*)XN, (const char*)WIN, 12, (NTOK / 256) * 12, G, vcu, DM};
                const pg8::EpiInProj E{QKV, ROPE, ctl + CW_KN + l * 128, 1.0f};
                pg8::gemm_phase<pg8::EpiInProj, pg8::SchedDense, true>(L, DM, S, E, tacc);
            } else {
                pg8::SchedDenseG S{(const char*)XN, (const char*)(WIN + (size_t)3072 * DM), 12, (NTOK / 256) * 12, G, vcu, DM};
                const pg8::EpiInProj E{QKV, ROPE, ctl + CW_KN + l * 128, 0.03125f};
                pg8::gemm_phase<pg8::EpiInProj, pg8::SchedDenseG, true, true>(L, DM, S, E, tacc);
            }
            } if (BOTH(pb + 0)) GRID_BAR(); TP_END(22)
        }
        if (ON(3) && IN(pb + 1)) { TP_BEGIN(23)
            FRESH_IDS(); WSPTRS();
        for (int rep_ = 0; rep_ < NREP(3); ++rep_) {
            const bf16_t* DQ = QKV; const bf16_t* DK = QKV + (size_t)NTOK * 512; const bf16_t* DV = QKV + (size_t)2 * NTOK * 512;
            const bf16_t* FQ = QKV + (size_t)3 * NTOK * 512; const bf16_t* FK = QKV + (size_t)4 * NTOK * 512; const bf16_t* FV = QKV + (size_t)5 * NTOK * 512;
            const float lam_init = 0.8f - 0.6f * expf(-0.3f * (float)l);
            const float s1 = wave_sum(args.lq1[l * 64 + lane] * args.lk1[l * 64 + lane]), s2 = wave_sum(args.lq2[l * 64 + lane] * args.lk2[l * 64 + lane]);
            const float lam = expf(s1) - expf(s2) + lam_init;
#ifndef ATT_PV
#define ATT_PV 0
#endif
            if (l == 0) {
            for (int p = vcu; p < 512; p += G) { const int bh = p >> 3, s = p & 7;
                att::fox_unit<0, false>(bh >> 3, bh & 7, 15 - s, FQ, FK, FV, NCK, ctl + CW_KN + l * 128, AO, (char*)lds);
                att::fox_unit<0, false>(bh >> 3, bh & 7, s, FQ, FK, FV, NCK, ctl + CW_KN + l * 128, AO, (char*)lds); }
            for (int p = vcu; p < 512; p += G) { const int bh = p >> 4, s = p & 15;
                att::diff_unit<0, false>(bh >> 2, bh & 3, 31 - s, DQ, DK, DV, args.subln + l * 128, lam, 1.0f - lam_init, AO, (char*)lds);
                att::diff_unit<0, false>(bh >> 2, bh & 3, s, DQ, DK, DV, args.subln + l * 128, lam, 1.0f - lam_init, AO, (char*)lds); }
            } else {
            for (int p = vcu; p < 512; p += G) { const int bh = p >> 3, s = p & 7;
                att::fox_unit<0, true>(bh >> 3, bh & 7, 15 - s, FQ, FK, FV, NCK, ctl + CW_KN + l * 128, AO, (char*)lds);
                att::fox_unit<0, true>(bh >> 3, bh & 7, s, FQ, FK, FV, NCK, ctl + CW_KN + l * 128, AO, (char*)lds); }
            for (int p = vcu; p < 512; p += G) { const int bh = p >> 4, s = p & 15;
                att::diff_unit<0, true>(bh >> 2, bh & 3, 31 - s, DQ, DK, DV, args.subln + l * 128, lam, 1.0f - lam_init, AO, (char*)lds);
                att::diff_unit<0, true>(bh >> 2, bh & 3, s, DQ, DK, DV, args.subln + l * 128, lam, 1.0f - lam_init, AO, (char*)lds); }
            }
            } if (BOTH(pb + 1)) GRID_BAR(); TP_END(23)
        }
        if (ON(4) && IN(pb + 2)) { TP_BEGIN(24)
            FRESH_IDS(); WSPTRS();
        for (int rep_ = 0; rep_ < NREP(4); ++rep_) {
            if (l == 0) {
                pg8::SchedDense S{(const char*)AO, (const char*)WOUT, 4, (NTOK / 256) * 4, G, vcu, DM};
                const pg8::EpiOutProj E{xin, X1, modl + 2 * 1024, 1.0f};
                pg8::gemm_phase<pg8::EpiOutProj, pg8::SchedDense, true>(L, DM, S, E, tacc);
            } else {
                pg8::SchedDenseG S{(const char*)AO, (const char*)(WOUT + (size_t)DM * DM), 4, (NTOK / 256) * 4, G, vcu, DM};
                const pg8::EpiOutProj E{xin, X1, modl + 2 * 1024, 0.03125f};
                pg8::gemm_phase<pg8::EpiOutProj, pg8::SchedDenseG, true, true>(L, DM, S, E, tacc);
            }
            } if (BOTH(pb + 2)) GRID_BAR(); TP_END(24)
        }
        if (ON(5) && IN(pb + 3)) { TP_BEGIN(25)
            FRESH_IDS(); WSPTRS();
            LAS u32x4* wq = (LAS u32x4*)L;
            LAS float* rsl = (LAS float*)(L + IDX_OFF) + wave * 16;
            LAS float* bql = (LAS float*)(L + IDX_OFF + 1024);
            LAS int* hist = (LAS int*)(L + L_HIST); LAS int* basel = (LAS int*)(L + L_BASE);
            const int nch = NTOK / 16, niter = (nch + NGW - 1) / NGW;
            int bcur = -1;
            if (tid < 32) hist[tid] = 0;
            unsigned* cntg = ctl + CW_CNT + l * 32 * 64;
            for (int itr = 0; itr < niter; ++itr) {
                const int ch = itr * NGW + gw; const bool act = ch < nch;
                const int bwg = ((itr * NGW + vcu * NWAVES) >> 8) & 7;
                if (bwg != bcur) { __syncthreads(); bcur = bwg;
                    const u32x4* src = (const u32x4*)(WQ + (size_t)(l * 8 + bwg) * 32 * 2 * 2 * 64 * 8);
                    for (int i = tid; i < 32 * 2 * 2 * 64; i += NTHR) wq[i] = src[i];
                    if (tid < 32) bql[tid] = BQ[(l * 8 + bwg) * 32 + tid];
                    __syncthreads(); }
                int te[4] = {0, 0, 0, 0}, lr[4] = {0, 0, 0, 0}; float tg[4] = {0.f, 0.f, 0.f, 0.f};
                for (int rep_ = 0; rep_ < NREP(5); ++rep_)
                if (act) {
                    const int b = ch >> 8; const float* mod = modl + (size_t)b * 6144;
                    const int tk = lane & 15, kg = lane >> 4;
                    const float* xr = X1 + (size_t)(ch * 16 + tk) * DM + 8 * kg;
                    f32x4 acc0 = {0.f, 0.f, 0.f, 0.f}, acc1 = acc0; float ssq = 0.f;
#pragma unroll 4
                    for (int sq = 0; sq < 32; ++sq) {
                        const f32x4 xa = *(const f32x4*)(xr + 32 * sq), xb = *(const f32x4*)(xr + 32 * sq + 4);
                        ssq += (xa[0] * xa[0] + xa[1] * xa[1]) + (xa[2] * xa[2] + xa[3] * xa[3]) + (xb[0] * xb[0] + xb[1] * xb[1]) + (xb[2] * xb[2] + xb[3] * xb[3]);
                        u32x4 xh, xl;
                        xh[0] = cvt_pk_bf16(xa[0], xa[1]); xh[1] = cvt_pk_bf16(xa[2], xa[3]); xh[2] = cvt_pk_bf16(xb[0], xb[1]); xh[3] = cvt_pk_bf16(xb[2], xb[3]);
                        xl[0] = cvt_pk_bf16(xa[0] - bf_lo(xh[0]), xa[1] - bf_hi(xh[0])); xl[1] = cvt_pk_bf16(xa[2] - bf_lo(xh[1]), xa[3] - bf_hi(xh[1]));
                        xl[2] = cvt_pk_bf16(xb[0] - bf_lo(xh[2]), xb[1] - bf_hi(xh[2])); xl[3] = cvt_pk_bf16(xb[2] - bf_lo(xh[3]), xb[3] - bf_hi(xh[3]));
                        const bf16x8 bh = __builtin_bit_cast(bf16x8, xh), bl = __builtin_bit_cast(bf16x8, xl);
                        const LAS u32x4* wp = wq + sq * 256 + lane;
                        const bf16x8 w0h = __builtin_bit_cast(bf16x8, wp[0]), w0l = __builtin_bit_cast(bf16x8, wp[64]), w1h = __builtin_bit_cast(bf16x8, wp[128]), w1l = __builtin_bit_cast(bf16x8, wp[192]);
                        acc0 = __builtin_amdgcn_mfma_f32_16x16x32_bf16(w0h, bh, acc0, 0, 0, 0); acc1 = __builtin_amdgcn_mfma_f32_16x16x32_bf16(w1h, bh, acc1, 0, 0, 0);
                        acc0 = __builtin_amdgcn_mfma_f32_16x16x32_bf16(w0l, bh, acc0, 0, 0, 0); acc1 = __builtin_amdgcn_mfma_f32_16x16x32_bf16(w1l, bh, acc1, 0, 0, 0);
                        acc0 = __builtin_amdgcn_mfma_f32_16x16x32_bf16(w0h, bl, acc0, 0, 0, 0); acc1 = __builtin_amdgcn_mfma_f32_16x16x32_bf16(w1h, bl, acc1, 0, 0, 0);
                    }
                    ssq += __shfl_xor(ssq, 16); ssq += __shfl_xor(ssq, 32);
                    const float rstd = __builtin_amdgcn_rsqf(ssq * (1.0f / DM) + NORM_EPS);
                    if (lane < 16) rsl[lane] = rstd;
                    float v0 = -INFINITY, v1 = -INFINITY, v2 = -INFINITY, v3 = -INFINITY; int i0 = 0, i1 = 0, i2 = 0, i3 = 0;
#define TOPK_INS(x_, e_) do { const float xx_ = (x_); const int ee_ = (e_); \
                        if (xx_ > v3 || (xx_ == v3 && ee_ < i3)) { v3 = xx_; i3 = ee_; \
                            if (v3 > v2 || (v3 == v2 && i3 < i2)) { float tf = v2; v2 = v3; v3 = tf; int ti = i2; i2 = i3; i3 = ti; \
                                if (v2 > v1 || (v2 == v1 && i2 < i1)) { tf = v1; v1 = v2; v2 = tf; ti = i1; i1 = i2; i2 = ti; \
                                    if (v1 > v0 || (v1 == v0 && i1 < i0)) { tf = v0; v0 = v1; v1 = tf; ti = i0; i0 = i1; i1 = ti; } } } } } while (0)
#pragma unroll
                    for (int r = 0; r < 4; ++r) { TOPK_INS(acc0[r] * rstd + bql[4 * kg + r], 4 * kg + r); }
#pragma unroll
                    for (int r = 0; r < 4; ++r) { TOPK_INS(acc1[r] * rstd + bql[16 + 4 * kg + r], 16 + 4 * kg + r); }
#pragma unroll
                    for (int st = 16; st <= 32; st <<= 1) {
                        const float p0 = __shfl_xor(v0, st), p1 = __shfl_xor(v1, st), p2 = __shfl_xor(v2, st), p3 = __shfl_xor(v3, st);
                        const int q0 = __shfl_xor(i0, st), q1 = __shfl_xor(i1, st), q2 = __shfl_xor(i2, st), q3 = __shfl_xor(i3, st);
                        TOPK_INS(p0, q0); TOPK_INS(p1, q1); TOPK_INS(p2, q2); TOPK_INS(p3, q3);
                    }
#undef TOPK_INS
                    if (lane < 16) {
                        const float e1 = __expf(v1 - v0), e2 = __expf(v2 - v0), e3 = __expf(v3 - v0); const float rs = 1.0f / (1.0f + e1 + e2 + e3);
                        te[0] = i0; te[1] = i1; te[2] = i2; te[3] = i3; tg[0] = rs; tg[1] = e1 * rs; tg[2] = e2 * rs; tg[3] = e3 * rs;
#pragma unroll
                        for (int k = 0; k < 4; ++k) if (rep_ == NREP(5) - 1) lr[k] = atomicAdd((int*)(lds + L_HIST) + te[k], 1);
                    }
                    f32x4 gm[4], sh[4];
#pragma unroll
                    for (int j = 0; j < 4; ++j) { const int c0 = CB(j); const f32x4 g = *(const f32x4*)(args.norm_ffn + l * DM + c0), sc = *(const f32x4*)(mod + 4 * 1024 + c0); gm[j] = g * (sc + 1.0f); sh[j] = *(const f32x4*)(mod + 3 * 1024 + c0); }
                    asm volatile("s_waitcnt lgkmcnt(0)" ::: "memory");
#pragma unroll 2
                    for (int rr = 0; rr < 16; ++rr) { const int mrow = ch * 16 + rr; const float rs2 = rsl[rr];
#pragma unroll
                        for (int jj = 0; jj < 2; ++jj) { const int c0 = 512 * jj + 8 * lane;
                            const f32x4 va = *(const f32x4*)(X1 + (size_t)mrow * DM + c0) * rs2 * gm[2 * jj] + sh[2 * jj], vc = *(const f32x4*)(X1 + (size_t)mrow * DM + c0 + 4) * rs2 * gm[2 * jj + 1] + sh[2 * jj + 1];
                            u32x2 w; w.x = pack4_fp8(va[0], va[1], va[2], va[3]); w.y = pack4_fp8(vc[0], vc[1], vc[2], vc[3]); *(u32x2*)(XN2 + (size_t)mrow * DM + c0) = w; } }
                }
                __syncthreads();
                if (tid < 32) { const int c = hist[tid]; int base = 0; if (c > 0) base = (int)__hip_atomic_fetch_add(cntg + tid * 64, (unsigned)c, __ATOMIC_RELAXED, __HIP_MEMORY_SCOPE_AGENT); basel[tid] = base; hist[tid] = 0; }
                __syncthreads();
                if (act && lane < 16) { const int mrow = ch * 16 + lane;
#pragma unroll
                    for (int k = 0; k < 4; ++k) { ROWL[(size_t)te[k] * ROWCAP + basel[te[k]] + lr[k]] = mrow * 4 + k; GATES[mrow * 4 + k] = tg[k]; } }
                __syncthreads();
            }
            if (BOTH(pb + 3)) GRID_BAR(); TP_END(25)
        }
        if ((ON(6) && IN(pb + 4)) || (ON(7) && IN(pb + 5))) {
            FRESH_IDS(); WSPTRS();
            LAS int* lcnt = (LAS int*)(L + L_CNT); LAS int* lblk = (LAS int*)(L + L_BLK); LAS int* idx = (LAS int*)(L + IDX_OFF);
            unsigned* cntg = ctl + CW_CNT + l * 32 * 64;
            __syncthreads();
            if (tid < 32) lcnt[tid] = (int)__hip_atomic_load(cntg + tid * 64, __ATOMIC_RELAXED, __HIP_MEMORY_SCOPE_AGENT);
            __syncthreads();
            if (tid == 0) { int s = 0; for (int e = 0; e < 32; ++e) { lblk[e] = s; s += (lcnt[e] + 255) >> 8; } lblk[32] = s; }
            __syncthreads();
            const int nrb = lblk[32];
            if (ON(6) && IN(pb + 4)) { TP_BEGIN(26)
        for (int rep_ = 0; rep_ < NREP(6); ++rep_) {
                const int nU = nrb * 8;
                for (int i = 0; i * G + vcu < nU; ++i) { const int rb = (i * G + vcu) >> 3; const int e = pg8::find_expert(lblk, rb);
                    if (tid < 256) { const int r = (rb - lblk[e]) * 256 + tid; idx[i * 256 + tid] = (r < lcnt[e]) ? (ROWL[(size_t)e * ROWCAP + r] >> 2) : 0; } }
                __syncthreads();
                pg8::SchedMoe1 S{(const char*)XN2, (const char*)(W1T + (size_t)l * NEXP * 2048 * DM), lblk, idx, nU, G, vcu};
                pg8::EpiMoe1 E{HID, args.b1 + (size_t)l * NEXP * 2048, (LAS float*)(L + BIAS_OFF)};
                pg8::gemm_phase<pg8::EpiMoe1, pg8::SchedMoe1, true, true>(L, DM, S, E, tacc);
                } if (BOTH(pb + 4)) GRID_BAR(); TP_END(26)
            }
            if (ON(7) && IN(pb + 5)) { TP_BEGIN(27)
        for (int rep_ = 0; rep_ < NREP(7); ++rep_) {
                const int nU = nrb * 4;
                __syncthreads();
                for (int i = 0; i * G + vcu < nU; ++i) { const int rb = (i * G + vcu) >> 2; const int e = pg8::find_expert(lblk, rb);
                    if (tid < 256) { const int r = (rb - lblk[e]) * 256 + tid; idx[i * 256 + tid] = (r < lcnt[e]) ? ROWL[(size_t)e * ROWCAP + r] : NTOK * TOPK; } }
                __syncthreads();
                pg8::SchedMoe2 S{(const char*)HID, (const char*)(W2T + (size_t)l * NEXP * DM * DM), lblk, nU, G, vcu};
                pg8::EpiMoe2 E{Y, args.b2 + (size_t)l * NEXP * DM, idx, (LAS float*)(L + BIAS_OFF)};
                pg8::gemm_phase<pg8::EpiMoe2, pg8::SchedMoe2, true, true>(L, DM, S, E, tacc);
                } if (BOTH(pb + 5)) GRID_BAR(); TP_END(27)
            }
        }
        if (ON(8) && IN(pb + 6)) { TP_BEGIN(28)
            FRESH_IDS(); WSPTRS();
        for (int rep_ = 0; rep_ < NREP(8); ++rep_) {
            LAS float* wft = (LAS float*)L;
            if (l + 1 < DEPTH) { for (int i = tid; i < 8 * DM; i += NTHR) wft[i] = WFT[(size_t)(l + 1) * 8 * DM + i]; }
            __syncthreads();
            for (int ch = gw; ch < NTOK / 16; ch += NGW) {
                const int b = ch >> 8; const float* mod = modl + (size_t)b * 6144;
                f32x4 g2[4], gm[4], sh[4];
#pragma unroll
                for (int j = 0; j < 4; ++j) { const int c0 = CB(j); g2[j] = *(const f32x4*)(mod + 5 * 1024 + c0);
                    if (l + 1 < DEPTH) { const float* mod2 = MOD + ((size_t)(l + 1) * 8 + b) * 6144; const f32x4 g = *(const f32x4*)(args.norm_mix + (l + 1) * DM + c0), sc = *(const f32x4*)(mod2 + 1024 + c0); gm[j] = g * (sc + 1.0f); sh[j] = *(const f32x4*)(mod2 + c0); }
                    else { gm[j] = *(const f32x4*)(args.final_norm + c0); sh[j] = (f32x4){0.f, 0.f, 0.f, 0.f}; } }
#pragma unroll 4
                for (int rr = 0; rr < 16; ++rr) { const int mrow = ch * 16 + rr;
                    const f32x4 gt = *(const f32x4*)(GATES + (size_t)mrow * 4);
                    f32x4 v[4];
#pragma unroll
                    for (int jj = 0; jj < 2; ++jj) { const int c0 = 512 * jj + 8 * lane;
                        f32x4 a = {0.f, 0.f, 0.f, 0.f}, c = a;
#pragma unroll
                        for (int k = 0; k < 4; ++k) { const u32x4 yw = *(const u32x4*)(Y + ((size_t)mrow * 4 + k) * DM + c0); const float gk = gt[k];
                            a[0] += gk * bf_lo(yw.x); a[1] += gk * bf_hi(yw.x); a[2] += gk * bf_lo(yw.y); a[3] += gk * bf_hi(yw.y);
                            c[0] += gk * bf_lo(yw.z); c[1] += gk * bf_hi(yw.z); c[2] += gk * bf_lo(yw.w); c[3] += gk * bf_hi(yw.w); }
                        v[2 * jj] = *(const f32x4*)(X1 + (size_t)mrow * DM + c0) + g2[2 * jj] * a; v[2 * jj + 1] = *(const f32x4*)(X1 + (size_t)mrow * DM + c0 + 4) + g2[2 * jj + 1] * c; }
                    if (l + 1 < DEPTH) {
#pragma unroll
                        for (int j = 0; j < 4; ++j) *(f32x4*)(X2 + (size_t)mrow * DM + CB(j)) = v[j];
                        norm1_row<true>(v, gm, sh, wft, args.b_forget + (l + 1) * 8, (bf16_t*)((unsigned char*)XN + (size_t)mrow * DM), LF, b, mrow & (SEQ - 1), lane);
                    } else {
                        float ss = 0.f;
#pragma unroll
                        for (int j = 0; j < 4; ++j) ss += (v[j][0] * v[j][0] + v[j][1] * v[j][1]) + (v[j][2] * v[j][2] + v[j][3] * v[j][3]);
                        const float rstd = __builtin_amdgcn_rsqf(wave_sum(ss) * (1.0f / DM) + NORM_EPS);
#pragma unroll
                        for (int j = 0; j < 4; ++j) *(f32x4*)(args.out + (size_t)mrow * DM + CB(j)) = v[j] * rstd * gm[j];
                    }
                }
            }
            __syncthreads();
            } if (BOTH(pb + 6)) GRID_BAR(); TP_END(28)
        }
    }
    TP_END(30)
    if (TPROBE != 0 && blockIdx.x == 0 && threadIdx.x == 0) { const long t0 = (long)__builtin_amdgcn_s_memtime(); while ((long)__builtin_amdgcn_s_memtime() - t0 < tacc * TP_MULT) __builtin_amdgcn_s_sleep(8); }
#undef IN
#undef BOTH
}

extern "C" void kernel_launch(void* const* d_in, const int* in_sizes, int n_in, void* d_out, int out_size, void* d_ws, size_t ws_size, hipStream_t stream) {
    static int grid = 0;
    if (grid == 0) {
        if (n_in != 22 || in_sizes[0] != NTOK * DM || out_size != NTOK * DM || ws_size < WS_END) {
            fprintf(stderr, "kernel_launch: unexpected shapes: n_in %d in0 %d out %d ws %zu (need %zu)\n", n_in, n_in > 0 ? in_sizes[0] : -1, out_size, ws_size, (size_t)WS_END); grid = -1; return; }
        int dev = 0, cus = 0, per_cu = 0;
        if (hipGetDevice(&dev) != hipSuccess || hipDeviceGetAttribute(&cus, hipDeviceAttributeMultiprocessorCount, dev) != hipSuccess) { grid = -1; return; }
        if (hipFuncSetAttribute((const void*)fwd_kernel, hipFuncAttributeMaxDynamicSharedMemorySize, LDS_BYTES) != hipSuccess) { fprintf(stderr, "kernel_launch: hipFuncSetAttribute failed\n"); grid = -1; return; }
        if (hipOccupancyMaxActiveBlocksPerMultiprocessor(&per_cu, (const void*)fwd_kernel, NTHR, LDS_BYTES) != hipSuccess || per_cu < 1)
            fprintf(stderr, "kernel_launch: occupancy query reports %d blocks per CU\n", per_cu);
        (void)hipGetLastError();
        grid = cus;
    }
    if (grid < 0) return;
    (void)hipMemsetAsync((char*)d_ws + WS_CTL, 0, CTL_ZERO_BYTES, stream);
    Args a{};
    a.x = (const float*)d_in[0]; a.c = (const float*)d_in[1]; a.pos = (const int*)d_in[2]; a.ada_w = (const float*)d_in[3]; a.ada_b = (const float*)d_in[4];
    a.norm_mix = (const float*)d_in[5]; a.norm_ffn = (const float*)d_in[6]; a.w_in = (const float*)d_in[7]; a.b_forget = (const float*)d_in[8];
    a.lq1 = (const float*)d_in[9]; a.lk1 = (const float*)d_in[10]; a.lq2 = (const float*)d_in[11]; a.lk2 = (const float*)d_in[12]; a.subln = (const float*)d_in[13];
    a.w_out = (const float*)d_in[14]; a.router_w = (const float*)d_in[15]; a.router_b = (const float*)d_in[16]; a.w1 = (const float*)d_in[17]; a.b1 = (const float*)d_in[18];
    a.w2 = (const float*)d_in[19]; a.b2 = (const float*)d_in[20]; a.final_norm = (const float*)d_in[21];
    a.out = (float*)d_out; a.ws = (unsigned char*)d_ws;
    constexpr int NPH = 2 + 7 * DEPTH;
#if MK_MULTI
    for (int p = 0; p < NPH; ++p) { a.ph_lo = p; a.ph_hi = p + 1; hipLaunchKernelGGL(fwd_kernel, dim3(grid), dim3(NTHR), LDS_BYTES, stream, a); }
#else
    a.ph_lo = 0; a.ph_hi = NPH;
    hipLaunchKernelGGL(fwd_kernel, dim3(grid), dim3(NTHR), LDS_BYTES, stream, a);
#endif
    const hipError_t le = hipPeekAtLastError();
    if (le != hipSuccess) fprintf(stderr, "kernel_launch: launch failed: %s\n", hipGetErrorName(le));
}
```

```cpp
#include <hip/hip_runtime.h>
#include <hip/hip_bf16.h>
#include <cstdio>
#include <cstdint>
#include <cmath>

#ifndef MK_MULTI
#define MK_MULTI 0
#endif

constexpr int BATCH = 8, SEQ = 4096, DM = 1024, NTOK = BATCH * SEQ, DEPTH = 2, NEXP = 32, TOPK = 4;
constexpr int INCOLS = 3080, DFF = 1024;
constexpr int NWAVES = 8, NTHR = 512;
constexpr float NORM_EPS = 1e-6f;
constexpr float LOG2E = 1.4426950408889634f;
constexpr float QSCALE = 0.125f * LOG2E;
constexpr int ROWCAP = NTOK;
constexpr int MAXRB = (NTOK * TOPK) / 256 + NEXP;

constexpr size_t MiB = 1u << 20;
constexpr size_t WS_CTL = 0, CTL_ZERO_BYTES = 2 * MiB;
constexpr size_t WS_MOD = 2 * MiB;
constexpr size_t WS_RWT = 3 * MiB;
constexpr size_t WS_WFT = 3 * MiB + 512 * 1024;
constexpr size_t WS_ROPE = 4 * MiB;
constexpr size_t WS_NCK = 6 * MiB;
constexpr size_t WS_LF = 7 * MiB;
constexpr size_t WS_GATES = 8 * MiB;
constexpr size_t WS_ROWL = 9 * MiB;
constexpr size_t WS_WQ = 13 * MiB;
constexpr size_t WS_BQ = 15 * MiB;
constexpr size_t WS_WIN = 16 * MiB;
constexpr size_t WS_WOUT = 28 * MiB;
constexpr size_t WS_W1 = 32 * MiB;
constexpr size_t WS_W2 = 288 * MiB;
constexpr size_t WS_XN = 416 * MiB;
constexpr size_t WS_QKV = 480 * MiB;
constexpr size_t WS_AO = 672 * MiB;
constexpr size_t WS_X1 = 736 * MiB;
constexpr size_t WS_X2 = 864 * MiB;
constexpr size_t WS_XN2 = 992 * MiB;
constexpr size_t WS_HID = 1056 * MiB;
constexpr size_t WS_Y = 1328 * MiB;
constexpr size_t WS_END = 1585 * MiB;
constexpr int CW_BAR = 4096;
constexpr int CW_KN = 12288;
constexpr int CW_CNT = 16384;

constexpr int RING_BYTES = 131072;
constexpr int MISC_OFF = RING_BYTES;
constexpr int L_XBST = MISC_OFF;
constexpr int L_CNT = MISC_OFF + 64;
constexpr int L_BLK = MISC_OFF + 192;
constexpr int L_HIST = MISC_OFF + 384;
constexpr int L_BASE = MISC_OFF + 512;
constexpr int L_SCAN = MISC_OFF + 640;
constexpr int L_VOTE = MISC_OFF + 704;
constexpr int IDX_OFF = MISC_OFF + 1024;
constexpr int IDX_BYTES = 18432;
constexpr int BIAS_OFF = IDX_OFF + IDX_BYTES;
constexpr int LDS_BYTES = BIAS_OFF + 8192;

#define GAS __attribute__((address_space(1)))
#define LAS __attribute__((address_space(3)))
typedef unsigned short bf16_t;
typedef short bf16x8 __attribute__((ext_vector_type(8)));
typedef short s16x4 __attribute__((ext_vector_type(4)));
typedef float f32x4 __attribute__((ext_vector_type(4)));
typedef float f32x2 __attribute__((ext_vector_type(2)));
typedef float f32x16 __attribute__((ext_vector_type(16)));
typedef unsigned u32x4 __attribute__((ext_vector_type(4)));
typedef unsigned u32x2 __attribute__((ext_vector_type(2)));

__device__ __forceinline__ unsigned cvt_pk_bf16(float lo, float hi) { unsigned r; asm volatile("v_cvt_pk_bf16_f32 %0, %1, %2" : "=v"(r) : "v"(lo), "v"(hi)); return r; }
__device__ __forceinline__ int fresh_tid() { int t = threadIdx.x; asm volatile("" : "+v"(t)); return t; }
__device__ __forceinline__ unsigned pack4_fp8(float a, float b, float c, float d) {
    int w = __builtin_amdgcn_cvt_pk_fp8_f32(a, b, 0, false); w = __builtin_amdgcn_cvt_pk_fp8_f32(c, d, w, true); return (unsigned)w; }
__device__ __forceinline__ float bf_lo(unsigned w) { return __uint_as_float(w << 16); }
__device__ __forceinline__ float bf_hi(unsigned w) { return __uint_as_float(w & 0xffff0000u); }
__device__ __forceinline__ float wave_sum(float v) {
#pragma unroll
    for (int o = 1; o < 64; o <<= 1) v += __shfl_xor(v, o);
    return v;
}

#define XB_TMO      128
#define XB_XCNT(j)  (256  + 64 * (j))
#define XB_XSUB(j)  (1280 + 64 * (j))
#define XB_XGEN(j)  (2304 + 64 * (j))
#define XB_TOP      3328
#define XB_TOPGEN   3392
#define XCD_BAR_WORDS 3456
#define XB_SPIN_CAP (1u << 18)
__device__ __forceinline__ unsigned xb_ld(unsigned* p)              { return __hip_atomic_load(p, __ATOMIC_RELAXED, __HIP_MEMORY_SCOPE_AGENT); }
__device__ __forceinline__ unsigned xb_add(unsigned* p, unsigned v) { return __hip_atomic_fetch_add(p, v, __ATOMIC_RELAXED, __HIP_MEMORY_SCOPE_AGENT); }
__device__ __forceinline__ unsigned xb_xcc_id() { return (unsigned)__builtin_amdgcn_s_getreg((3 << 11) | 20) & 0xFu; }
#define XB_SPIN(cond, bar) do { unsigned _sp = 0; while (cond) { __builtin_amdgcn_s_sleep(1); \
    if ((++_sp & 255u) == 0u) { if (xb_ld(&(bar)[XB_TMO])) break; if (_sp > XB_SPIN_CAP) { atomicAdd(&(bar)[XB_TMO], 1u); break; } } } } while (0)
struct XcdBarrier { unsigned* bar; unsigned x; volatile LAS unsigned* st; };
__device__ __forceinline__ XcdBarrier xcd_barrier_post(unsigned* bar, volatile LAS unsigned* st) {
    XcdBarrier b; b.bar = bar; b.x = xb_xcc_id(); b.st = st;
    if (threadIdx.x == 0) (void)xb_add(&bar[XB_XCNT(b.x)], 1u);
    return b;
}
__device__ __forceinline__ void xcd_barrier_complete(unsigned* bar, unsigned x, unsigned& nloc, unsigned& nx) {
    const unsigned G = gridDim.x * gridDim.y * gridDim.z;
    unsigned sum, cnt, mine, sp = 0u;
    for (;;) {
        sum = 0u; cnt = 0u; mine = 0u;
#pragma unroll
        for (unsigned j = 0; j < 16; ++j) { const unsigned c = xb_ld(&bar[XB_XCNT(j)]); sum += c; cnt += (c > 0u) ? 1u : 0u; mine = (j == x) ? c : mine; }
        if (sum == G) break;
        __builtin_amdgcn_s_sleep(1);
        if ((++sp & 255u) == 0u) { if (xb_ld(&bar[XB_TMO])) break; if (sp > XB_SPIN_CAP) { atomicAdd(&bar[XB_TMO], 1u); break; } }
    }
    nloc = mine > 0u ? mine : 1u; nx = cnt > 0u ? cnt : 1u;
}
__device__ __forceinline__ void xcd_barrier(const XcdBarrier& b) {
    asm volatile("s_waitcnt vmcnt(0)" ::: "memory");
    __syncthreads();
    if (threadIdx.x == 0) {
        unsigned* bar = b.bar;
        __builtin_amdgcn_s_waitcnt(0);
        unsigned nloc = b.st[0], nx = b.st[1];
        if (nloc == 0u) { xcd_barrier_complete(bar, b.x, nloc, nx); b.st[0] = nloc; b.st[1] = nx; }
        const unsigned old = xb_add(&bar[XB_XSUB(b.x)], 1u);
        const unsigned gen = old / nloc;
        if (old + 1u == (gen + 1u) * nloc) {
            __builtin_amdgcn_fence(__ATOMIC_RELEASE, "agent");
            asm volatile("s_waitcnt vmcnt(0)" ::: "memory");
            const unsigned og = xb_add(&bar[XB_TOP], 1u);
            const unsigned tg = og / nx;
            if (og + 1u == (tg + 1u) * nx) xb_add(&bar[XB_TOPGEN], 1u);
            else XB_SPIN(xb_ld(&bar[XB_TOPGEN]) == tg, bar);
            __builtin_amdgcn_fence(__ATOMIC_ACQUIRE, "agent");
            xb_add(&bar[XB_XGEN(b.x)], 1u);
            asm volatile("s_waitcnt vmcnt(0)" ::: "memory");
        } else {
            XB_SPIN(xb_ld(&bar[XB_XGEN(b.x)]) == gen, bar);
            __builtin_amdgcn_fence(__ATOMIC_ACQUIRE, "agent");
            asm volatile("s_waitcnt vmcnt(0)" ::: "memory");
        }
    }
    __syncthreads();
}

#ifndef TPROBE
#define TPROBE 0
#endif
#define TP_MULT 4
#define TP_BEGIN(id) long tp_t0_##id = 0; if (TPROBE == (id)) { tp_t0_##id = (long)__builtin_amdgcn_s_memtime(); }
#define TP_END(id) if (TPROBE == (id)) { tacc += (long)__builtin_amdgcn_s_memtime() - tp_t0_##id; }
namespace pg8 {
constexpr int BM = 256, BK = 64, HALF = 128, HTB = HALF * BK * 2, STAGE_BYTES = 8 * HTB;
__host__ __device__ __forceinline__ int lds_byte(int r, int c) { const int st = (r >> 4) * 2 + (c >> 5), rr = r & 15, cc = c & 31, ob = rr * 64 + cc * 2; return st * 1024 + (ob ^ (((ob >> 9) & 1) << 5)); }
__host__ __device__ __forceinline__ void stage_rc(int b, int& R, int& C) { const int st = b / 1024, sb = b % 1024, swz = sb ^ (((sb >> 9) & 1) << 5); R = (st >> 1) * 16 + swz / 64; C = (st & 1) * 32 + (swz % 64) / 2; }
__host__ __device__ __forceinline__ int perm32(int rho) { const int n = rho >> 4, i = rho & 15; return 8 * (i >> 2) + 4 * n + (i & 3); }

typedef int i32x8 __attribute__((ext_vector_type(8)));
typedef int i32x4 __attribute__((ext_vector_type(4)));
__device__ __forceinline__ i32x8 cat8(bf16x8 lo, bf16x8 hi) { const i32x4 a = __builtin_bit_cast(i32x4, lo), b = __builtin_bit_cast(i32x4, hi); return (i32x8){a[0], a[1], a[2], a[3], b[0], b[1], b[2], b[3]}; }
struct Unit { int pm, pn, e; };

template <class Epi, class Sched, bool ALIGN_EPI, bool F8 = false>
__device__ __forceinline__ void gemm_phase(LAS unsigned char* lds, const int K, const Sched& S, const Epi& E, long& tacc) {
    const int tid = fresh_tid(), wid = __builtin_amdgcn_readfirstlane(tid >> 6), lane = tid & 63, wr = wid >> 2, wc = wid & 3, fr = lane & 15, fq = lane >> 4;
    const int nt = F8 ? K / (2 * BK) : K / BK;
    const int rowb = F8 ? K : 2 * K;
    int Rp[2]; unsigned voffA[2], voffB[2];
#pragma unroll
    for (int i = 0; i < 2; ++i) { int R, C; stage_rc(tid * 16 + i * 8192, R, C); Rp[i] = R; const int Rb = Epi::PERM ? ((R & ~31) + perm32(R & 31)) : R;
        voffA[i] = Sched::GATHER ? (unsigned)C * 2u : (unsigned)(R * rowb + C * 2); voffB[i] = (unsigned)(Rb * rowb + C * 2); }
    const size_t kstep = (size_t)(BK * 2);
    const size_t hstep = (size_t)HALF * rowb;
    const unsigned ldsw = (unsigned)wid * 1024u;
    const int aoff = lds_byte(wr * 64 + fr, fq * 8), boff = lds_byte(wc * 32 + fr, fq * 8);
#define PG8_SA(b, h) (((b) * 2 + (h)) * HTB)
#define PG8_SB(b, h) ((4 + (b) * 2 + (h)) * HTB)
#define PG8_STAGE(bufoff, gbase, v0, v1) do { \
        __builtin_amdgcn_global_load_lds((const unsigned*)((const char*)(gbase) + (v0)), (LAS unsigned*)(lds + (bufoff) + ldsw), 16, 0, 0); \
        __builtin_amdgcn_global_load_lds((const unsigned*)((const char*)(gbase) + (v1)), (LAS unsigned*)(lds + (bufoff) + ldsw + 8192), 16, 0, 0); } while (0)
#define PG8_STAGE_A(bufoff, gbase, h) do { if constexpr (Sched::GATHER) { PG8_STAGE(bufoff, gbase, (unsigned)tok[h][0] * (unsigned)rowb + voffA[0], (unsigned)tok[h][1] * (unsigned)rowb + voffA[1]); } \
        else { PG8_STAGE(bufoff, (gbase) + (h) * hstep, voffA[0], voffA[1]); } } while (0)
#define PG8_LDA_(dst, b, h) do { if constexpr (F8) { _Pragma("unroll") for (int m = 0; m < 4; ++m) { const i32x4 lo_ = *(const LAS i32x4*)(lds + PG8_SA(b, h) + aoff + m * 2048), hi_ = *(const LAS i32x4*)(lds + PG8_SA(b, h) + aoff + m * 2048 + 1024); \
            dst##8[m] = __builtin_shufflevector(lo_, hi_, 0, 1, 2, 3, 4, 5, 6, 7); } } \
        else { _Pragma("unroll") for (int m = 0; m < 4; ++m) _Pragma("unroll") for (int k = 0; k < 2; ++k) dst[m][k] = *(const LAS bf16x8*)(lds + PG8_SA(b, h) + aoff + m * 2048 + k * 1024); } } while (0)
#define PG8_LDB_(dst, b, h) do { if constexpr (F8) { _Pragma("unroll") for (int n = 0; n < 2; ++n) { const i32x4 lo_ = *(const LAS i32x4*)(lds + PG8_SB(b, h) + boff + n * 2048), hi_ = *(const LAS i32x4*)(lds + PG8_SB(b, h) + boff + n * 2048 + 1024); \
            dst##8[n] = __builtin_shufflevector(lo_, hi_, 0, 1, 2, 3, 4, 5, 6, 7); } } \
        else { _Pragma("unroll") for (int n = 0; n < 2; ++n) _Pragma("unroll") for (int k = 0; k < 2; ++k) dst[n][k] = *(const LAS bf16x8*)(lds + PG8_SB(b, h) + boff + n * 2048 + k * 1024); } } while (0)
#define PG8_LDA(dst, b, h) PG8_LDA_(dst, b, h)
#define PG8_LDB(dst, b, h) PG8_LDB_(dst, b, h)
#define PG8_MMA(ai, bj, At, Bt) do { __builtin_amdgcn_s_setprio(1); \
        if constexpr (F8) { _Pragma("unroll") for (int m = 0; m < 4; ++m) _Pragma("unroll") for (int n = 0; n < 2; ++n) \
            acc[ai][bj][m][n] = __builtin_amdgcn_mfma_scale_f32_16x16x128_f8f6f4(Bt##8[n], At##8[m], acc[ai][bj][m][n], 0, 0, 0, 0x7f7f7f7f, 0, 0x7f7f7f7f); } \
        else { _Pragma("unroll") for (int m = 0; m < 4; ++m) _Pragma("unroll") for (int n = 0; n < 2; ++n) _Pragma("unroll") for (int k = 0; k < 2; ++k) \
            acc[ai][bj][m][n] = __builtin_amdgcn_mfma_f32_16x16x32_bf16(Bt[n][k], At[m][k], acc[ai][bj][m][n], 0, 0, 0); } \
        __builtin_amdgcn_s_setprio(0); } while (0)
#define PG8_WAIT_V(n) asm volatile("s_waitcnt vmcnt(" #n ")" ::: "memory")
#define PG8_WAIT_V8X(nrm) do { \
        if constexpr (Epi::NST == 8) asm volatile("v_cmp_ne_u32_e32 vcc, 0, %0\n\ts_cbranch_vccnz 1f\n\ts_waitcnt vmcnt(16)\n\ts_branch 2f\n1:\n\ts_waitcnt vmcnt(8)\n2:" :: "v"(nrm) : "memory", "vcc"); \
        else if constexpr (Epi::NST == 16) asm volatile("v_cmp_ne_u32_e32 vcc, 0, %0\n\ts_cbranch_vccnz 1f\n\ts_waitcnt vmcnt(24)\n\ts_branch 2f\n1:\n\ts_waitcnt vmcnt(8)\n2:" :: "v"(nrm) : "memory", "vcc"); \
        else { static_assert(Epi::NST == 32, "NST"); asm volatile("v_cmp_ne_u32_e32 vcc, 0, %0\n\ts_cbranch_vccnz 1f\n\ts_waitcnt vmcnt(40)\n\ts_branch 2f\n1:\n\ts_waitcnt vmcnt(8)\n2:" :: "v"(nrm) : "memory", "vcc"); } } while (0)
#define PG8_WAIT_L(n) asm volatile("s_waitcnt lgkmcnt(" #n ")" ::: "memory")
#define PG8_BAR __builtin_amdgcn_s_barrier()
#define PG8_SCHED __builtin_amdgcn_sched_barrier(0)
    Unit cur, nxt; int ui = 0;
    if (!S.next(0, cur)) return;
    f32x4 acc[2][2][4][2];
#pragma unroll
    for (int a = 0; a < 2; ++a)
#pragma unroll
        for (int b = 0; b < 2; ++b)
#pragma unroll
            for (int m = 0; m < 4; ++m)
#pragma unroll
                for (int n = 0; n < 2; ++n) acc[a][b][m][n] = (f32x4){0.f, 0.f, 0.f, 0.f};
    bf16x8 At[4][2], B0[2][2], B1[2][2]; i32x8 At8[4], B08[2], B18[2];
    int tok[2][2] = {{0, 0}, {0, 0}};
    if constexpr (Sched::GATHER) S.load_tok(cur, 0, Rp, tok);
    const char* cA = S.a_ptr(cur); const char* cB = S.b_ptr(cur);
    PG8_STAGE(PG8_SB(0, 0), cB, voffB[0], voffB[1]); PG8_STAGE(PG8_SB(0, 1), cB + hstep, voffB[0], voffB[1]); PG8_STAGE_A(PG8_SA(0, 0), cA, 0); PG8_STAGE_A(PG8_SA(0, 1), cA, 1);
    if (wr == 1) PG8_BAR;
    PG8_WAIT_V(2); PG8_BAR;
    PG8_STAGE(PG8_SB(1, 0), cB + kstep, voffB[0], voffB[1]); PG8_STAGE_A(PG8_SA(1, 0), cA + kstep, 0); PG8_STAGE(PG8_SB(1, 1), cB + hstep + kstep, voffB[0], voffB[1]);
    PG8_WAIT_V(6); PG8_BAR;
    for (;;) {
        if constexpr (Epi::PRE) E.pre(cur, wid, lane);
        const bool has_next = S.next(ui + 1, nxt);
        const char* nA = has_next ? S.a_ptr(nxt) : cA; const char* nB = has_next ? S.b_ptr(nxt) : cB;
        TP_BEGIN(40) long tpk_ = 0; if (TPROBE == Epi::TPK) tpk_ = (long)__builtin_amdgcn_s_memtime();
#pragma unroll 1
        for (int t = 0; t < nt; t += 2) {
            const bool last = (t == nt - 2); const int nrm = (t != 0 || ui == 0) ? 1 : 0;
            const char* a1 = cA + (size_t)(t + 1) * kstep;
            const char* a2 = last ? nA : cA + (size_t)(t + 2) * kstep; const char* b2 = last ? nB : cB + (size_t)(t + 2) * kstep;
            const char* a3 = a2 + kstep; const char* b3 = b2 + kstep;
            PG8_LDB(B0, 0, 0); PG8_LDB(B1, 0, 1); PG8_SCHED; PG8_LDA(At, 0, 0); PG8_STAGE_A(PG8_SA(1, 1), a1, 1);
            if constexpr (Sched::GATHER) { if (last && has_next) S.load_tok(nxt, ui + 1, Rp, tok); }
            PG8_WAIT_V8X(nrm); PG8_WAIT_L(0); PG8_BAR; PG8_MMA(0, 0, At, B0); PG8_MMA(0, 1, At, B1); PG8_BAR; PG8_SCHED;
            PG8_LDA(At, 0, 1); PG8_STAGE(PG8_SB(0, 0), b2, voffB[0], voffB[1]); PG8_STAGE(PG8_SB(0, 1), b2 + hstep, voffB[0], voffB[1]); PG8_STAGE_A(PG8_SA(0, 0), a2, 0);
            PG8_WAIT_V8X(nrm); PG8_WAIT_L(0); PG8_BAR; PG8_MMA(1, 0, At, B0); PG8_MMA(1, 1, At, B1); PG8_BAR; PG8_SCHED;
            PG8_LDB(B0, 1, 0); PG8_LDB(B1, 1, 1); PG8_SCHED; PG8_LDA(At, 1, 0); PG8_STAGE_A(PG8_SA(0, 1), a2, 1);
            PG8_WAIT_V(8); PG8_WAIT_L(0); PG8_BAR; PG8_MMA(0, 0, At, B0); PG8_MMA(0, 1, At, B1); PG8_BAR; PG8_SCHED;
            PG8_LDA(At, 1, 1); PG8_STAGE(PG8_SB(1, 0), b3, voffB[0], voffB[1]); PG8_STAGE(PG8_SB(1, 1), b3 + hstep, voffB[0], voffB[1]); PG8_STAGE_A(PG8_SA(1, 0), a3, 0);
            PG8_WAIT_V(8); PG8_WAIT_L(0); PG8_BAR; PG8_MMA(1, 0, At, B0); PG8_MMA(1, 1, At, B1); PG8_BAR; PG8_SCHED;
        }
        TP_END(40) if (TPROBE == Epi::TPK) tacc += (long)__builtin_amdgcn_s_memtime() - tpk_;
        TP_BEGIN(41) long tpe_ = 0; if (TPROBE == Epi::TPE) tpe_ = (long)__builtin_amdgcn_s_memtime();
        if constexpr (ALIGN_EPI) { if (wr == 0) PG8_BAR; }
        { int fr_ = fr, fq_ = fq; asm volatile("" : "+v"(fr_), "+v"(fq_));
          E(acc, cur, ui, wr, wc, fr_, fq_); }
        TP_END(41) if (TPROBE == Epi::TPE) tacc += (long)__builtin_amdgcn_s_memtime() - tpe_;
        if (!has_next) break;
#pragma unroll
        for (int a = 0; a < 2; ++a)
#pragma unroll
            for (int b = 0; b < 2; ++b)
#pragma unroll
                for (int m = 0; m < 4; ++m)
#pragma unroll
                    for (int n = 0; n < 2; ++n) acc[a][b][m][n] = (f32x4){0.f, 0.f, 0.f, 0.f};
        cur = nxt; cA = nA; cB = nB; ++ui;
        if constexpr (ALIGN_EPI) { if (wr == 1) PG8_BAR; }
    }
    PG8_WAIT_V(0);
    if constexpr (!ALIGN_EPI) { if (wr == 0) PG8_BAR; }
    PG8_BAR;
#undef PG8_SA
#undef PG8_SB
#undef PG8_STAGE
#undef PG8_STAGE_A
#undef PG8_LDA
#undef PG8_LDB
#undef PG8_LDA_
#undef PG8_LDB_
#undef PG8_MMA
#undef PG8_WAIT_V
#undef PG8_WAIT_V8X
#undef PG8_WAIT_L
#undef PG8_BAR
#undef PG8_SCHED
}

struct SchedDense {
    const char* A; const char* B; int nN, nUnits, G, vcu, K;
    __device__ __forceinline__ bool next(int i, Unit& u) const { const int L = i * G + vcu; if (L >= nUnits) return false; u.pm = L / nN; u.pn = L - u.pm * nN; u.e = 0; return true; }
    __device__ __forceinline__ const char* a_ptr(const Unit& u) const { return A + (size_t)u.pm * BM * K * 2; }
    __device__ __forceinline__ const char* b_ptr(const Unit& u) const { return B + (size_t)u.pn * BM * K * 2; }
    static constexpr bool GATHER = false;
    __device__ __forceinline__ void load_tok(const Unit&, int, const int (&)[2], int (&)[2][2]) const {}
};
struct SchedDenseG {
    const char* A; const char* B; int nN, nUnits, G, vcu, K;
    __device__ __forceinline__ bool next(int i, Unit& u) const { const int L = i * G + vcu; if (L >= nUnits) return false; u.pm = L / nN; u.pn = L - u.pm * nN; u.e = 0; return true; }
    __device__ __forceinline__ const char* a_ptr(const Unit&) const { return A; }
    __device__ __forceinline__ const char* b_ptr(const Unit& u) const { return B + (size_t)u.pn * BM * K; }
    static constexpr bool GATHER = true;
    __device__ __forceinline__ void load_tok(const Unit& u, int, const int (&Rp)[2], int (&tok)[2][2]) const {
#pragma unroll
        for (int h = 0; h < 2; ++h)
#pragma unroll
            for (int i = 0; i < 2; ++i) tok[h][i] = u.pm * BM + h * HALF + Rp[i];
    }
};
__device__ __forceinline__ int find_expert(const LAS int* blk, int rb) { int e = 0;
#pragma unroll
    for (int j = 1; j < NEXP; ++j) e += (rb >= blk[j]) ? 1 : 0;
    return e; }
struct SchedMoe1 {
    const char* A; const char* W; const LAS int* blk; const LAS int* idx; int nUnits, G, vcu;
    __device__ __forceinline__ bool next(int i, Unit& u) const { const int L = i * G + vcu; if (L >= nUnits) return false; u.pm = L >> 3; u.pn = L & 7; u.e = find_expert(blk, u.pm); return true; }
    __device__ __forceinline__ const char* a_ptr(const Unit&) const { return A; }
    __device__ __forceinline__ const char* b_ptr(const Unit& u) const { return W + ((size_t)u.e * 2048 + (size_t)u.pn * 256) * DM; }
    static constexpr bool GATHER = true;
    __device__ __forceinline__ void load_tok(const Unit&, int ui, const int (&Rp)[2], int (&tok)[2][2]) const {
#pragma unroll
        for (int h = 0; h < 2; ++h)
#pragma unroll
            for (int i = 0; i < 2; ++i) tok[h][i] = idx[ui * 256 + h * HALF + Rp[i]];
    }
};
struct SchedMoe2 {
    const char* A; const char* W; const LAS int* blk; int nUnits, G, vcu;
    __device__ __forceinline__ bool next(int i, Unit& u) const { const int L = i * G + vcu; if (L >= nUnits) return false; u.pm = L >> 2; u.pn = L & 3; u.e = find_expert(blk, u.pm); return true; }
    __device__ __forceinline__ const char* a_ptr(const Unit&) const { return A; }
    __device__ __forceinline__ const char* b_ptr(const Unit& u) const { return W + ((size_t)u.e * 1024 + (size_t)u.pn * 256) * DM; }
    static constexpr bool GATHER = true;
    __device__ __forceinline__ void load_tok(const Unit& u, int, const int (&Rp)[2], int (&tok)[2][2]) const {
#pragma unroll
        for (int h = 0; h < 2; ++h)
#pragma unroll
            for (int i = 0; i < 2; ++i) tok[h][i] = u.pm * BM + h * HALF + Rp[i];
    }
};

struct EpiInProj {
    static constexpr bool PERM = true, PRE = false; static constexpr int NST = 16; static constexpr int TPK = 46, TPE = 47;
    bf16_t* QKV; const float* rope; unsigned* kn; float ws;
    __device__ __forceinline__ void operator()(const f32x4 (&acc)[2][2][4][2], const Unit& u, int, int wr, int wc, int fr, int fq) const {
        const int t = u.pn >> 1; bf16_t* base = QKV + (size_t)t * NTOK * 512;
        const float sc = (t == 0 || t == 3) ? QSCALE : 1.0f;
        const bool dorope = (t < 2) && ((wc & 1) == 0);
        const int col0 = (u.pn & 1) * 256 + wc * 32 + 8 * fq;
        const float sgn = (fq == 0) ? -1.0f : 1.0f; const bool rl = fq < 2;
        float kmx0 = 0.f, kmx1 = 0.f;
#pragma unroll
        for (int ai = 0; ai < 2; ++ai)
#pragma unroll
            for (int m = 0; m < 4; ++m) {
                const int row = u.pm * BM + ai * HALF + wr * 64 + m * 16 + fr;
                f32x4 cs0 = {1.f, 1.f, 1.f, 1.f}, cs1 = cs0, sn0 = {0.f, 0.f, 0.f, 0.f}, sn1 = sn0;
                if (dorope) { const f32x4* rp = (const f32x4*)(rope + (size_t)row * 16); cs0 = rp[0]; cs1 = rp[1]; sn0 = rp[2]; sn1 = rp[3]; }
#pragma unroll
                for (int bj = 0; bj < 2; ++bj) {
                    f32x4 v0 = acc[ai][bj][m][0] * ws, v1 = acc[ai][bj][m][1] * ws;
                    if (dorope) {
#pragma unroll
                        for (int i = 0; i < 4; ++i) { const float p0 = __shfl_xor(v0[i], 16), p1 = __shfl_xor(v1[i], 16);
                            const float r0 = v0[i] * cs0[i] + sgn * p0 * sn0[i], r1 = v1[i] * cs1[i] + sgn * p1 * sn1[i];
                            v0[i] = rl ? r0 : v0[i]; v1[i] = rl ? r1 : v1[i]; }
                    }
                    v0 = v0 * sc; v1 = v1 * sc;
                    if (t == 4) { float ss = (v0[0] * v0[0] + v0[1] * v0[1]) + (v0[2] * v0[2] + v0[3] * v0[3]) + (v1[0] * v1[0] + v1[1] * v1[1]) + (v1[2] * v1[2] + v1[3] * v1[3]);
                        ss += __shfl_xor(ss, 16); ss += __shfl_xor(ss, 32); if (bj == 0) kmx0 = fmaxf(kmx0, ss); else kmx1 = fmaxf(kmx1, ss); }
                    u32x4 w; w.x = cvt_pk_bf16(v0[0], v0[1]); w.y = cvt_pk_bf16(v0[2], v0[3]); w.z = cvt_pk_bf16(v1[0], v1[1]); w.w = cvt_pk_bf16(v1[2], v1[3]);
                    *(u32x4*)(base + (size_t)row * 512 + col0 + bj * HALF) = w;
                }
            }
        if (t == 4) {
#pragma unroll
            for (int bj = 0; bj < 2; ++bj) { float v = (bj == 0) ? kmx0 : kmx1;
#pragma unroll
                for (int o = 1; o < 16; o <<= 1) v = fmaxf(v, __shfl_xor(v, o));
                unsigned* const kp = kn + (((u.pm >> 4) * 8 + (u.pn & 1) * 4 + bj * 2 + (wc >> 1)) * 2 + (wc & 1));
                if (fr == 0 && fq == 0) __hip_atomic_fetch_max(kp, __float_as_uint(v), __ATOMIC_RELAXED, __HIP_MEMORY_SCOPE_AGENT); }
        }
    }
};
struct EpiOutProj {
    static constexpr bool PERM = false, PRE = false; static constexpr int NST = 32; static constexpr int TPK = 48, TPE = 49;
    const float* xin; float* xout; const float* g1; float ws;
    __device__ __forceinline__ void operator()(const f32x4 (&acc)[2][2][4][2], const Unit& u, int, int wr, int wc, int fr, int fq) const {
        const int b = u.pm >> 4; const int col0 = u.pn * BM + wc * 32 + 4 * fq;
        f32x4 gv[2][2];
#pragma unroll
        for (int bj = 0; bj < 2; ++bj)
#pragma unroll
            for (int n = 0; n < 2; ++n) gv[bj][n] = *(const f32x4*)(g1 + (size_t)b * 6144 + col0 + bj * HALF + n * 16) * ws;
#pragma unroll
        for (int ai = 0; ai < 2; ++ai)
#pragma unroll
            for (int m = 0; m < 4; ++m) { const size_t off = (size_t)(u.pm * BM + ai * HALF + wr * 64 + m * 16 + fr) * DM + col0;
#pragma unroll
                for (int bj = 0; bj < 2; ++bj)
#pragma unroll
                    for (int n = 0; n < 2; ++n) { const f32x4 xi = *(const f32x4*)(xin + off + bj * HALF + n * 16); *(f32x4*)(xout + off + bj * HALF + n * 16) = xi + gv[bj][n] * acc[ai][bj][m][n]; }
            }
    }
};
struct EpiMoe1 {
    static constexpr bool PERM = true, PRE = true; static constexpr int NST = 8; static constexpr int TPK = 44, TPE = 45;
    unsigned char* HID; const float* b1; LAS float* biasl;
    __device__ __forceinline__ void pre(const Unit& u, int wid, int lane) const {
        const float* g = b1 + (size_t)u.e * 2048 + u.pn * HALF + ((lane < 32) ? 4 * lane : 1024 + 4 * (lane - 32));
        __builtin_amdgcn_global_load_lds((const unsigned*)g, (LAS unsigned*)(biasl + wid * 256), 16, 0, 0);
    }
    __device__ __forceinline__ void operator()(const f32x4 (&acc)[2][2][4][2], const Unit& u, int, int wr, int wc, int fr, int fq) const {
        const int wid = wr * 4 + wc; const int hl = wc * 32 + 8 * fq; const int hc = u.pn * HALF + hl; const LAS float* bb = biasl + wid * 256 + hl;
        const f32x4 bg0 = *(const LAS f32x4*)(bb), bg1 = *(const LAS f32x4*)(bb + 4), bu0 = *(const LAS f32x4*)(bb + 128), bu1 = *(const LAS f32x4*)(bb + 132);
#pragma unroll
        for (int ai = 0; ai < 2; ++ai)
#pragma unroll
            for (int m = 0; m < 4; ++m) {
                const size_t row = (size_t)u.pm * BM + ai * HALF + wr * 64 + m * 16 + fr;
                float o[8];
#pragma unroll
                for (int n = 0; n < 2; ++n) { const f32x4 g = acc[ai][0][m][n] * 0.03125f + (n ? bg1 : bg0), up = acc[ai][1][m][n] * 0.03125f + (n ? bu1 : bu0);
#pragma unroll
                    for (int i = 0; i < 4; ++i) { const float gt = fminf(g[i], 7.0f), uu = fminf(fmaxf(up[i], -7.0f), 7.0f);
                        const float sg = __builtin_amdgcn_rcpf(1.0f + __builtin_amdgcn_exp2f(-1.702f * LOG2E * gt)); o[n * 4 + i] = (uu + 1.0f) * gt * sg; } }
                u32x2 w; w.x = pack4_fp8(o[0], o[1], o[2], o[3]); w.y = pack4_fp8(o[4], o[5], o[6], o[7]);
                *(u32x2*)(HID + row * DM + hc) = w;
            }
    }
};
struct EpiMoe2 {
    static constexpr bool PERM = true, PRE = true; static constexpr int NST = 16; static constexpr int TPK = 42, TPE = 43;
    bf16_t* Y; const float* b2; const LAS int* aidx; LAS float* biasl;
    __device__ __forceinline__ void pre(const Unit& u, int wid, int lane) const {
        __builtin_amdgcn_global_load_lds((const unsigned*)(b2 + (size_t)u.e * 1024 + u.pn * BM + 4 * lane), (LAS unsigned*)(biasl + wid * 256), 16, 0, 0);
    }
    __device__ __forceinline__ void operator()(const f32x4 (&acc)[2][2][4][2], const Unit& u, int ui, int wr, int wc, int fr, int fq) const {
        const int wid = wr * 4 + wc; const int cl = wc * 32 + 8 * fq; const int col0 = u.pn * BM + cl; const LAS float* bb = biasl + wid * 256 + cl;
        f32x4 bv[2][2];
#pragma unroll
        for (int bj = 0; bj < 2; ++bj)
#pragma unroll
            for (int n = 0; n < 2; ++n) bv[bj][n] = *(const LAS f32x4*)(bb + bj * HALF + 4 * n);
#pragma unroll
        for (int ai = 0; ai < 2; ++ai)
#pragma unroll
            for (int m = 0; m < 4; ++m) {
                const int aid = aidx[ui * 256 + ai * HALF + wr * 64 + m * 16 + fr];
#pragma unroll
                for (int bj = 0; bj < 2; ++bj) { const f32x4 v0 = acc[ai][bj][m][0] * 0.03125f + bv[bj][0], v1 = acc[ai][bj][m][1] * 0.03125f + bv[bj][1];
                    u32x4 w; w.x = cvt_pk_bf16(v0[0], v0[1]); w.y = cvt_pk_bf16(v0[2], v0[3]); w.z = cvt_pk_bf16(v1[0], v1[1]); w.w = cvt_pk_bf16(v1[2], v1[3]);
                    *(u32x4*)(Y + (size_t)aid * DM + col0 + bj * HALF) = w; }
            }
    }
};
}

namespace att {
constexpr int STG_F = 16384, STG_D = 32768;
constexpr int LDS_NCK = 98304;
typedef LAS const char* lds_cptr;
typedef short v4i16_t __attribute__((ext_vector_type(4)));
typedef __bf16 bf16x2_t __attribute__((ext_vector_type(2)));
__device__ __forceinline__ void glds16(const void* gsrc, unsigned lds_dst) { unsigned keep;
    asm volatile("s_mov_b32 %0, m0\n\ts_mov_b32 m0, %2\n\ts_nop 0\n\tglobal_load_lds_dwordx4 %1, off\n\ts_mov_b32 m0, %0" : "=&s"(keep) : "v"(gsrc), "s"(lds_dst) : "memory"); }
__device__ __forceinline__ unsigned cvtpk(float lo, float hi) { f32x2 v = {lo, hi}; bf16x2_t b = __builtin_convertvector(v, bf16x2_t); return __builtin_bit_cast(unsigned, b); }
__device__ __forceinline__ s16x4 vtr(lds_cptr p) { return __builtin_bit_cast(s16x4, __builtin_amdgcn_ds_read_tr16_b64_v4i16((LAS v4i16_t*)p)); }
__device__ __forceinline__ float swapmax(float m) { auto rr = __builtin_amdgcn_permlane32_swap(__float_as_uint(m), __float_as_uint(m), false, false); return fmaxf(__uint_as_float(rr[0]), __uint_as_float(rr[1])); }
__device__ __forceinline__ float swapsum(float m) { auto rr = __builtin_amdgcn_permlane32_swap(__float_as_uint(m), __float_as_uint(m), false, false); return __uint_as_float(rr[0]) + __uint_as_float(rr[1]); }
__device__ __forceinline__ u32x4 widen_pair(u32x2 a, u32x2 b) {
    auto r0 = __builtin_amdgcn_permlane32_swap(a.x, b.x, false, false); auto r1 = __builtin_amdgcn_permlane32_swap(a.y, b.y, false, false);
    return (u32x4){r0[0], r1[0], r0[1], r1[1]};
}
#define ATT_WAIT_BAR(N) asm volatile("s_waitcnt vmcnt(" #N ") lgkmcnt(0)\n\ts_barrier" ::: "memory")
#define ATT_BAR() asm volatile("s_waitcnt lgkmcnt(0)\n\ts_barrier" ::: "memory")

__device__ __forceinline__ float max3f(float a, float b, float c) { float r; asm("v_max3_f32 %0, %1, %2, %3" : "=v"(r) : "v"(a), "v"(b), "v"(c)); return r; }
template <int NO, bool REL>
__device__ __forceinline__ void softmax_tile(f32x16& p0, f32x16& p1, float& m, float& l, f32x16 (&o)[NO], u32x4 (&pw)[4], f32x16& negm, bool first) {
    float mx = max3f(p0[0], p1[0], p0[1]);
    mx = max3f(mx, p1[1], p0[2]); mx = max3f(mx, p1[2], p0[3]); mx = max3f(mx, p1[3], p0[4]); mx = max3f(mx, p1[4], p0[5]); mx = max3f(mx, p1[5], p0[6]); mx = max3f(mx, p1[6], p0[7]);
    float my = max3f(p1[7], p0[8], p1[8]);
    my = max3f(my, p0[9], p1[9]); my = max3f(my, p0[10], p1[10]); my = max3f(my, p0[11], p1[11]); my = max3f(my, p0[12], p1[12]); my = max3f(my, p0[13], p1[13]); my = max3f(my, p0[14], p1[14]);
    mx = max3f(mx, my, p0[15]); mx = fmaxf(mx, p1[15]);
    mx = swapmax(mx);
    if constexpr (REL) {
        if (first || __any(mx > 8.0f)) {
            const float dl = first ? mx : fmaxf(mx, 0.f); const float al = __builtin_amdgcn_exp2f(-dl); m += dl; l *= al;
#pragma unroll
            for (int r = 0; r < 16; ++r) { p0[r] -= dl; p1[r] -= dl; negm[r] = -m; }
#pragma unroll
            for (int d = 0; d < NO; ++d)
#pragma unroll
                for (int r = 0; r < 16; ++r) o[d][r] *= al;
        }
    } else {
        if (__any(mx > m + 8.0f)) {
            const float mn = fmaxf(m, mx); const float al = __builtin_amdgcn_exp2f(m - mn); m = mn; l *= al;
#pragma unroll
            for (int d = 0; d < NO; ++d)
#pragma unroll
                for (int r = 0; r < 16; ++r) o[d][r] *= al;
        }
#pragma unroll
        for (int r = 0; r < 16; ++r) { p0[r] -= m; p1[r] -= m; }
    }
    float ls0 = 0.f, ls1 = 0.f;
#pragma unroll
    for (int r = 0; r < 16; ++r) { p0[r] = __builtin_amdgcn_exp2f(p0[r]); p1[r] = __builtin_amdgcn_exp2f(p1[r]); ls0 += p0[r]; ls1 += p1[r]; }
    l += ls0 + ls1;
    pw[0] = (u32x4){cvtpk(p0[0], p0[1]), cvtpk(p0[2], p0[3]), cvtpk(p0[4], p0[5]), cvtpk(p0[6], p0[7])};
    pw[1] = (u32x4){cvtpk(p0[8], p0[9]), cvtpk(p0[10], p0[11]), cvtpk(p0[12], p0[13]), cvtpk(p0[14], p0[15])};
    pw[2] = (u32x4){cvtpk(p1[0], p1[1]), cvtpk(p1[2], p1[3]), cvtpk(p1[4], p1[5]), cvtpk(p1[6], p1[7])};
    pw[3] = (u32x4){cvtpk(p1[8], p1[9]), cvtpk(p1[10], p1[11]), cvtpk(p1[12], p1[13]), cvtpk(p1[14], p1[15])};
}
#define ATT_SBAR() __builtin_amdgcn_sched_barrier(0)
struct VFrag { s16x4 lo[4], hi[4]; };
__device__ __forceinline__ void vload(VFrag& f, lds_cptr vp, int d) {
#pragma unroll
    for (int ks = 0; ks < 4; ++ks) { f.lo[ks] = vtr(vp + d * 4096 + ks * 1024); f.hi[ks] = vtr(vp + d * 4096 + ks * 1024 + 512); }
}
__device__ __forceinline__ void pv_block(f32x16& o, const VFrag& f, const u32x4 (&pw)[4]) {
#pragma unroll
    for (int ks = 0; ks < 4; ++ks) {
        const bf16x8 vf = (bf16x8){f.lo[ks][0], f.lo[ks][1], f.lo[ks][2], f.lo[ks][3], f.hi[ks][0], f.hi[ks][1], f.hi[ks][2], f.hi[ks][3]};
        o = __builtin_amdgcn_mfma_f32_32x32x16_bf16(vf, __builtin_bit_cast(bf16x8, pw[ks]), o, 0, 0, 0);
    }
}
__device__ __forceinline__ void kload(bf16x8 (&kf)[8], lds_cptr kb, int hi, int sw) {
#pragma unroll
    for (int d0 = 0; d0 < 4; ++d0) { const int co = ((2 * d0 + hi) ^ sw) << 4; kf[2 * d0] = *(const LAS bf16x8*)(kb + co); kf[2 * d0 + 1] = *(const LAS bf16x8*)(kb + co + 4096); }
}
__device__ __forceinline__ void qk_mma(f32x16& p0, f32x16& p1, const bf16x8 (&kf)[8], const bf16x8 (&qr)[4]) {
#pragma unroll
    for (int d0 = 0; d0 < 4; ++d0) {
        p0 = __builtin_amdgcn_mfma_f32_32x32x16_bf16(kf[2 * d0], qr[d0], p0, 0, 0, 0);
        p1 = __builtin_amdgcn_mfma_f32_32x32x16_bf16(kf[2 * d0 + 1], qr[d0], p1, 0, 0, 0);
    }
}

template <int PV, bool F8O>
__device__ __forceinline__ void fox_unit(int b, int h, int qb, const bf16_t* FQ, const bf16_t* FK, const bf16_t* FV, const float* NCK, const unsigned* KN, bf16_t* AO, char* shm) {
    const int tid = fresh_tid(), lane = tid & 63, r32 = lane & 31, hi = lane >> 5; const int wid = __builtin_amdgcn_readfirstlane(tid >> 6);
    const long rowbase = (long)b * SEQ; const int q0 = qb * 256;
    const int NT = 4 * (qb + 1), tl = 4 * qb + (wid >> 1), i0 = NT - 1 - tl;
    const unsigned lds0 = (unsigned)(uintptr_t)shm;
    const lds_cptr shm3 = (lds_cptr)shm;
    LAS float* nckl = (LAS float*)(shm3 + LDS_NCK);
    LAS unsigned* vote = (LAS unsigned*)(shm3 + L_VOTE);
    const int krow = wid * 8 + (lane >> 3);
    const bf16_t* ksrc = FK + (rowbase + krow) * 512 + h * 64 + (((lane & 7) ^ ((krow >> 1) & 7)) << 3);
    const bf16_t* vsrc = FV + (rowbase + 16 * (wid & 3) + (lane >> 2)) * 512 + h * 64 + (wid >> 2) * 32 + (lane & 3) * 8;
    const unsigned kdst = lds0 + wid * 1024, vdst = lds0 + 8192 + wid * 1024;
#define FOX_DMA(t, so) do { glds16(ksrc + (long)(t) * 64 * 512, (unsigned)__builtin_amdgcn_readfirstlane(kdst + (so))); glds16(vsrc + (long)(t) * 64 * 512, (unsigned)__builtin_amdgcn_readfirstlane(vdst + (so))); } while (0)
    FOX_DMA(NT - 1, 0); FOX_DMA(NT - 2, STG_F);
    { const f32x4* src = (const f32x4*)(NCK + (size_t)(b * 8 + h) * SEQ); const int n4 = 16 * NT;
      f32x4 c0 = {0.f, 0.f, 0.f, 0.f}, c1 = c0; if (tid < n4) c0 = src[tid]; if (tid + NTHR < n4) c1 = src[tid + NTHR];
      if (tid < n4) ((LAS f32x4*)nckl)[tid] = c0; if (tid + NTHR < n4) ((LAS f32x4*)nckl)[tid + NTHR] = c1; }
    const bf16_t* Qw = FQ + (rowbase + q0 + wid * 32 + r32) * 512 + h * 64;
    bf16x8 qr[4];
#pragma unroll
    for (int d0 = 0; d0 < 4; ++d0) qr[d0] = *(const bf16x8*)(Qw + d0 * 16 + hi * 8);
    const float kn2 = __uint_as_float(KN[(b * 8 + h) * 2]) + __uint_as_float(KN[(b * 8 + h) * 2 + 1]);
    asm volatile("" : "+v"(qr[0]), "+v"(qr[1]), "+v"(qr[2]), "+v"(qr[3]));
    float qn2 = 0.f;
#pragma unroll
    for (int d0 = 0; d0 < 4; ++d0) { const u32x4 w = __builtin_bit_cast(u32x4, qr[d0]);
#pragma unroll
        for (int j = 0; j < 4; ++j) { const float a = bf_lo(w[j]), c = bf_hi(w[j]); qn2 += a * a + c * c; } }
    qn2 = swapsum(qn2);
    const float Bq = sqrtf(qn2 * kn2) * 1.02f + 0.01f;
    const lds_cptr kp0 = shm3 + r32 * 128; const int ksw = (r32 >> 1) & 7;
    const lds_cptr vp0 = shm3 + 8192 + ((lane >> 4) & 1) * 32 + (lane & 3) * 8 + (4 * hi + ((lane & 15) >> 2)) * 64;
    float m = -1e30f, l = 0.f; f32x16 o[2]; o[0] = f32x16{}; o[1] = f32x16{};
    const int qrow = q0 + wid * 32 + r32;
    int so = 0, so2 = 2 * STG_F;
    for (int i = 0; i < NT; ++i) {
        const int t = NT - 1 - i;
        if (i + 1 < NT) ATT_WAIT_BAR(2); else ATT_WAIT_BAR(0);
        if (i > 0) {
            const LAS unsigned* vv = vote + ((i - 1) & 1) * 8; const u32x4 va4 = *(const LAS u32x4*)vv, vb4 = *(const LAS u32x4*)(vv + 4);
            if (((va4[0] | va4[1]) | (va4[2] | va4[3]) | (vb4[0] | vb4[1]) | (vb4[2] | vb4[3])) == 0u) break;
        }
        bf16x8 kf[8];
        if (i >= i0) kload(kf, kp0 + so, hi, ksw);
        if (i + 2 < NT) FOX_DMA(t - 2, so2);
        unsigned myvote = 1u;
        if (i >= i0) {
            f32x16 p0, p1; VFrag va, vb;
            const LAS float* nk = nckl + 64 * t + 4 * hi;
#pragma unroll
            for (int g = 0; g < 4; ++g) { const f32x4 a = *(const LAS f32x4*)(nk + 8 * g), c = *(const LAS f32x4*)(nk + 32 + 8 * g);
                p0[4 * g] = a[0]; p0[4 * g + 1] = a[1]; p0[4 * g + 2] = a[2]; p0[4 * g + 3] = a[3]; p1[4 * g] = c[0]; p1[4 * g + 1] = c[1]; p1[4 * g + 2] = c[2]; p1[4 * g + 3] = c[3]; }
            vload(va, vp0 + so, 0);
            ATT_SBAR();
            qk_mma(p0, p1, kf, qr);
            asm volatile("s_nop 15\n\ts_nop 7" : "+v"(p0), "+v"(p1));
            ATT_SBAR();
            if (i == i0) { const int kb = 64 * t + 4 * hi;
#pragma unroll
                for (int r = 0; r < 16; ++r) { const int kv = kb + (r & 3) + 8 * (r >> 2); if (kv > qrow) p0[r] = -INFINITY; if (kv + 32 > qrow) p1[r] = -INFINITY; } }
            u32x4 pw[4];
            softmax_tile<2, false>(p0, p1, m, l, o, pw, p0, false);
            ATT_SBAR();
            vload(vb, vp0 + so, 1);
            pv_block(o[0], va, pw);
            ATT_SBAR();
            pv_block(o[1], vb, pw);
            ATT_SBAR();
            myvote = (t > 0 && __any(Bq + nckl[64 * t - 1] - m > -48.0f)) ? 1u : 0u;
        }
        if (lane == 0) vote[(i & 1) * 8 + wid] = myvote;
        so = (so == 2 * STG_F) ? 0 : so + STG_F; so2 = (so2 == 2 * STG_F) ? 0 : so2 + STG_F;
    }
#undef FOX_DMA
    asm volatile("s_waitcnt vmcnt(0)" ::: "memory");
    ATT_BAR();
    l = swapsum(l);
    const float inv = __builtin_amdgcn_rcpf(l);
    if constexpr (F8O) {
        unsigned char* Ow = (unsigned char*)AO + (rowbase + qrow) * 1024 + 512 + h * 64 + 8 * hi;
#pragma unroll
        for (int d = 0; d < 2; ++d)
#pragma unroll
            for (int g = 0; g < 4; g += 2) {
                const unsigned wa = pack4_fp8(o[d][4 * g] * inv, o[d][4 * g + 1] * inv, o[d][4 * g + 2] * inv, o[d][4 * g + 3] * inv), wb = pack4_fp8(o[d][4 * g + 4] * inv, o[d][4 * g + 5] * inv, o[d][4 * g + 6] * inv, o[d][4 * g + 7] * inv);
                auto r = __builtin_amdgcn_permlane32_swap(wa, wb, false, false);
                *(u32x2*)(Ow + d * 32 + 8 * g) = (u32x2){r[0], r[1]}; }
    } else {
    bf16_t* Ow = AO + (rowbase + qrow) * 1024 + 512 + h * 64 + 8 * hi;
#pragma unroll
    for (int d = 0; d < 2; ++d)
#pragma unroll
        for (int g = 0; g < 4; g += 2) { u32x2 wa, wb;
            wa.x = cvt_pk_bf16(o[d][4 * g] * inv, o[d][4 * g + 1] * inv); wa.y = cvt_pk_bf16(o[d][4 * g + 2] * inv, o[d][4 * g + 3] * inv);
            wb.x = cvt_pk_bf16(o[d][4 * g + 4] * inv, o[d][4 * g + 5] * inv); wb.y = cvt_pk_bf16(o[d][4 * g + 6] * inv, o[d][4 * g + 7] * inv);
            *(u32x4*)(Ow + d * 32 + 8 * g) = widen_pair(wa, wb); }
    }
}

template <int PV, bool F8O>
__device__ __forceinline__ void diff_unit(int b, int h, int qb, const bf16_t* DQ, const bf16_t* DK, const bf16_t* DV, const float* subg, float lam, float post, bf16_t* AO, char* shm) {
    const int tid = fresh_tid(), lane = tid & 63, r32 = lane & 31, hi = lane >> 5; const int wid = __builtin_amdgcn_readfirstlane(tid >> 6);
    const int map = wid >> 2, wq = wid & 3;
    const long rowbase = (long)b * SEQ; const int q0 = qb * 128;
    const int NT = 2 * (qb + 1), tl = 2 * qb + (wq >> 1);
    const unsigned lds0 = (unsigned)(uintptr_t)shm;
    const lds_cptr shm3 = (lds_cptr)shm;
    const int qrow = q0 + wq * 32 + r32;
    const int krow = wid * 8 + (lane >> 3);
    const bf16_t* ksrc = DK + (rowbase + krow) * 512 + h * 128 + (((lane & 7) ^ ((krow >> 1) & 7)) << 3);
    const bf16_t* vsrc = DV + (rowbase + 16 * (wid & 3) + (lane >> 2)) * 512 + h * 128 + (wid >> 2) * 32 + (lane & 3) * 8;
    const unsigned kdst = lds0 + wid * 1024, vdst = lds0 + 16384 + wid * 1024;
#define DIFF_DMA(t, so) do { glds16(ksrc + (long)(t) * 64 * 512, (unsigned)__builtin_amdgcn_readfirstlane(kdst + (so))); glds16(ksrc + (long)(t) * 64 * 512 + 64, (unsigned)__builtin_amdgcn_readfirstlane(kdst + 8192 + (so))); \
        glds16(vsrc + (long)(t) * 64 * 512, (unsigned)__builtin_amdgcn_readfirstlane(vdst + (so))); glds16(vsrc + (long)(t) * 64 * 512 + 64, (unsigned)__builtin_amdgcn_readfirstlane(vdst + 8192 + (so))); } while (0)
    if ((PV & 8) == 0) { DIFF_DMA(0, 0); DIFF_DMA(1, STG_D); }
    const bf16_t* Qw = DQ + (rowbase + qrow) * 512 + h * 128 + map * 64;
    bf16x8 qr[4];
#pragma unroll
    for (int d0 = 0; d0 < 4; ++d0) qr[d0] = *(const bf16x8*)(Qw + d0 * 16 + hi * 8);
    asm volatile("" : "+v"(qr[0]), "+v"(qr[1]), "+v"(qr[2]), "+v"(qr[3]));
    const lds_cptr kp0 = shm3 + map * 8192 + r32 * 128; const int ksw = (r32 >> 1) & 7;
    const lds_cptr vp0 = shm3 + 16384 + ((lane >> 4) & 1) * 32 + (lane & 3) * 8 + (4 * hi + ((lane & 15) >> 2)) * 64;
    float m = 0.f, l = 0.f; f32x16 o[4]; o[0] = f32x16{}; o[1] = f32x16{}; o[2] = f32x16{}; o[3] = f32x16{};
    f32x16 negm = f32x16{}; asm volatile("" : "+v"(negm));
    int so = 0, so2 = 2 * STG_D;
    for (int t = 0; t < NT; ++t) {
        if ((PV & 8) == 0) { if (t + 1 < NT) ATT_WAIT_BAR(4); else ATT_WAIT_BAR(0); } else ATT_BAR();
        bf16x8 kf[8];
        if ((PV & 4) == 0 && t <= tl) kload(kf, kp0 + so, hi, ksw);
        if ((PV & 8) == 0 && t + 2 < NT) DIFF_DMA(t + 2, so2);
        if (t <= tl) {
            f32x16 p0 = negm, p1 = negm; VFrag va, vb;
            if ((PV & 1) == 0) vload(va, vp0 + so, 0);
            ATT_SBAR();
            if ((PV & 4) == 0) qk_mma(p0, p1, kf, qr);
            asm volatile("s_nop 15\n\ts_nop 7" : "+v"(p0), "+v"(p1));
            ATT_SBAR();
            u32x4 pw[4];
            if ((PV & 2) == 0) softmax_tile<4, true>(p0, p1, m, l, o, pw, negm, t == 0); else { pw[0] = (u32x4){__float_as_uint(p0[0]), __float_as_uint(p0[1]), __float_as_uint(p1[0]), __float_as_uint(p1[1])}; pw[1] = pw[0]; pw[2] = pw[0]; pw[3] = pw[0]; }
            ATT_SBAR();
            if ((PV & 1) == 0) { vload(vb, vp0 + so, 1);
            pv_block(o[0], va, pw);
            ATT_SBAR();
            vload(va, vp0 + so, 2);
            pv_block(o[1], vb, pw);
            ATT_SBAR();
            vload(vb, vp0 + so, 3);
            pv_block(o[2], va, pw);
            ATT_SBAR();
            pv_block(o[3], vb, pw); } else { o[0][0] += __uint_as_float(pw[0][0]); o[1][0] += __uint_as_float(pw[1][1]); }
            ATT_SBAR();
        }
        so = (so == 2 * STG_D) ? 0 : so + STG_D; so2 = (so2 == 2 * STG_D) ? 0 : so2 + STG_D;
    }
#undef DIFF_DMA
    l = swapsum(l);
    const float inv = __builtin_amdgcn_rcpf(l);
    ATT_BAR();
    LAS float* xch = (LAS float*)shm3 + (wq * 64) * 64 + lane;
    if (map == 1) {
#pragma unroll
        for (int d = 0; d < 4; ++d)
#pragma unroll
            for (int r = 0; r < 16; ++r) xch[(d * 16 + r) * 64] = o[d][r] * inv;
    }
    ATT_BAR();
    if (map == 0) {
        float ss = 0.f;
#pragma unroll
        for (int d = 0; d < 4; ++d)
#pragma unroll
            for (int r = 0; r < 16; ++r) { const float a = o[d][r] * inv - lam * xch[(d * 16 + r) * 64]; o[d][r] = a; ss += a * a; }
        ss = swapsum(ss);
        const float rn = __builtin_amdgcn_rsqf(ss * (1.0f / 128.0f) + NORM_EPS) * post;
        if constexpr (F8O) {
            unsigned char* Ow = (unsigned char*)AO + (rowbase + qrow) * 1024 + h * 128 + 8 * hi;
#pragma unroll
            for (int d = 0; d < 4; ++d)
#pragma unroll
                for (int g = 0; g < 4; g += 2) { const f32x4 sa = *(const f32x4*)(subg + d * 32 + 8 * g + 4 * hi), sb = *(const f32x4*)(subg + d * 32 + 8 * g + 8 + 4 * hi);
                    const unsigned wa = pack4_fp8(o[d][4 * g] * rn * sa[0], o[d][4 * g + 1] * rn * sa[1], o[d][4 * g + 2] * rn * sa[2], o[d][4 * g + 3] * rn * sa[3]);
                    const unsigned wb = pack4_fp8(o[d][4 * g + 4] * rn * sb[0], o[d][4 * g + 5] * rn * sb[1], o[d][4 * g + 6] * rn * sb[2], o[d][4 * g + 7] * rn * sb[3]);
                    auto r = __builtin_amdgcn_permlane32_swap(wa, wb, false, false);
                    *(u32x2*)(Ow + d * 32 + 8 * g) = (u32x2){r[0], r[1]}; }
        } else {
        bf16_t* Ow = AO + (rowbase + qrow) * 1024 + h * 128 + 8 * hi;
#pragma unroll
        for (int d = 0; d < 4; ++d)
#pragma unroll
            for (int g = 0; g < 4; g += 2) { const f32x4 sa = *(const f32x4*)(subg + d * 32 + 8 * g + 4 * hi), sb = *(const f32x4*)(subg + d * 32 + 8 * g + 8 + 4 * hi);
                u32x2 wa, wb;
                wa.x = cvt_pk_bf16(o[d][4 * g] * rn * sa[0], o[d][4 * g + 1] * rn * sa[1]); wa.y = cvt_pk_bf16(o[d][4 * g + 2] * rn * sa[2], o[d][4 * g + 3] * rn * sa[3]);
                wb.x = cvt_pk_bf16(o[d][4 * g + 4] * rn * sb[0], o[d][4 * g + 5] * rn * sb[1]); wb.y = cvt_pk_bf16(o[d][4 * g + 6] * rn * sb[2], o[d][4 * g + 7] * rn * sb[3]);
                *(u32x4*)(Ow + d * 32 + 8 * g) = widen_pair(wa, wb); }
        }
    }
    ATT_BAR();
}
}

struct Args {
    const float* x; const float* c; const int* pos; const float* ada_w; const float* ada_b; const float* norm_mix; const float* norm_ffn; const float* w_in;
    const float* b_forget; const float* lq1; const float* lk1; const float* lq2; const float* lk2; const float* subln; const float* w_out; const float* router_w;
    const float* router_b; const float* w1; const float* b1; const float* w2; const float* b2; const float* final_norm;
    float* out; unsigned char* ws; int ph_lo, ph_hi;
};

__device__ __forceinline__ void transpose_item(const float* W, int ldw, int K, bf16_t* WT, int k0, int n0, int drow, LAS float* scr, int lane) {
    float ld_[32];
#pragma unroll
    for (int i = 0; i < 32; ++i) ld_[i] = W[(size_t)(k0 + 2 * i + (lane >> 5)) * ldw + n0 + (lane & 31)];
#pragma unroll
    for (int i = 0; i < 32; ++i) scr[(2 * i + (lane >> 5)) * 33 + (lane & 31)] = ld_[i];
    asm volatile("s_waitcnt lgkmcnt(0)" ::: "memory");
    const int c = lane & 7;
#pragma unroll
    for (int j = 0; j < 4; ++j) { const int n = (lane >> 3) + 8 * j; const LAS float* s = scr + (8 * c) * 33 + n;
        u32x4 o; o.x = cvt_pk_bf16(s[0 * 33], s[1 * 33]); o.y = cvt_pk_bf16(s[2 * 33], s[3 * 33]); o.z = cvt_pk_bf16(s[4 * 33], s[5 * 33]); o.w = cvt_pk_bf16(s[6 * 33], s[7 * 33]);
        *(u32x4*)(WT + (size_t)(drow + n) * K + k0 + 8 * c) = o; }
    asm volatile("s_waitcnt lgkmcnt(0)" ::: "memory");
}

__device__ __forceinline__ void transpose_item_f8(const float* W, int ldw, int K, unsigned char* WT, int k0, int n0, int drow, LAS float* scr, int lane) {
    float ld_[32];
#pragma unroll
    for (int i = 0; i < 32; ++i) ld_[i] = W[(size_t)(k0 + 2 * i + (lane >> 5)) * ldw + n0 + (lane & 31)];
#pragma unroll
    for (int i = 0; i < 32; ++i) scr[(2 * i + (lane >> 5)) * 33 + (lane & 31)] = ld_[i];
    asm volatile("s_waitcnt lgkmcnt(0)" ::: "memory");
    const int c = lane & 7;
#pragma unroll
    for (int j = 0; j < 4; ++j) { const int n = (lane >> 3) + 8 * j; const LAS float* s = scr + (8 * c) * 33 + n;
        u32x2 o; o.x = pack4_fp8(s[0 * 33] * 32.f, s[1 * 33] * 32.f, s[2 * 33] * 32.f, s[3 * 33] * 32.f); o.y = pack4_fp8(s[4 * 33] * 32.f, s[5 * 33] * 32.f, s[6 * 33] * 32.f, s[7 * 33] * 32.f);
        *(u32x2*)(WT + (size_t)(drow + n) * K + k0 + 8 * c) = o; }
    asm volatile("s_waitcnt lgkmcnt(0)" ::: "memory");
}

#define CB(j) (512 * ((j) >> 1) + 8 * lane + 4 * ((j) & 1))
template <bool F8OUT>
__device__ __forceinline__ void norm1_row(const f32x4 (&v)[4], const f32x4 (&gm)[4], const f32x4 (&sh)[4], const LAS float* wft, const float* bfor, bf16_t* xnrow, float* LF, int b, int s, int lane) {
    float ss = 0.f;
#pragma unroll
    for (int j = 0; j < 4; ++j) ss += (v[j][0] * v[j][0] + v[j][1] * v[j][1]) + (v[j][2] * v[j][2] + v[j][3] * v[j][3]);
    const float rstd = __builtin_amdgcn_rsqf(wave_sum(ss) * (1.0f / DM) + NORM_EPS);
    f32x4 hv[4];
#pragma unroll
    for (int j = 0; j < 4; ++j) hv[j] = v[j] * rstd * gm[j] + sh[j];
#pragma unroll
    for (int jj = 0; jj < 2; ++jj) { const f32x4 a = hv[2 * jj], c = hv[2 * jj + 1];
        if constexpr (F8OUT) { u32x2 w; w.x = pack4_fp8(a[0], a[1], a[2], a[3]); w.y = pack4_fp8(c[0], c[1], c[2], c[3]); *(u32x2*)((unsigned char*)xnrow + 512 * jj + 8 * lane) = w; }
        else { u32x4 w; w.x = cvt_pk_bf16(a[0], a[1]); w.y = cvt_pk_bf16(a[2], a[3]); w.z = cvt_pk_bf16(c[0], c[1]); w.w = cvt_pk_bf16(c[2], c[3]); *(u32x4*)(xnrow + 512 * jj + 8 * lane) = w; } }
    float a8[8];
#pragma unroll
    for (int hh = 0; hh < 8; ++hh) { float a = 0.f;
#pragma unroll
        for (int j = 0; j < 4; ++j) { const f32x4 w = *(const LAS f32x4*)(wft + hh * DM + CB(j)); a += (hv[j][0] * w[0] + hv[j][1] * w[1]) + (hv[j][2] * w[2] + hv[j][3] * w[3]); }
        a8[hh] = a; }
    float a4[4], a2[2], a1;
    { const bool up = (lane & 32) != 0;
#pragma unroll
      for (int i = 0; i < 4; ++i) { const float snd = up ? a8[i] : a8[i + 4], kp = up ? a8[i + 4] : a8[i]; a4[i] = kp + __shfl_xor(snd, 32); } }
    { const bool up = (lane & 16) != 0;
#pragma unroll
      for (int i = 0; i < 2; ++i) { const float snd = up ? a4[i] : a4[i + 2], kp = up ? a4[i + 2] : a4[i]; a2[i] = kp + __shfl_xor(snd, 16); } }
    { const bool up = (lane & 8) != 0; const float snd = up ? a2[0] : a2[1], kp = up ? a2[1] : a2[0]; a1 = kp + __shfl_xor(snd, 8); }
    a1 += __shfl_xor(a1, 4); a1 += __shfl_xor(a1, 2); a1 += __shfl_xor(a1, 1);
    if ((lane & 7) == 0) { const int hd = lane >> 3; const float z = a1 + bfor[hd];
        const float lf = (z >= 0.f) ? -log1pf(__expf(-z)) : (z - log1pf(__expf(z)));
        LF[(size_t)(b * 8 + hd) * SEQ + s] = lf; }
}

__global__ void __launch_bounds__(NTHR, 2) fwd_kernel(Args args) {
    extern __shared__ __attribute__((aligned(16))) unsigned char lds[];
    LAS unsigned char* L = (LAS unsigned char*)lds;
    int tid = threadIdx.x, lane = tid & 63, wave = __builtin_amdgcn_readfirstlane(tid >> 6);
#define FRESH_IDS() do { tid = fresh_tid(); lane = tid & 63; wave = __builtin_amdgcn_readfirstlane(tid >> 6); gw = vcu * NWAVES + wave; } while (0)
    const int G = gridDim.x; const int bx = blockIdx.x; const int vcu = (G % 8 == 0) ? (bx % 8) * (G / 8) + bx / 8 : bx;
#define WSPTRS() unsigned char* ws = args.ws; asm volatile("" : "+s"(ws)); \
    unsigned* ctl = (unsigned*)(ws + WS_CTL); (void)ctl; \
    bf16_t* WQ = (bf16_t*)(ws + WS_WQ); float* BQ = (float*)(ws + WS_BQ); (void)WQ; (void)BQ; \
    float* MOD = (float*)(ws + WS_MOD); float* RWT = (float*)(ws + WS_RWT); float* WFT = (float*)(ws + WS_WFT); float* ROPE = (float*)(ws + WS_ROPE); \
    float* NCK = (float*)(ws + WS_NCK); float* LF = (float*)(ws + WS_LF); float* GATES = (float*)(ws + WS_GATES); int* ROWL = (int*)(ws + WS_ROWL); \
    bf16_t* WIN = (bf16_t*)(ws + WS_WIN); bf16_t* WOUT = (bf16_t*)(ws + WS_WOUT); unsigned char* W1T = ws + WS_W1; unsigned char* W2T = ws + WS_W2; \
    bf16_t* XN = (bf16_t*)(ws + WS_XN); bf16_t* QKV = (bf16_t*)(ws + WS_QKV); bf16_t* AO = (bf16_t*)(ws + WS_AO); \
    float* X1 = (float*)(ws + WS_X1); float* X2 = (float*)(ws + WS_X2); unsigned char* XN2 = ws + WS_XN2; unsigned char* HID = ws + WS_HID; bf16_t* Y = (bf16_t*)(ws + WS_Y); \
    (void)MOD; (void)RWT; (void)WFT; (void)ROPE; (void)NCK; (void)LF; (void)GATES; (void)ROWL; (void)WIN; (void)WOUT; (void)W1T; (void)W2T; (void)XN; (void)QKV; (void)AO; (void)X1; (void)X2; (void)XN2; (void)HID; (void)Y
    for (int u = tid; u < 256; u += NTHR) ((LAS unsigned*)(L + MISC_OFF))[u] = 0u;
    __syncthreads();
#if MK_MULTI
#define GRID_BAR() do { } while (0)
#else
    XcdBarrier bar = xcd_barrier_post((unsigned*)(args.ws + WS_CTL) + CW_BAR, (volatile LAS unsigned*)(L + L_XBST));
#define GRID_BAR() xcd_barrier(bar)
#endif
    long tacc = 0;
    TP_BEGIN(30)
    const int lo = args.ph_lo, hi_ = args.ph_hi;
#ifndef PH_MASK
#define PH_MASK 0x1ff
#endif
#define IN(k) (lo <= (k) && (k) < hi_)
#define ON(j) (((PH_MASK) >> (j)) & 1)
#ifndef REP_MASK
#define REP_MASK 0
#endif
#define NREP(j) (1 + (((REP_MASK) >> (j)) & 1))
#define BOTH(k) (IN(k) && IN((k) + 1))
    int gw = vcu * NWAVES + wave; const int NGW = G * NWAVES;

    if (ON(0) && IN(0)) { TP_BEGIN(20)
        FRESH_IDS(); WSPTRS();
        for (int rep_ = 0; rep_ < NREP(0); ++rep_) {
        TP_BEGIN(31)
        {
            LAS float* cact = (LAS float*)(L + 73728);
            LAS float* part = (LAS float*)(L + 73728 + 32768);
            for (int i = tid; i < 8 * DM; i += NTHR) { const float cv = args.c[i]; cact[i] = cv / (1.0f + __expf(-cv)); }
            __syncthreads();
            for (int it = vcu; it < 256; it += G) {
                const int l = it >> 7, j0 = (it & 127) * 48; const bool on = lane < 48;
                const float* aw = args.ada_w + (size_t)l * DM * 6144 + j0 + (on ? lane : 0);
                float a8[8] = {0.f, 0.f, 0.f, 0.f, 0.f, 0.f, 0.f, 0.f};
                for (int kc = 0; kc < 4; ++kc) { const int kb = wave * 128 + kc * 32; float av[32];
#pragma unroll
                    for (int i = 0; i < 32; ++i) av[i] = aw[(size_t)(kb + i) * 6144];
#pragma unroll
                    for (int i = 0; i < 32; ++i)
#pragma unroll
                        for (int b = 0; b < 8; ++b) a8[b] += cact[b * DM + kb + i] * av[i]; }
#pragma unroll
                for (int b = 0; b < 8; ++b) part[(wave * 8 + b) * 64 + lane] = a8[b];
                __syncthreads();
                { const int b = tid >> 6; float s = 0.f;
#pragma unroll
                  for (int w = 0; w < 8; ++w) s += part[(w * 8 + b) * 64 + lane];
                  if (on) MOD[((size_t)l * 8 + b) * 6144 + j0 + lane] = s + args.ada_b[l * 6144 + j0 + lane]; }
                __syncthreads();
            }
        }
        TP_END(31) TP_BEGIN(32)
        {
            const int gt = vcu * NTHR + tid, NGT = G * NTHR;
            const double invf[8] = {1.0, 0.1939227432012558, 0.03760603070259094, 0.007292664609849453, 0.0014142135623842478, 0.00027424818836152554, 5.3182957344688475e-05, 1.0313385246263351e-05};
            for (int i = gt; i < NTOK * 8; i += NGT) { const int tok = i >> 3, j = i & 7;
                double iv = invf[0];
#pragma unroll
                for (int q = 1; q < 8; ++q) iv = (j == q) ? invf[q] : iv;
                double rev = (double)args.pos[tok] * iv * 0.15915494309189535; rev -= rint(rev); const float fr_ = (float)rev;
                ROPE[(size_t)tok * 16 + j] = __builtin_amdgcn_cosf(fr_); ROPE[(size_t)tok * 16 + 8 + j] = __builtin_amdgcn_sinf(fr_); }
            for (int i = gt; i < DEPTH * NEXP * DM; i += NGT) { const int l = i / (NEXP * DM), r = i % (NEXP * DM), e = r / DM, k = r % DM; RWT[i] = args.router_w[((size_t)l * DM + k) * NEXP + e]; }
            for (int i = gt; i < DEPTH * 8 * DM; i += NGT) { const int l = i / (8 * DM), r = i % (8 * DM), hh = r / DM, k = r % DM; WFT[i] = args.w_in[((size_t)l * DM + k) * INCOLS + 3072 + hh]; }
        }
        TP_END(32) TP_BEGIN(33)
        {
            LAS float* tile = (LAS float*)L;
            constexpr int TS = 265;
            constexpr int I_IN = 16 * 12, I_OUT = 16 * 4, I_1 = 16 * 8, I_2 = 16 * 4;
            constexpr int T_IN = DEPTH * I_IN, T_OUT = DEPTH * I_OUT, T_1 = DEPTH * NEXP * I_1, T_2 = DEPTH * NEXP * I_2, T_ALL = T_IN + T_OUT + T_1 + T_2;
            struct Desc { const float* W; unsigned char* WT; int ldw, k0, n0, kind; };
            auto desc = [&](int it) { Desc d; int r = it;
                if (r < T_IN) { const int l = r / I_IN, q = r % I_IN, kb = q / 12, nb = q % 12;
                    d.W = args.w_in + (size_t)l * DM * INCOLS; d.ldw = INCOLS; d.k0 = kb * 64; d.n0 = nb * 256; d.kind = (l != 0) ? 1 : 0;
                    d.WT = (l == 0) ? (unsigned char*)WIN : (unsigned char*)(WIN + (size_t)3072 * DM); return d; }
                r -= T_IN;
                if (r < T_OUT) { const int l = r / I_OUT, q = r % I_OUT, kb = q / 4, nb = q % 4;
                    d.W = args.w_out + (size_t)l * DM * DM; d.ldw = DM; d.k0 = kb * 64; d.n0 = nb * 256; d.kind = (l != 0) ? 1 : 0; d.WT = (unsigned char*)(WOUT + (size_t)l * DM * DM); return d; }
                r -= T_OUT;
                if (r < T_1) { const int le = r / I_1, q = r % I_1, kb = q / 8, nb = q % 8;
                    d.W = args.w1 + (size_t)le * DM * 2048; d.ldw = 2048; d.k0 = kb * 64; d.n0 = nb * 256; d.kind = 2; d.WT = W1T + (size_t)le * 2048 * DM; return d; }
                r -= T_1;
                { const int le = r / I_2, q = r % I_2, kb = q / 4, nb = q % 4;
                    d.W = args.w2 + (size_t)le * DM * DM; d.ldw = DM; d.k0 = kb * 64; d.n0 = nb * 256; d.kind = 1; d.WT = W2T + (size_t)le * DM * DM; return d; } };
            f32x4 lda[8], ldb[8], ldq[8]; Desc da, db, dq;
#define P0_LOAD(ld_, d_, it_) do { d_ = desc((it_) < T_ALL ? (it_) : 0); if ((it_) < T_ALL) { _Pragma("unroll") for (int i = 0; i < 8; ++i) ld_[i] = *(const f32x4*)(d_.W + (size_t)(d_.k0 + 8 * wave + i) * d_.ldw + d_.n0 + 4 * lane); } } while (0)
#define P0_PROC(ld_, d_) do { \
                _Pragma("unroll") for (int i = 0; i < 8; ++i) { LAS float* tp = tile + (8 * wave + i) * TS + 4 * lane + (lane >> 3); tp[0] = ld_[i][0]; tp[1] = ld_[i][1]; tp[2] = ld_[i][2]; tp[3] = ld_[i][3]; } \
                __syncthreads(); \
                { const int c = lane & 7; \
                _Pragma("unroll") for (int r2 = 0; r2 < 4; ++r2) { const int nr = 32 * wave + 8 * r2 + (lane >> 3); const LAS float* sp = tile + (8 * c) * TS + nr + (nr >> 5); \
                    const int n = d_.n0 + nr; \
                    const int drow = (d_.kind == 2) ? ((n < 1024) ? ((n >> 7) * 256 + (n & 127)) : ((((n - 1024) >> 7) * 256) + 128 + ((n - 1024) & 127))) : n; \
                    if (d_.kind != 0) { u32x2 o; o.x = pack4_fp8(sp[0 * TS] * 32.f, sp[1 * TS] * 32.f, sp[2 * TS] * 32.f, sp[3 * TS] * 32.f); o.y = pack4_fp8(sp[4 * TS] * 32.f, sp[5 * TS] * 32.f, sp[6 * TS] * 32.f, sp[7 * TS] * 32.f); \
                        *(u32x2*)(d_.WT + (size_t)drow * DM + d_.k0 + 8 * c) = o; } \
                    else { u32x4 o; o.x = cvt_pk_bf16(sp[0 * TS], sp[1 * TS]); o.y = cvt_pk_bf16(sp[2 * TS], sp[3 * TS]); o.z = cvt_pk_bf16(sp[4 * TS], sp[5 * TS]); o.w = cvt_pk_bf16(sp[6 * TS], sp[7 * TS]); \
                        *(u32x4*)((bf16_t*)d_.WT + (size_t)drow * DM + d_.k0 + 8 * c) = o; } } } \
                __syncthreads(); } while (0)
            int it = vcu;
            P0_LOAD(lda, da, it); P0_LOAD(ldb, db, it + G);
            __syncthreads();
            for (; it < T_ALL; it += 3 * G) {
                P0_LOAD(ldq, dq, it + 2 * G);
                P0_PROC(lda, da);
                if (it + G >= T_ALL) break;
                P0_LOAD(lda, da, it + 3 * G);
                P0_PROC(ldb, db);
                if (it + 2 * G >= T_ALL) break;
                P0_LOAD(ldb, db, it + 4 * G);
                P0_PROC(ldq, dq);
            }
#undef P0_LOAD
#undef P0_PROC
        }
        TP_END(33)
        } if (BOTH(0)) GRID_BAR(); TP_END(20)
    }

    if (ON(1) && IN(1)) { TP_BEGIN(21)
        FRESH_IDS(); WSPTRS();
        for (int rep_ = 0; rep_ < NREP(1); ++rep_) {
        for (int i = vcu * NTHR + tid; i < DEPTH * 8 * 32 * 2 * 64; i += G * NTHR) {
            const int ln = i & 63, blk = (i >> 6) & 1, sq = (i >> 7) & 31, bb = (i >> 12) & 7, ll = i >> 15;
            const int e = 16 * blk + (ln & 15), k0 = 32 * sq + 8 * (ln >> 4);
            const float* md = MOD + ((size_t)ll * 8 + bb) * 6144 + 4 * 1024;
            float w[8]; unsigned hi4[4], lo4[4];
#pragma unroll
            for (int j = 0; j < 8; ++j) w[j] = args.router_w[((size_t)ll * DM + k0 + j) * NEXP + e] * args.norm_ffn[ll * DM + k0 + j] * (1.0f + md[k0 + j]);
#pragma unroll
            for (int j = 0; j < 4; ++j) { hi4[j] = cvt_pk_bf16(w[2 * j], w[2 * j + 1]); lo4[j] = cvt_pk_bf16(w[2 * j] - bf_lo(hi4[j]), w[2 * j + 1] - bf_hi(hi4[j])); }
            u32x4* dst = (u32x4*)(WQ + ((((size_t)(ll * 8 + bb) * 32 + sq) * 2 + blk) * 2) * 64 * 8);
            dst[ln] = (u32x4){hi4[0], hi4[1], hi4[2], hi4[3]}; dst[64 + ln] = (u32x4){lo4[0], lo4[1], lo4[2], lo4[3]};
        }
        for (int i = gw; i < DEPTH * 8 * 32; i += NGW) { const int e = i & 31, bb = (i >> 5) & 7, ll = i >> 8;
            const float* md = MOD + ((size_t)ll * 8 + bb) * 6144 + 3 * 1024; float a = 0.f;
#pragma unroll 4
            for (int j = 0; j < 16; ++j) { const int k = lane + 64 * j; a += md[k] * args.router_w[((size_t)ll * DM + k) * NEXP + e]; }
            a = wave_sum(a); if (lane == 0) BQ[i] = a + args.router_b[ll * NEXP + e]; }
        LAS float* wft = (LAS float*)L;
        for (int i = tid; i < 8 * DM; i += NTHR) wft[i] = WFT[i];
        __syncthreads();
        for (int ch = gw; ch < NTOK / 16; ch += NGW) {
            const int b = ch >> 8; const float* mod = MOD + (size_t)b * 6144;
            f32x4 gm[4], sh[4];
#pragma unroll
            for (int j = 0; j < 4; ++j) { const int c0 = CB(j); const f32x4 g = *(const f32x4*)(args.norm_mix + c0), sc = *(const f32x4*)(mod + 1024 + c0); gm[j] = g * (sc + 1.0f); sh[j] = *(const f32x4*)(mod + c0); }
#pragma unroll 2
            for (int rr = 0; rr < 16; ++rr) { const int mrow = ch * 16 + rr;
                f32x4 v[4];
#pragma unroll
                for (int j = 0; j < 4; ++j) v[j] = *(const f32x4*)(args.x + (size_t)mrow * DM + CB(j));
                norm1_row<false>(v, gm, sh, wft, args.b_forget, XN + (size_t)mrow * DM, LF, b, mrow & (SEQ - 1), lane); }
        }
        __syncthreads();
        } if (BOTH(1)) GRID_BAR(); TP_END(21)
    }

    for (int l = 0; l < DEPTH; ++l) {
        const int pb = 2 + 7 * l;
#define modl (MOD + (size_t)l * 8 * 6144)
#define xin ((l == 0) ? args.x : (const float*)X2)
        if (ON(2) && IN(pb + 0)) { TP_BEGIN(22)
            FRESH_IDS(); WSPTRS();
        for (int rep_ = 0; rep_ < NREP(2); ++rep_) {
            if (vcu < 64) {
                const float* src = LF + (size_t)vcu * SEQ + 8 * tid; float* dst = NCK + (size_t)vcu * SEQ + 8 * tid;
                f32x4 a = *(const f32x4*)src, c2 = *(const f32x4*)(src + 4);
                float e[8] = {a[0], a[1], a[2], a[3], c2[0], c2[1], c2[2], c2[3]};
#pragma unroll
                for (int i = 1; i < 8; ++i) e[i] += e[i - 1];
                float tot = e[7], inc = tot;
#pragma unroll
                for (int o = 1; o < 64; o <<= 1) { const float n = __shfl_up(inc, o); if (lane >= o) inc += n; }
                LAS float* sc = (LAS float*)(L + L_SCAN);
                if (lane == 63) sc[wave] = inc;
                __syncthreads();
                float pre = inc - tot;
                for (int w = 0; w < wave; ++w) pre += sc[w];
                f32x4 o0, o1;
                o0[0] = -(e[0] + pre) * LOG2E; o0[1] = -(e[1] + pre) * LOG2E; o0[2] = -(e[2] + pre) * LOG2E; o0[3] = -(e[3] + pre) * LOG2E;
                o1[0] = -(e[4] + pre) * LOG2E; o1[1] = -(e[5] + pre) * LOG2E; o1[2] = -(e[6] + pre) * LOG2E; o1[3] = -(e[7] + pre) * LOG2E;
                *(f32x4*)dst = o0; *(f32x4*)(dst + 4) = o1;
            }
            __syncthreads();
            if (l == 0) {
                pg8::SchedDense S{(const char*)XN, (const char*)WIN, 12, (NTOK / 256) * 12, G, vcu, DM};
                const pg8::EpiInProj E{QKV, ROPE, ctl + CW_KN + l * 128, 1.0f};
                pg8::gemm_phase<pg8::EpiInProj, pg8::SchedDense, true>(L, DM, S, E, tacc);
            } else {
                pg8::SchedDenseG S{(const char*)XN, (const char*)(WIN + (size_t)3072 * DM), 12, (NTOK / 256) * 12, G, vcu, DM};
                const pg8::EpiInProj E{QKV, ROPE, ctl + CW_KN + l * 128, 0.03125f};
                pg8::gemm_phase<pg8::EpiInProj, pg8::SchedDenseG, true, true>(L, DM, S, E, tacc);
            }
            } if (BOTH(pb + 0)) GRID_BAR(); TP_END(22)
        }
        if (ON(3) && IN(pb + 1)) { TP_BEGIN(23)
            FRESH_IDS(); WSPTRS();
        for (int rep_ = 0; rep_ < NREP(3); ++rep_) {
            const bf16_t* DQ = QKV; const bf16_t* DK = QKV + (size_t)NTOK * 512; const bf16_t* DV = QKV + (size_t)2 * NTOK * 512;
            const bf16_t* FQ = QKV + (size_t)3 * NTOK * 512; const bf16_t* FK = QKV + (size_t)4 * NTOK * 512; const bf16_t* FV = QKV + (size_t)5 * NTOK * 512;
            const float lam_init = 0.8f - 0.6f * expf(-0.3f * (float)l);
            const float s1 = wave_sum(args.lq1[l * 64 + lane] * args.lk1[l * 64 + lane]), s2 = wave_sum(args.lq2[l * 64 + lane] * args.lk2[l * 64 + lane]);
            const float lam = expf(s1) - expf(s2) + lam_init;
#ifndef ATT_PV
#define ATT_PV 0
#endif
            if (l == 0) {
            for (int p = vcu; p < 512; p += G) { const int bh = p >> 3, s = p & 7;
                att::fox_unit<0, false>(bh >> 3, bh & 7, 15 - s, FQ, FK, FV, NCK, ctl + CW_KN + l * 128, AO, (char*)lds);
                att::fox_unit<0, false>(bh >> 3, bh & 7, s, FQ, FK, FV, NCK, ctl + CW_KN + l * 128, AO, (char*)lds); }
            for (int p = vcu; p < 512; p += G) { const int bh = p >> 4, s = p & 15;
                att::diff_unit<0, false>(bh >> 2, bh & 3, 31 - s, DQ, DK, DV, args.subln + l * 128, lam, 1.0f - lam_init, AO, (char*)lds);
                att::diff_unit<0, false>(bh >> 2, bh & 3, s, DQ, DK, DV, args.subln + l * 128, lam, 1.0f - lam_init, AO, (char*)lds); }
            } else {
            for (int p = vcu; p < 512; p += G) { const int bh = p >> 3, s = p & 7;
                att::fox_unit<0, true>(bh >> 3, bh & 7, 15 - s, FQ, FK, FV, NCK, ctl + CW_KN + l * 128, AO, (char*)lds);
                att::fox_unit<0, true>(bh >> 3, bh & 7, s, FQ, FK, FV, NCK, ctl + CW_KN + l * 128, AO, (char*)lds); }
            for (int p = vcu; p < 512; p += G) { const int bh = p >> 4, s = p & 15;
                att::diff_unit<0, true>(bh >> 2, bh & 3, 31 - s, DQ, DK, DV, args.subln + l * 128, lam, 1.0f - lam_init, AO, (char*)lds);
                att::diff_unit<0, true>(bh >> 2, bh & 3, s, DQ, DK, DV, args.subln + l * 128, lam, 1.0f - lam_init, AO, (char*)lds); }
            }
            } if (BOTH(pb + 1)) GRID_BAR(); TP_END(23)
        }
        if (ON(4) && IN(pb + 2)) { TP_BEGIN(24)
            FRESH_IDS(); WSPTRS();
        for (int rep_ = 0; rep_ < NREP(4); ++rep_) {
            if (l == 0) {
                pg8::SchedDense S{(const char*)AO, (const char*)WOUT, 4, (NTOK / 256) * 4, G, vcu, DM};
                const pg8::EpiOutProj E{xin, X1, modl + 2 * 1024, 1.0f};
                pg8::gemm_phase<pg8::EpiOutProj, pg8::SchedDense, true>(L, DM, S, E, tacc);
            } else {
                pg8::SchedDenseG S{(const char*)AO, (const char*)(WOUT + (size_t)DM * DM), 4, (NTOK / 256) * 4, G, vcu, DM};
                const pg8::EpiOutProj E{xin, X1, modl + 2 * 1024, 0.03125f};
                pg8::gemm_phase<pg8::EpiOutProj, pg8::SchedDenseG, true, true>(L, DM, S, E, tacc);
            }
            } if (BOTH(pb + 2)) GRID_BAR(); TP_END(24)
        }
        if (ON(5) && IN(pb + 3)) { TP_BEGIN(25)
            FRESH_IDS(); WSPTRS();
            LAS u32x4* wq = (LAS u32x4*)L;
            LAS float* rsl = (LAS float*)(L + IDX_OFF) + wave * 16;
            LAS float* bql = (LAS float*)(L + IDX_OFF + 1024);
            LAS int* hist = (LAS int*)(L + L_HIST); LAS int* basel = (LAS int*)(L + L_BASE);
            const int nch = NTOK / 16, niter = (nch + NGW - 1) / NGW;
            int bcur = -1;
            if (tid < 32) hist[tid] = 0;
            unsigned* cntg = ctl + CW_CNT + l * 32 * 64;
            for (int itr = 0; itr < niter; ++itr) {
                const int ch = itr * NGW + gw; const bool act = ch < nch;
                const int bwg = ((itr * NGW + vcu * NWAVES) >> 8) & 7;
                if (bwg != bcur) { __syncthreads(); bcur = bwg;
                    const u32x4* src = (const u32x4*)(WQ + (size_t)(l * 8 + bwg) * 32 * 2 * 2 * 64 * 8);
                    for (int i = tid; i < 32 * 2 * 2 * 64; i += NTHR) wq[i] = src[i];
                    if (tid < 32) bql[tid] = BQ[(l * 8 + bwg) * 32 + tid];
                    __syncthreads(); }
                int te[4] = {0, 0, 0, 0}, lr[4] = {0, 0, 0, 0}; float tg[4] = {0.f, 0.f, 0.f, 0.f};
                for (int rep_ = 0; rep_ < NREP(5); ++rep_)
                if (act) {
                    const int b = ch >> 8; const float* mod = modl + (size_t)b * 6144;
                    const int tk = lane & 15, kg = lane >> 4;
                    const float* xr = X1 + (size_t)(ch * 16 + tk) * DM + 8 * kg;
                    f32x4 acc0 = {0.f, 0.f, 0.f, 0.f}, acc1 = acc0; float ssq = 0.f;
#pragma unroll 4
                    for (int sq = 0; sq < 32; ++sq) {
                        const f32x4 xa = *(const f32x4*)(xr + 32 * sq), xb = *(const f32x4*)(xr + 32 * sq + 4);
                        ssq += (xa[0] * xa[0] + xa[1] * xa[1]) + (xa[2] * xa[2] + xa[3] * xa[3]) + (xb[0] * xb[0] + xb[1] * xb[1]) + (xb[2] * xb[2] + xb[3] * xb[3]);
                        u32x4 xh, xl;
                        xh[0] = cvt_pk_bf16(xa[0], xa[1]); xh[1] = cvt_pk_bf16(xa[2], xa[3]); xh[2] = cvt_pk_bf16(xb[0], xb[1]); xh[3] = cvt_pk_bf16(xb[2], xb[3]);
                        xl[0] = cvt_pk_bf16(xa[0] - bf_lo(xh[0]), xa[1] - bf_hi(xh[0])); xl[1] = cvt_pk_bf16(xa[2] - bf_lo(xh[1]), xa[3] - bf_hi(xh[1]));
                        xl[2] = cvt_pk_bf16(xb[0] - bf_lo(xh[2]), xb[1] - bf_hi(xh[2])); xl[3] = cvt_pk_bf16(xb[2] - bf_lo(xh[3]), xb[3] - bf_hi(xh[3]));
                        const bf16x8 bh = __builtin_bit_cast(bf16x8, xh), bl = __builtin_bit_cast(bf16x8, xl);
                        const LAS u32x4* wp = wq + sq * 256 + lane;
                        const bf16x8 w0h = __builtin_bit_cast(bf16x8, wp[0]), w0l = __builtin_bit_cast(bf16x8, wp[64]), w1h = __builtin_bit_cast(bf16x8, wp[128]), w1l = __builtin_bit_cast(bf16x8, wp[192]);
                        acc0 = __builtin_amdgcn_mfma_f32_16x16x32_bf16(w0h, bh, acc0, 0, 0, 0); acc1 = __builtin_amdgcn_mfma_f32_16x16x32_bf16(w1h, bh, acc1, 0, 0, 0);
                        acc0 = __builtin_amdgcn_mfma_f32_16x16x32_bf16(w0l, bh, acc0, 0, 0, 0); acc1 = __builtin_amdgcn_mfma_f32_16x16x32_bf16(w1l, bh, acc1, 0, 0, 0);
                        acc0 = __builtin_amdgcn_mfma_f32_16x16x32_bf16(w0h, bl, acc0, 0, 0, 0); acc1 = __builtin_amdgcn_mfma_f32_16x16x32_bf16(w1h, bl, acc1, 0, 0, 0);
                    }
                    ssq += __shfl_xor(ssq, 16); ssq += __shfl_xor(ssq, 32);
                    const float rstd = __builtin_amdgcn_rsqf(ssq * (1.0f / DM) + NORM_EPS);
                    if (lane < 16) rsl[lane] = rstd;
                    float v0 = -INFINITY, v1 = -INFINITY, v2 = -INFINITY, v3 = -INFINITY; int i0 = 0, i1 = 0, i2 = 0, i3 = 0;
#define TOPK_INS(x_, e_) do { const float xx_ = (x_); const int ee_ = (e_); \
                        if (xx_ > v3 || (xx_ == v3 && ee_ < i3)) { v3 = xx_; i3 = ee_; \
                            if (v3 > v2 || (v3 == v2 && i3 < i2)) { float tf = v2; v2 = v3; v3 = tf; int ti = i2; i2 = i3; i3 = ti; \
                                if (v2 > v1 || (v2 == v1 && i2 < i1)) { tf = v1; v1 = v2; v2 = tf; ti = i1; i1 = i2; i2 = ti; \
                                    if (v1 > v0 || (v1 == v0 && i1 < i0)) { tf = v0; v0 = v1; v1 = tf; ti = i0; i0 = i1; i1 = ti; } } } } } while (0)
#pragma unroll
                    for (int r = 0; r < 4; ++r) { TOPK_INS(acc0[r] * rstd + bql[4 * kg + r], 4 * kg + r); }
#pragma unroll
                    for (int r = 0; r < 4; ++r) { TOPK_INS(acc1[r] * rstd + bql[16 + 4 * kg + r], 16 + 4 * kg + r); }
#pragma unroll
                    for (int st = 16; st <= 32; st <<= 1) {
                        const float p0 = __shfl_xor(v0, st), p1 = __shfl_xor(v1, st), p2 = __shfl_xor(v2, st), p3 = __shfl_xor(v3, st);
                        const int q0 = __shfl_xor(i0, st), q1 = __shfl_xor(i1, st), q2 = __shfl_xor(i2, st), q3 = __shfl_xor(i3, st);
                        TOPK_INS(p0, q0); TOPK_INS(p1, q1); TOPK_INS(p2, q2); TOPK_INS(p3, q3);
                    }
#undef TOPK_INS
                    if (lane < 16) {
                        const float e1 = __expf(v1 - v0), e2 = __expf(v2 - v0), e3 = __expf(v3 - v0); const float rs = 1.0f / (1.0f + e1 + e2 + e3);
                        te[0] = i0; te[1] = i1; te[2] = i2; te[3] = i3; tg[0] = rs; tg[1] = e1 * rs; tg[2] = e2 * rs; tg[3] = e3 * rs;
#pragma unroll
                        for (int k = 0; k < 4; ++k) if (rep_ == NREP(5) - 1) lr[k] = atomicAdd((int*)(lds + L_HIST) + te[k], 1);
                    }
                    f32x4 gm[4], sh[4];
#pragma unroll
                    for (int j = 0; j < 4; ++j) { const int c0 = CB(j); const f32x4 g = *(const f32x4*)(args.norm_ffn + l * DM + c0), sc = *(const f32x4*)(mod + 4 * 1024 + c0); gm[j] = g * (sc + 1.0f); sh[j] = *(const f32x4*)(mod + 3 * 1024 + c0); }
                    asm volatile("s_waitcnt lgkmcnt(0)" ::: "memory");
#pragma unroll 2
                    for (int rr = 0; rr < 16; ++rr) { const int mrow = ch * 16 + rr; const float rs2 = rsl[rr];
#pragma unroll
                        for (int jj = 0; jj < 2; ++jj) { const int c0 = 512 * jj + 8 * lane;
                            const f32x4 va = *(const f32x4*)(X1 + (size_t)mrow * DM + c0) * rs2 * gm[2 * jj] + sh[2 * jj], vc = *(const f32x4*)(X1 + (size_t)mrow * DM + c0 + 4) * rs2 * gm[2 * jj + 1] + sh[2 * jj + 1];
                            u32x2 w; w.x = pack4_fp8(va[0], va[1], va[2], va[3]); w.y = pack4_fp8(vc[0], vc[1], vc[2], vc[3]); *(u32x2*)(XN2 + (size_t)mrow * DM + c0) = w; } }
                }
                __syncthreads();
                if (tid < 32) { const int c = hist[tid]; int base = 0; if (c > 0) base = (int)__hip_atomic_fetch_add(cntg + tid * 64, (unsigned)c, __ATOMIC_RELAXED, __HIP_MEMORY_SCOPE_AGENT); basel[tid] = base; hist[tid] = 0; }
                __syncthreads();
                if (act && lane < 16) { const int mrow = ch * 16 + lane;
#pragma unroll
                    for (int k = 0; k < 4; ++k) { ROWL[(size_t)te[k] * ROWCAP + basel[te[k]] + lr[k]] = mrow * 4 + k; GATES[mrow * 4 + k] = tg[k]; } }
                __syncthreads();
            }
            if (BOTH(pb + 3)) GRID_BAR(); TP_END(25)
        }
        if ((ON(6) && IN(pb + 4)) || (ON(7) && IN(pb + 5))) {
            FRESH_IDS(); WSPTRS();
            LAS int* lcnt = (LAS int*)(L + L_CNT); LAS int* lblk = (LAS int*)(L + L_BLK); LAS int* idx = (LAS int*)(L + IDX_OFF);
            unsigned* cntg = ctl + CW_CNT + l * 32 * 64;
            __syncthreads();
            if (tid < 32) lcnt[tid] = (int)__hip_atomic_load(cntg + tid * 64, __ATOMIC_RELAXED, __HIP_MEMORY_SCOPE_AGENT);
            __syncthreads();
            if (tid == 0) { int s = 0; for (int e = 0; e < 32; ++e) { lblk[e] = s; s += (lcnt[e] + 255) >> 8; } lblk[32] = s; }
            __syncthreads();
            const int nrb = lblk[32];
            if (ON(6) && IN(pb + 4)) { TP_BEGIN(26)
        for (int rep_ = 0; rep_ < NREP(6); ++rep_) {
                const int nU = nrb * 8;
                for (int i = 0; i * G + vcu < nU; ++i) { const int rb = (i * G + vcu) >> 3; const int e = pg8::find_expert(lblk, rb);
                    if (tid < 256) { const int r = (rb - lblk[e]) * 256 + tid; idx[i * 256 + tid] = (r < lcnt[e]) ? (ROWL[(size_t)e * ROWCAP + r] >> 2) : 0; } }
                __syncthreads();
                pg8::SchedMoe1 S{(const char*)XN2, (const char*)(W1T + (size_t)l * NEXP * 2048 * DM), lblk, idx, nU, G, vcu};
                pg8::EpiMoe1 E{HID, args.b1 + (size_t)l * NEXP * 2048, (LAS float*)(L + BIAS_OFF)};
                pg8::gemm_phase<pg8::EpiMoe1, pg8::SchedMoe1, true, true>(L, DM, S, E, tacc);
                } if (BOTH(pb + 4)) GRID_BAR(); TP_END(26)
            }
            if (ON(7) && IN(pb + 5)) { TP_BEGIN(27)
        for (int rep_ = 0; rep_ < NREP(7); ++rep_) {
                const int nU = nrb * 4;
                __syncthreads();
                for (int i = 0; i * G + vcu < nU; ++i) { const int rb = (i * G + vcu) >> 2; const int e = pg8::find_expert(lblk, rb);
                    if (tid < 256) { const int r = (rb - lblk[e]) * 256 + tid; idx[i * 256 + tid] = (r < lcnt[e]) ? ROWL[(size_t)e * ROWCAP + r] : NTOK * TOPK; } }
                __syncthreads();
                pg8::SchedMoe2 S{(const char*)HID, (const char*)(W2T + (size_t)l * NEXP * DM * DM), lblk, nU, G, vcu};
                pg8::EpiMoe2 E{Y, args.b2 + (size_t)l * NEXP * DM, idx, (LAS float*)(L + BIAS_OFF)};
                pg8::gemm_phase<pg8::EpiMoe2, pg8::SchedMoe2, true, true>(L, DM, S, E, tacc);
                } if (BOTH(pb + 5)) GRID_BAR(); TP_END(27)
            }
        }
        if (ON(8) && IN(pb + 6)) { TP_BEGIN(28)
            FRESH_IDS(); WSPTRS();
        for (int rep_ = 0; rep_ < NREP(8); ++rep_) {
            LAS float* wft = (LAS float*)L;
            if (l + 1 < DEPTH) { for (int i = tid; i < 8 * DM; i += NTHR) wft[i] = WFT[(size_t)(l + 1) * 8 * DM + i]; }
            __syncthreads();
            for (int ch = gw; ch < NTOK / 16; ch += NGW) {
                const int b = ch >> 8; const float* mod = modl + (size_t)b * 6144;
                f32x4 g2[4], gm[4], sh[4];
#pragma unroll
                for (int j = 0; j < 4; ++j) { const int c0 = CB(j); g2[j] = *(const f32x4*)(mod + 5 * 1024 + c0);
                    if (l + 1 < DEPTH) { const float* mod2 = MOD + ((size_t)(l + 1) * 8 + b) * 6144; const f32x4 g = *(const f32x4*)(args.norm_mix + (l + 1) * DM + c0), sc = *(const f32x4*)(mod2 + 1024 + c0); gm[j] = g * (sc + 1.0f); sh[j] = *(const f32x4*)(mod2 + c0); }
                    else { gm[j] = *(const f32x4*)(args.final_norm + c0); sh[j] = (f32x4){0.f, 0.f, 0.f, 0.f}; } }
#pragma unroll 4
                for (int rr = 0; rr < 16; ++rr) { const int mrow = ch * 16 + rr;
                    const f32x4 gt = *(const f32x4*)(GATES + (size_t)mrow * 4);
                    f32x4 v[4];
#pragma unroll
                    for (int jj = 0; jj < 2; ++jj) { const int c0 = 512 * jj + 8 * lane;
                        f32x4 a = {0.f, 0.f, 0.f, 0.f}, c = a;
#pragma unroll
                        for (int k = 0; k < 4; ++k) { const u32x4 yw = *(const u32x4*)(Y + ((size_t)mrow * 4 + k) * DM + c0); const float gk = gt[k];
                            a[0] += gk * bf_lo(yw.x); a[1] += gk * bf_hi(yw.x); a[2] += gk * bf_lo(yw.y); a[3] += gk * bf_hi(yw.y);
                            c[0] += gk * bf_lo(yw.z); c[1] += gk * bf_hi(yw.z); c[2] += gk * bf_lo(yw.w); c[3] += gk * bf_hi(yw.w); }
                        v[2 * jj] = *(const f32x4*)(X1 + (size_t)mrow * DM + c0) + g2[2 * jj] * a; v[2 * jj + 1] = *(const f32x4*)(X1 + (size_t)mrow * DM + c0 + 4) + g2[2 * jj + 1] * c; }
                    if (l + 1 < DEPTH) {
#pragma unroll
                        for (int j = 0; j < 4; ++j) *(f32x4*)(X2 + (size_t)mrow * DM + CB(j)) = v[j];
                        norm1_row<true>(v, gm, sh, wft, args.b_forget + (l + 1) * 8, (bf16_t*)((unsigned char*)XN + (size_t)mrow * DM), LF, b, mrow & (SEQ - 1), lane);
                    } else {
                        float ss = 0.f;
#pragma unroll
                        for (int j = 0; j < 4; ++j) ss += (v[j][0] * v[j][0] + v[j][1] * v[j][1]) + (v[j][2] * v[j][2] + v[j][3] * v[j][3]);
                        const float rstd = __builtin_amdgcn_rsqf(wave_sum(ss) * (1.0f / DM) + NORM_EPS);
#pragma unroll
                        for (int j = 0; j < 4; ++j) *(f32x4*)(args.out + (size_t)mrow * DM + CB(j)) = v[j] * rstd * gm[j];
                    }
                }
            }
            __syncthreads();
            } if (BOTH(pb + 6)) GRID_BAR(); TP_END(28)
        }
    }
    TP_END(30)
    if (TPROBE != 0 && blockIdx.x == 0 && threadIdx.x == 0) { const long t0 = (long)__builtin_amdgcn_s_memtime(); while ((long)__builtin_amdgcn_s_memtime() - t0 < tacc * TP_MULT) __builtin_amdgcn_s_sleep(8); }
#undef IN
#undef BOTH
}

extern "C" void kernel_launch(void* const* d_in, const int* in_sizes, int n_in, void* d_out, int out_size, void* d_ws, size_t ws_size, hipStream_t stream) {
    static int grid = 0;
    if (grid == 0) {
        if (n_in != 22 || in_sizes[0] != NTOK * DM || out_size != NTOK * DM || ws_size < WS_END) {
            fprintf(stderr, "kernel_launch: unexpected shapes: n_in %d in0 %d out %d ws %zu (need %zu)\n", n_in, n_in > 0 ? in_sizes[0] : -1, out_size, ws_size, (size_t)WS_END); grid = -1; return; }
        int dev = 0, cus = 0, per_cu = 0;
        if (hipGetDevice(&dev) != hipSuccess || hipDeviceGetAttribute(&cus, hipDeviceAttributeMultiprocessorCount, dev) != hipSuccess) { grid = -1; return; }
        if (hipFuncSetAttribute((const void*)fwd_kernel, hipFuncAttributeMaxDynamicSharedMemorySize, LDS_BYTES) != hipSuccess) { fprintf(stderr, "kernel_launch: hipFuncSetAttribute failed\n"); grid = -1; return; }
        if (hipOccupancyMaxActiveBlocksPerMultiprocessor(&per_cu, (const void*)fwd_kernel, NTHR, LDS_BYTES) != hipSuccess || per_cu < 1)
            fprintf(stderr, "kernel_launch: occupancy query reports %d blocks per CU\n", per_cu);
        (void)hipGetLastError();
        grid = cus;
    }
    if (grid < 0) return;
    (void)hipMemsetAsync((char*)d_ws + WS_CTL, 0, CTL_ZERO_BYTES, stream);
    Args a{};
    a.x = (const float*)d_in[0]; a.c = (const float*)d_in[1]; a.pos = (const int*)d_in[2]; a.ada_w = (const float*)d_in[3]; a.ada_b = (const float*)d_in[4];
    a.norm_mix = (const float*)d_in[5]; a.norm_ffn = (const float*)d_in[6]; a.w_in = (const float*)d_in[7]; a.b_forget = (const float*)d_in[8];
    a.lq1 = (const float*)d_in[9]; a.lk1 = (const float*)d_in[10]; a.lq2 = (const float*)d_in[11]; a.lk2 = (const float*)d_in[12]; a.subln = (const float*)d_in[13];
    a.w_out = (const float*)d_in[14]; a.router_w = (const float*)d_in[15]; a.router_b = (const float*)d_in[16]; a.w1 = (const float*)d_in[17]; a.b1 = (const float*)d_in[18];
    a.w2 = (const float*)d_in[19]; a.b2 = (const float*)d_in[20]; a.final_norm = (const float*)d_in[21];
    a.out = (float*)d_out; a.ws = (unsigned char*)d_ws;
    constexpr int NPH = 2 + 7 * DEPTH;
#if MK_MULTI
    for (int p = 0; p < NPH; ++p) { a.ph_lo = p; a.ph_hi = p + 1; hipLaunchKernelGGL(fwd_kernel, dim3(grid), dim3(NTHR), LDS_BYTES, stream, a); }
#else
    a.ph_lo = 0; a.ph_hi = NPH;
    hipLaunchKernelGGL(fwd_kernel, dim3(grid), dim3(NTHR), LDS_BYTES, stream, a);
#endif
    const hipError_t le = hipPeekAtLastError();
    if (le != hipSuccess) fprintf(stderr, "kernel_launch: launch failed: %s\n", hipGetErrorName(le));
}
```

```cpp
#include <hip/hip_runtime.h>
#include <hip/hip_bf16.h>
#include <cstdio>
#include <cstdint>
#include <cmath>

#ifndef MK_MULTI
#define MK_MULTI 0
#endif

constexpr int BATCH = 8, SEQ = 4096, DM = 1024, NTOK = BATCH * SEQ, DEPTH = 2, NEXP = 32, TOPK = 4;
constexpr int INCOLS = 3080, DFF = 1024;
constexpr int NWAVES = 8, NTHR = 512;
constexpr float NORM_EPS = 1e-6f;
constexpr float LOG2E = 1.4426950408889634f;
constexpr float QSCALE = 0.125f * LOG2E;
constexpr int ROWCAP = NTOK;
constexpr int MAXRB = (NTOK * TOPK) / 256 + NEXP;

constexpr size_t MiB = 1u << 20;
constexpr size_t WS_CTL = 0, CTL_ZERO_BYTES = 2 * MiB;
constexpr size_t WS_MOD = 2 * MiB;
constexpr size_t WS_RWT = 3 * MiB;
constexpr size_t WS_WFT = 3 * MiB + 512 * 1024;
constexpr size_t WS_ROPE = 4 * MiB;
constexpr size_t WS_NCK = 6 * MiB;
constexpr size_t WS_LF = 7 * MiB;
constexpr size_t WS_GATES = 8 * MiB;
constexpr size_t WS_ROWL = 9 * MiB;
constexpr size_t WS_WQ = 13 * MiB;
constexpr size_t WS_BQ = 15 * MiB;
constexpr size_t WS_WIN = 16 * MiB;
constexpr size_t WS_WOUT = 28 * MiB;
constexpr size_t WS_W1 = 32 * MiB;
constexpr size_t WS_W2 = 288 * MiB;
constexpr size_t WS_XN = 416 * MiB;
constexpr size_t WS_QKV = 480 * MiB;
constexpr size_t WS_AO = 672 * MiB;
constexpr size_t WS_X1 = 736 * MiB;
constexpr size_t WS_X2 = 864 * MiB;
constexpr size_t WS_XN2 = 992 * MiB;
constexpr size_t WS_HID = 1056 * MiB;
constexpr size_t WS_Y = 1328 * MiB;
constexpr size_t WS_END = 1585 * MiB;
constexpr int CW_BAR = 4096;
constexpr int CW_KN = 12288;
constexpr int CW_CNT = 16384;

constexpr int RING_BYTES = 131072;
constexpr int MISC_OFF = RING_BYTES;
constexpr int L_XBST = MISC_OFF;
constexpr int L_CNT = MISC_OFF + 64;
constexpr int L_BLK = MISC_OFF + 192;
constexpr int L_HIST = MISC_OFF + 384;
constexpr int L_BASE = MISC_OFF + 512;
constexpr int L_SCAN = MISC_OFF + 640;
constexpr int L_VOTE = MISC_OFF + 704;
constexpr int IDX_OFF = MISC_OFF + 1024;
constexpr int IDX_BYTES = 18432;
constexpr int BIAS_OFF = IDX_OFF + IDX_BYTES;
constexpr int LDS_BYTES = BIAS_OFF + 8192;

#define GAS __attribute__((address_space(1)))
#define LAS __attribute__((address_space(3)))
typedef unsigned short bf16_t;
typedef short bf16x8 __attribute__((ext_vector_type(8)));
typedef short s16x4 __attribute__((ext_vector_type(4)));
typedef float f32x4 __attribute__((ext_vector_type(4)));
typedef float f32x2 __attribute__((ext_vector_type(2)));
typedef float f32x16 __attribute__((ext_vector_type(16)));
typedef unsigned u32x4 __attribute__((ext_vector_type(4)));
typedef unsigned u32x2 __attribute__((ext_vector_type(2)));

__device__ __forceinline__ unsigned cvt_pk_bf16(float lo, float hi) { unsigned r; asm volatile("v_cvt_pk_bf16_f32 %0, %1, %2" : "=v"(r) : "v"(lo), "v"(hi)); return r; }
__device__ __forceinline__ int fresh_tid() { int t = threadIdx.x; asm volatile("" : "+v"(t)); return t; }
__device__ __forceinline__ unsigned pack4_fp8(float a, float b, float c, float d) {
    int w = __builtin_amdgcn_cvt_pk_fp8_f32(a, b, 0, false); w = __builtin_amdgcn_cvt_pk_fp8_f32(c, d, w, true); return (unsigned)w; }
__device__ __forceinline__ float bf_lo(unsigned w) { return __uint_as_float(w << 16); }
__device__ __forceinline__ float bf_hi(unsigned w) { return __uint_as_float(w & 0xffff0000u); }
__device__ __forceinline__ float wave_sum(float v) {
#pragma unroll
    for (int o = 1; o < 64; o <<= 1) v += __shfl_xor(v, o);
    return v;
}

#define XB_TMO      128
#define XB_XCNT(j)  (256  + 64 * (j))
#define XB_XSUB(j)  (1280 + 64 * (j))
#define XB_XGEN(j)  (2304 + 64 * (j))
#define XB_TOP      3328
#define XB_TOPGEN   3392
#define XCD_BAR_WORDS 3456
#define XB_SPIN_CAP (1u << 18)
__device__ __forceinline__ unsigned xb_ld(unsigned* p)              { return __hip_atomic_load(p, __ATOMIC_RELAXED, __HIP_MEMORY_SCOPE_AGENT); }
__device__ __forceinline__ unsigned xb_add(unsigned* p, unsigned v) { return __hip_atomic_fetch_add(p, v, __ATOMIC_RELAXED, __HIP_MEMORY_SCOPE_AGENT); }
__device__ __forceinline__ unsigned xb_xcc_id() { return (unsigned)__builtin_amdgcn_s_getreg((3 << 11) | 20) & 0xFu; }
#define XB_SPIN(cond, bar) do { unsigned _sp = 0; while (cond) { __builtin_amdgcn_s_sleep(1); \
    if ((++_sp & 255u) == 0u) { if (xb_ld(&(bar)[XB_TMO])) break; if (_sp > XB_SPIN_CAP) { atomicAdd(&(bar)[XB_TMO], 1u); break; } } } } while (0)
struct XcdBarrier { unsigned* bar; unsigned x; volatile LAS unsigned* st; };
__device__ __forceinline__ XcdBarrier xcd_barrier_post(unsigned* bar, volatile LAS unsigned* st) {
    XcdBarrier b; b.bar = bar; b.x = xb_xcc_id(); b.st = st;
    if (threadIdx.x == 0) (void)xb_add(&bar[XB_XCNT(b.x)], 1u);
    return b;
}
__device__ __forceinline__ void xcd_barrier_complete(unsigned* bar, unsigned x, unsigned& nloc, unsigned& nx) {
    const unsigned G = gridDim.x * gridDim.y * gridDim.z;
    unsigned sum, cnt, mine, sp = 0u;
    for (;;) {
        sum = 0u; cnt = 0u; mine = 0u;
#pragma unroll
        for (unsigned j = 0; j < 16; ++j) { const unsigned c = xb_ld(&bar[XB_XCNT(j)]); sum += c; cnt += (c > 0u) ? 1u : 0u; mine = (j == x) ? c : mine; }
        if (sum == G) break;
        __builtin_amdgcn_s_sleep(1);
        if ((++sp & 255u) == 0u) { if (xb_ld(&bar[XB_TMO])) break; if (sp > XB_SPIN_CAP) { atomicAdd(&bar[XB_TMO], 1u); break; } }
    }
    nloc = mine > 0u ? mine : 1u; nx = cnt > 0u ? cnt : 1u;
}
__device__ __forceinline__ void xcd_barrier(const XcdBarrier& b) {
    asm volatile("s_waitcnt vmcnt(0)" ::: "memory");
    __syncthreads();
    if (threadIdx.x == 0) {
        unsigned* bar = b.bar;
        __builtin_amdgcn_s_waitcnt(0);
        unsigned nloc = b.st[0], nx = b.st[1];
        if (nloc == 0u) { xcd_barrier_complete(bar, b.x, nloc, nx); b.st[0] = nloc; b.st[1] = nx; }
        const unsigned old = xb_add(&bar[XB_XSUB(b.x)], 1u);
        const unsigned gen = old / nloc;
        if (old + 1u == (gen + 1u) * nloc) {
            __builtin_amdgcn_fence(__ATOMIC_RELEASE, "agent");
            asm volatile("s_waitcnt vmcnt(0)" ::: "memory");
            const unsigned og = xb_add(&bar[XB_TOP], 1u);
            const unsigned tg = og / nx;
            if (og + 1u == (tg + 1u) * nx) xb_add(&bar[XB_TOPGEN], 1u);
            else XB_SPIN(xb_ld(&bar[XB_TOPGEN]) == tg, bar);
            __builtin_amdgcn_fence(__ATOMIC_ACQUIRE, "agent");
            xb_add(&bar[XB_XGEN(b.x)], 1u);
            asm volatile("s_waitcnt vmcnt(0)" ::: "memory");
        } else {
            XB_SPIN(xb_ld(&bar[XB_XGEN(b.x)]) == gen, bar);
            __builtin_amdgcn_fence(__ATOMIC_ACQUIRE, "agent");
            asm volatile("s_waitcnt vmcnt(0)" ::: "memory");
        }
    }
    __syncthreads();
}

#ifndef TPROBE
#define TPROBE 0
#endif
#define TP_MULT 4
#define TP_BEGIN(id) long tp_t0_##id = 0; if (TPROBE == (id)) { tp_t0_##id = (long)__builtin_amdgcn_s_memtime(); }
#define TP_END(id) if (TPROBE == (id)) { tacc += (long)__builtin_amdgcn_s_memtime() - tp_t0_##id; }
namespace pg8 {
constexpr int BM = 256, BK = 64, HALF = 128, HTB = HALF * BK * 2, STAGE_BYTES = 8 * HTB;
__host__ __device__ __forceinline__ int lds_byte(int r, int c) { const int st = (r >> 4) * 2 + (c >> 5), rr = r & 15, cc = c & 31, ob = rr * 64 + cc * 2; return st * 1024 + (ob ^ (((ob >> 9) & 1) << 5)); }
__host__ __device__ __forceinline__ void stage_rc(int b, int& R, int& C) { const int st = b / 1024, sb = b % 1024, swz = sb ^ (((sb >> 9) & 1) << 5); R = (st >> 1) * 16 + swz / 64; C = (st & 1) * 32 + (swz % 64) / 2; }
__host__ __device__ __forceinline__ int perm32(int rho) { const int n = rho >> 4, i = rho & 15; return 8 * (i >> 2) + 4 * n + (i & 3); }

typedef int i32x8 __attribute__((ext_vector_type(8)));
typedef int i32x4 __attribute__((ext_vector_type(4)));
__device__ __forceinline__ i32x8 cat8(bf16x8 lo, bf16x8 hi) { const i32x4 a = __builtin_bit_cast(i32x4, lo), b = __builtin_bit_cast(i32x4, hi); return (i32x8){a[0], a[1], a[2], a[3], b[0], b[1], b[2], b[3]}; }
struct Unit { int pm, pn, e; };

template <class Epi, class Sched, bool ALIGN_EPI, bool F8 = false>
__device__ __forceinline__ void gemm_phase(LAS unsigned char* lds, const int K, const Sched& S, const Epi& E, long& tacc) {
    const int tid = fresh_tid(), wid = __builtin_amdgcn_readfirstlane(tid >> 6), lane = tid & 63, wr = wid >> 2, wc = wid & 3, fr = lane & 15, fq = lane >> 4;
    const int nt = F8 ? K / (2 * BK) : K / BK;
    const int rowb = F8 ? K : 2 * K;
    int Rp[2]; unsigned voffA[2], voffB[2];
#pragma unroll
    for (int i = 0; i < 2; ++i) { int R, C; stage_rc(tid * 16 + i * 8192, R, C); Rp[i] = R; const int Rb = Epi::PERM ? ((R & ~31) + perm32(R & 31)) : R;
        voffA[i] = Sched::GATHER ? (unsigned)C * 2u : (unsigned)(R * rowb + C * 2); voffB[i] = (unsigned)(Rb * rowb + C * 2); }
    const size_t kstep = (size_t)(BK * 2);
    const size_t hstep = (size_t)HALF * rowb;
    const unsigned ldsw = (unsigned)wid * 1024u;
    const int aoff = lds_byte(wr * 64 + fr, fq * 8), boff = lds_byte(wc * 32 + fr, fq * 8);
#define PG8_SA(b, h) (((b) * 2 + (h)) * HTB)
#define PG8_SB(b, h) ((4 + (b) * 2 + (h)) * HTB)
#define PG8_STAGE(bufoff, gbase, v0, v1) do { \
        __builtin_amdgcn_global_load_lds((const unsigned*)((const char*)(gbase) + (v0)), (LAS unsigned*)(lds + (bufoff) + ldsw), 16, 0, 0); \
        __builtin_amdgcn_global_load_lds((const unsigned*)((const char*)(gbase) + (v1)), (LAS unsigned*)(lds + (bufoff) + ldsw + 8192), 16, 0, 0); } while (0)
#define PG8_STAGE_A(bufoff, gbase, h) do { if constexpr (Sched::GATHER) { PG8_STAGE(bufoff, gbase, (unsigned)tok[h][0] * (unsigned)rowb + voffA[0], (unsigned)tok[h][1] * (unsigned)rowb + voffA[1]); } \
        else { PG8_STAGE(bufoff, (gbase) + (h) * hstep, voffA[0], voffA[1]); } } while (0)
#define PG8_LDA_(dst, b, h) do { if constexpr (F8) { _Pragma("unroll") for (int m = 0; m < 4; ++m) { const i32x4 lo_ = *(const LAS i32x4*)(lds + PG8_SA(b, h) + aoff + m * 2048), hi_ = *(const LAS i32x4*)(lds + PG8_SA(b, h) + aoff + m * 2048 + 1024); \
            dst##8[m] = __builtin_shufflevector(lo_, hi_, 0, 1, 2, 3, 4, 5, 6, 7); } } \
        else { _Pragma("unroll") for (int m = 0; m < 4; ++m) _Pragma("unroll") for (int k = 0; k < 2; ++k) dst[m][k] = *(const LAS bf16x8*)(lds + PG8_SA(b, h) + aoff + m * 2048 + k * 1024); } } while (0)
#define PG8_LDB_(dst, b, h) do { if constexpr (F8) { _Pragma("unroll") for (int n = 0; n < 2; ++n) { const i32x4 lo_ = *(const LAS i32x4*)(lds + PG8_SB(b, h) + boff + n * 2048), hi_ = *(const LAS i32x4*)(lds + PG8_SB(b, h) + boff + n * 2048 + 1024); \
            dst##8[n] = __builtin_shufflevector(lo_, hi_, 0, 1, 2, 3, 4, 5, 6, 7); } } \
        else { _Pragma("unroll") for (int n = 0; n < 2; ++n) _Pragma("unroll") for (int k = 0; k < 2; ++k) dst[n][k] = *(const LAS bf16x8*)(lds + PG8_SB(b, h) + boff + n * 2048 + k * 1024); } } while (0)
#define PG8_LDA(dst, b, h) PG8_LDA_(dst, b, h)
#define PG8_LDB(dst, b, h) PG8_LDB_(dst, b, h)
#define PG8_MMA(ai, bj, At, Bt) do { __builtin_amdgcn_s_setprio(1); \
        if constexpr (F8) { _Pragma("unroll") for (int m = 0; m < 4; ++m) _Pragma("unroll") for (int n = 0; n < 2; ++n) \
            acc[ai][bj][m][n] = __builtin_amdgcn_mfma_scale_f32_16x16x128_f8f6f4(Bt##8[n], At##8[m], acc[ai][bj][m][n], 0, 0, 0, 0x7f7f7f7f, 0, 0x7f7f7f7f); } \
        else { _Pragma("unroll") for (int m = 0; m < 4; ++m) _Pragma("unroll") for (int n = 0; n < 2; ++n) _Pragma("unroll") for (int k = 0; k < 2; ++k) \
            acc[ai][bj][m][n] = __builtin_amdgcn_mfma_f32_16x16x32_bf16(Bt[n][k], At[m][k], acc[ai][bj][m][n], 0, 0, 0); } \
        __builtin_amdgcn_s_setprio(0); } while (0)
#define PG8_WAIT_V(n) asm volatile("s_waitcnt vmcnt(" #n ")" ::: "memory")
#define PG8_WAIT_V8X(nrm) do { \
        if constexpr (Epi::NST == 8) asm volatile("v_cmp_ne_u32_e32 vcc, 0, %0\n\ts_cbranch_vccnz 1f\n\ts_waitcnt vmcnt(16)\n\ts_branch 2f\n1:\n\ts_waitcnt vmcnt(8)\n2:" :: "v"(nrm) : "memory", "vcc"); \
        else if constexpr (Epi::NST == 16) asm volatile("v_cmp_ne_u32_e32 vcc, 0, %0\n\ts_cbranch_vccnz 1f\n\ts_waitcnt vmcnt(24)\n\ts_branch 2f\n1:\n\ts_waitcnt vmcnt(8)\n2:" :: "v"(nrm) : "memory", "vcc"); \
        else { static_assert(Epi::NST == 32, "NST"); asm volatile("v_cmp_ne_u32_e32 vcc, 0, %0\n\ts_cbranch_vccnz 1f\n\ts_waitcnt vmcnt(40)\n\ts_branch 2f\n1:\n\ts_waitcnt vmcnt(8)\n2:" :: "v"(nrm) : "memory", "vcc"); } } while (0)
#define PG8_WAIT_L(n) asm volatile("s_waitcnt lgkmcnt(" #n ")" ::: "memory")
#define PG8_BAR __builtin_amdgcn_s_barrier()
#define PG8_SCHED __builtin_amdgcn_sched_barrier(0)
    Unit cur, nxt; int ui = 0;
    if (!S.next(0, cur)) return;
    f32x4 acc[2][2][4][2];
#pragma unroll
    for (int a = 0; a < 2; ++a)
#pragma unroll
        for (int b = 0; b < 2; ++b)
#pragma unroll
            for (int m = 0; m < 4; ++m)
#pragma unroll
                for (int n = 0; n < 2; ++n) acc[a][b][m][n] = (f32x4){0.f, 0.f, 0.f, 0.f};
    bf16x8 At[4][2], B0[2][2], B1[2][2]; i32x8 At8[4], B08[2], B18[2];
    int tok[2][2] = {{0, 0}, {0, 0}};
    if constexpr (Sched::GATHER) S.load_tok(cur, 0, Rp, tok);
    const char* cA = S.a_ptr(cur); const char* cB = S.b_ptr(cur);
    PG8_STAGE(PG8_SB(0, 0), cB, voffB[0], voffB[1]); PG8_STAGE(PG8_SB(0, 1), cB + hstep, voffB[0], voffB[1]); PG8_STAGE_A(PG8_SA(0, 0), cA, 0); PG8_STAGE_A(PG8_SA(0, 1), cA, 1);
    if (wr == 1) PG8_BAR;
    PG8_WAIT_V(2); PG8_BAR;
    PG8_STAGE(PG8_SB(1, 0), cB + kstep, voffB[0], voffB[1]); PG8_STAGE_A(PG8_SA(1, 0), cA + kstep, 0); PG8_STAGE(PG8_SB(1, 1), cB + hstep + kstep, voffB[0], voffB[1]);
    PG8_WAIT_V(6); PG8_BAR;
    for (;;) {
        if constexpr (Epi::PRE) E.pre(cur, wid, lane);
        const bool has_next = S.next(ui + 1, nxt);
        const char* nA = has_next ? S.a_ptr(nxt) : cA; const char* nB = has_next ? S.b_ptr(nxt) : cB;
        TP_BEGIN(40) long tpk_ = 0; if (TPROBE == Epi::TPK) tpk_ = (long)__builtin_amdgcn_s_memtime();
#pragma unroll 1
        for (int t = 0; t < nt; t += 2) {
            const bool last = (t == nt - 2); const int nrm = (t != 0 || ui == 0) ? 1 : 0;
            const char* a1 = cA + (size_t)(t + 1) * kstep;
            const char* a2 = last ? nA : cA + (size_t)(t + 2) * kstep; const char* b2 = last ? nB : cB + (size_t)(t + 2) * kstep;
            const char* a3 = a2 + kstep; const char* b3 = b2 + kstep;
            PG8_LDB(B0, 0, 0); PG8_LDB(B1, 0, 1); PG8_SCHED; PG8_LDA(At, 0, 0); PG8_STAGE_A(PG8_SA(1, 1), a1, 1);
            if constexpr (Sched::GATHER) { if (last && has_next) S.load_tok(nxt, ui + 1, Rp, tok); }
            PG8_WAIT_V8X(nrm); PG8_WAIT_L(0); PG8_BAR; PG8_MMA(0, 0, At, B0); PG8_MMA(0, 1, At, B1); PG8_BAR; PG8_SCHED;
            PG8_LDA(At, 0, 1); PG8_STAGE(PG8_SB(0, 0), b2, voffB[0], voffB[1]); PG8_STAGE(PG8_SB(0, 1), b2 + hstep, voffB[0], voffB[1]); PG8_STAGE_A(PG8_SA(0, 0), a2, 0);
            PG8_WAIT_V8X(nrm); PG8_WAIT_L(0); PG8_BAR; PG8_MMA(1, 0, At, B0); PG8_MMA(1, 1, At, B1); PG8_BAR; PG8_SCHED;
            PG8_LDB(B0, 1, 0); PG8_LDB(B1, 1, 1); PG8_SCHED; PG8_LDA(At, 1, 0); PG8_STAGE_A(PG8_SA(0, 1), a2, 1);
            PG8_WAIT_V(8); PG8_WAIT_L(0); PG8_BAR; PG8_MMA(0, 0, At, B0); PG8_MMA(0, 1, At, B1); PG8_BAR; PG8_SCHED;
            PG8_LDA(At, 1, 1); PG8_STAGE(PG8_SB(1, 0), b3, voffB[0], voffB[1]); PG8_STAGE(PG8_SB(1, 1), b3 + hstep, voffB[0], voffB[1]); PG8_STAGE_A(PG8_SA(1, 0), a3, 0);
            PG8_WAIT_V(8); PG8_WAIT_L(0); PG8_BAR; PG8_MMA(1, 0, At, B0); PG8_MMA(1, 1, At, B1); PG8_BAR; PG8_SCHED;
        }
        TP_END(40) if (TPROBE == Epi::TPK) tacc += (long)__builtin_amdgcn_s_memtime() - tpk_;
        TP_BEGIN(41) long tpe_ = 0; if (TPROBE == Epi::TPE) tpe_ = (long)__builtin_amdgcn_s_memtime();
        if constexpr (ALIGN_EPI) { if (wr == 0) PG8_BAR; }
        { int fr_ = fr, fq_ = fq; asm volatile("" : "+v"(fr_), "+v"(fq_));
          E(acc, cur, ui, wr, wc, fr_, fq_); }
        TP_END(41) if (TPROBE == Epi::TPE) tacc += (long)__builtin_amdgcn_s_memtime() - tpe_;
        if (!has_next) break;
#pragma unroll
        for (int a = 0; a < 2; ++a)
#pragma unroll
            for (int b = 0; b < 2; ++b)
#pragma unroll
                for (int m = 0; m < 4; ++m)
#pragma unroll
                    for (int n = 0; n < 2; ++n) acc[a][b][m][n] = (f32x4){0.f, 0.f, 0.f, 0.f};
        cur = nxt; cA = nA; cB = nB; ++ui;
        if constexpr (ALIGN_EPI) { if (wr == 1) PG8_BAR; }
    }
    PG8_WAIT_V(0);
    if constexpr (!ALIGN_EPI) { if (wr == 0) PG8_BAR; }
    PG8_BAR;
#undef PG8_SA
#undef PG8_SB
#undef PG8_STAGE
#undef PG8_STAGE_A
#undef PG8_LDA
#undef PG8_LDB
#undef PG8_LDA_
#undef PG8_LDB_
#undef PG8_MMA
#undef PG8_WAIT_V
#undef PG8_WAIT_V8X
#undef PG8_WAIT_L
#undef PG8_BAR
#undef PG8_SCHED
}

struct SchedDense {
    const char* A; const char* B; int nN, nUnits, G, vcu, K;
    __device__ __forceinline__ bool next(int i, Unit& u) const { const int L = i * G + vcu; if (L >= nUnits) return false;
        if ((nN & 3) == 0) { const int st = L >> 5, j = L & 31, ng = nN >> 2, rbg = st / ng, png = st - rbg * ng; u.pm = rbg * 8 + (j >> 2); u.pn = png * 4 + (j & 3); }
        else { u.pm = L / nN; u.pn = L - u.pm * nN; }
        u.e = 0; return true; }
    __device__ __forceinline__ const char* a_ptr(const Unit& u) const { return A + (size_t)u.pm * BM * K * 2; }
    __device__ __forceinline__ const char* b_ptr(const Unit& u) const { return B + (size_t)u.pn * BM * K * 2; }
    static constexpr bool GATHER = false;
    __device__ __forceinline__ void load_tok(const Unit&, int, const int (&)[2], int (&)[2][2]) const {}
};
struct SchedDenseG {
    const char* A; const char* B; int nN, nUnits, G, vcu, K;
    __device__ __forceinline__ bool next(int i, Unit& u) const { const int L = i * G + vcu; if (L >= nUnits) return false;
        if ((nN & 3) == 0) { const int st = L >> 5, j = L & 31, ng = nN >> 2, rbg = st / ng, png = st - rbg * ng; u.pm = rbg * 8 + (j >> 2); u.pn = png * 4 + (j & 3); }
        else { u.pm = L / nN; u.pn = L - u.pm * nN; }
        u.e = 0; return true; }
    __device__ __forceinline__ const char* a_ptr(const Unit&) const { return A; }
    __device__ __forceinline__ const char* b_ptr(const Unit& u) const { return B + (size_t)u.pn * BM * K; }
    static constexpr bool GATHER = true;
    __device__ __forceinline__ void load_tok(const Unit& u, int, const int (&Rp)[2], int (&tok)[2][2]) const {
#pragma unroll
        for (int h = 0; h < 2; ++h)
#pragma unroll
            for (int i = 0; i < 2; ++i) tok[h][i] = u.pm * BM + h * HALF + Rp[i];
    }
};
__device__ __forceinline__ int find_expert(const LAS int* blk, int rb) { int e = 0;
#pragma unroll
    for (int j = 1; j < NEXP; ++j) e += (rb >= blk[j]) ? 1 : 0;
    return e; }
struct SchedMoe1 {
    const char* A; const char* W; const LAS int* blk; const LAS int* idx; int nUnits, G, vcu;
    __device__ __forceinline__ bool next(int i, Unit& u) const { const int L = i * G + vcu; if (L >= nUnits) return false; u.pm = L >> 3; u.pn = L & 7; u.e = find_expert(blk, u.pm); return true; }
    __device__ __forceinline__ const char* a_ptr(const Unit&) const { return A; }
    __device__ __forceinline__ const char* b_ptr(const Unit& u) const { return W + ((size_t)u.e * 2048 + (size_t)u.pn * 256) * DM; }
    static constexpr bool GATHER = true;
    __device__ __forceinline__ void load_tok(const Unit&, int ui, const int (&Rp)[2], int (&tok)[2][2]) const {
#pragma unroll
        for (int h = 0; h < 2; ++h)
#pragma unroll
            for (int i = 0; i < 2; ++i) tok[h][i] = idx[ui * 256 + h * HALF + Rp[i]];
    }
};
struct SchedMoe2 {
    const char* A; const char* W; const LAS int* blk; int nUnits, G, vcu;
    __device__ __forceinline__ bool next(int i, Unit& u) const { const int L = i * G + vcu; if (L >= nUnits) return false; u.pm = L >> 2; u.pn = L & 3; u.e = find_expert(blk, u.pm); return true; }
    __device__ __forceinline__ const char* a_ptr(const Unit&) const { return A; }
    __device__ __forceinline__ const char* b_ptr(const Unit& u) const { return W + ((size_t)u.e * 1024 + (size_t)u.pn * 256) * DM; }
    static constexpr bool GATHER = true;
    __device__ __forceinline__ void load_tok(const Unit& u, int, const int (&Rp)[2], int (&tok)[2][2]) const {
#pragma unroll
        for (int h = 0; h < 2; ++h)
#pragma unroll
            for (int i = 0; i < 2; ++i) tok[h][i] = u.pm * BM + h * HALF + Rp[i];
    }
};

struct EpiInProj {
    static constexpr bool PERM = true, PRE = false; static constexpr int NST = 16; static constexpr int TPK = 46, TPE = 47;
    bf16_t* QKV; const float* rope; unsigned* kn; float ws;
    __device__ __forceinline__ void operator()(const f32x4 (&acc)[2][2][4][2], const Unit& u, int, int wr, int wc, int fr, int fq) const {
        const int t = u.pn >> 1; bf16_t* base = QKV + (size_t)t * NTOK * 512;
        const float sc = (t == 0 || t == 3) ? QSCALE : 1.0f;
        const bool dorope = (t < 2) && ((wc & 1) == 0);
        const int col0 = (u.pn & 1) * 256 + wc * 32 + 8 * fq;
        const float sgn = (fq == 0) ? -1.0f : 1.0f; const bool rl = fq < 2;
        float kmx0 = 0.f, kmx1 = 0.f;
#pragma unroll
        for (int ai = 0; ai < 2; ++ai)
#pragma unroll
            for (int m = 0; m < 4; ++m) {
                const int row = u.pm * BM + ai * HALF + wr * 64 + m * 16 + fr;
                f32x4 cs0 = {1.f, 1.f, 1.f, 1.f}, cs1 = cs0, sn0 = {0.f, 0.f, 0.f, 0.f}, sn1 = sn0;
                if (dorope) { const f32x4* rp = (const f32x4*)(rope + (size_t)row * 16); cs0 = rp[0]; cs1 = rp[1]; sn0 = rp[2]; sn1 = rp[3]; }
#pragma unroll
                for (int bj = 0; bj < 2; ++bj) {
                    f32x4 v0 = acc[ai][bj][m][0] * ws, v1 = acc[ai][bj][m][1] * ws;
                    if (dorope) {
#pragma unroll
                        for (int i = 0; i < 4; ++i) { const float p0 = __shfl_xor(v0[i], 16), p1 = __shfl_xor(v1[i], 16);
                            const float r0 = v0[i] * cs0[i] + sgn * p0 * sn0[i], r1 = v1[i] * cs1[i] + sgn * p1 * sn1[i];
                            v0[i] = rl ? r0 : v0[i]; v1[i] = rl ? r1 : v1[i]; }
                    }
                    v0 = v0 * sc; v1 = v1 * sc;
                    if (t == 4) { float ss = (v0[0] * v0[0] + v0[1] * v0[1]) + (v0[2] * v0[2] + v0[3] * v0[3]) + (v1[0] * v1[0] + v1[1] * v1[1]) + (v1[2] * v1[2] + v1[3] * v1[3]);
                        ss += __shfl_xor(ss, 16); ss += __shfl_xor(ss, 32); if (bj == 0) kmx0 = fmaxf(kmx0, ss); else kmx1 = fmaxf(kmx1, ss); }
                    u32x4 w; w.x = cvt_pk_bf16(v0[0], v0[1]); w.y = cvt_pk_bf16(v0[2], v0[3]); w.z = cvt_pk_bf16(v1[0], v1[1]); w.w = cvt_pk_bf16(v1[2], v1[3]);
                    *(u32x4*)(base + (size_t)row * 512 + col0 + bj * HALF) = w;
                }
            }
        if (t == 4) {
#pragma unroll
            for (int bj = 0; bj < 2; ++bj) { float v = (bj == 0) ? kmx0 : kmx1;
#pragma unroll
                for (int o = 1; o < 16; o <<= 1) v = fmaxf(v, __shfl_xor(v, o));
                unsigned* const kp = kn + (((u.pm >> 4) * 8 + (u.pn & 1) * 4 + bj * 2 + (wc >> 1)) * 2 + (wc & 1));
                if (fr == 0 && fq == 0) __hip_atomic_fetch_max(kp, __float_as_uint(v), __ATOMIC_RELAXED, __HIP_MEMORY_SCOPE_AGENT); }
        }
    }
};
struct EpiOutProj {
    static constexpr bool PERM = false, PRE = false; static constexpr int NST = 32; static constexpr int TPK = 48, TPE = 49;
    const float* xin; float* xout; const float* g1; float ws;
    __device__ __forceinline__ void operator()(const f32x4 (&acc)[2][2][4][2], const Unit& u, int, int wr, int wc, int fr, int fq) const {
        const int b = u.pm >> 4; const int col0 = u.pn * BM + wc * 32 + 4 * fq;
        f32x4 gv[2][2];
#pragma unroll
        for (int bj = 0; bj < 2; ++bj)
#pragma unroll
            for (int n = 0; n < 2; ++n) gv[bj][n] = *(const f32x4*)(g1 + (size_t)b * 6144 + col0 + bj * HALF + n * 16) * ws;
#pragma unroll
        for (int ai = 0; ai < 2; ++ai)
#pragma unroll
            for (int m = 0; m < 4; ++m) { const size_t off = (size_t)(u.pm * BM + ai * HALF + wr * 64 + m * 16 + fr) * DM + col0;
#pragma unroll
                for (int bj = 0; bj < 2; ++bj)
#pragma unroll
                    for (int n = 0; n < 2; ++n) { const f32x4 xi = *(const f32x4*)(xin + off + bj * HALF + n * 16); *(f32x4*)(xout + off + bj * HALF + n * 16) = xi + gv[bj][n] * acc[ai][bj][m][n]; }
            }
    }
};
struct EpiMoe1 {
    static constexpr bool PERM = true, PRE = true; static constexpr int NST = 8; static constexpr int TPK = 44, TPE = 45;
    unsigned char* HID; const float* b1; LAS float* biasl;
    __device__ __forceinline__ void pre(const Unit& u, int wid, int lane) const {
        const float* g = b1 + (size_t)u.e * 2048 + u.pn * HALF + ((lane < 32) ? 4 * lane : 1024 + 4 * (lane - 32));
        __builtin_amdgcn_global_load_lds((const unsigned*)g, (LAS unsigned*)(biasl + wid * 256), 16, 0, 0);
    }
    __device__ __forceinline__ void operator()(const f32x4 (&acc)[2][2][4][2], const Unit& u, int, int wr, int wc, int fr, int fq) const {
        const int wid = wr * 4 + wc; const int hl = wc * 32 + 8 * fq; const int hc = u.pn * HALF + hl; const LAS float* bb = biasl + wid * 256 + hl;
        const f32x4 bg0 = *(const LAS f32x4*)(bb), bg1 = *(const LAS f32x4*)(bb + 4), bu0 = *(const LAS f32x4*)(bb + 128), bu1 = *(const LAS f32x4*)(bb + 132);
#pragma unroll
        for (int ai = 0; ai < 2; ++ai)
#pragma unroll
            for (int m = 0; m < 4; ++m) {
                const size_t row = (size_t)u.pm * BM + ai * HALF + wr * 64 + m * 16 + fr;
                float o[8];
#pragma unroll
                for (int n = 0; n < 2; ++n) { const f32x4 g = acc[ai][0][m][n] * 0.03125f + (n ? bg1 : bg0), up = acc[ai][1][m][n] * 0.03125f + (n ? bu1 : bu0);
#pragma unroll
                    for (int i = 0; i < 4; ++i) { const float gt = fminf(g[i], 7.0f), uu = fminf(fmaxf(up[i], -7.0f), 7.0f);
                        const float sg = __builtin_amdgcn_rcpf(1.0f + __builtin_amdgcn_exp2f(-1.702f * LOG2E * gt)); o[n * 4 + i] = (uu + 1.0f) * gt * sg; } }
                u32x2 w; w.x = pack4_fp8(o[0], o[1], o[2], o[3]); w.y = pack4_fp8(o[4], o[5], o[6], o[7]);
                *(u32x2*)(HID + row * DM + hc) = w;
            }
    }
};
struct EpiMoe2 {
    static constexpr bool PERM = true, PRE = true; static constexpr int NST = 16; static constexpr int TPK = 42, TPE = 43;
    bf16_t* Y; const float* b2; const LAS int* aidx; LAS float* biasl;
    __device__ __forceinline__ void pre(const Unit& u, int wid, int lane) const {
        __builtin_amdgcn_global_load_lds((const unsigned*)(b2 + (size_t)u.e * 1024 + u.pn * BM + 4 * lane), (LAS unsigned*)(biasl + wid * 256), 16, 0, 0);
    }
    __device__ __forceinline__ void operator()(const f32x4 (&acc)[2][2][4][2], const Unit& u, int ui, int wr, int wc, int fr, int fq) const {
        const int wid = wr * 4 + wc; const int cl = wc * 32 + 8 * fq; const int col0 = u.pn * BM + cl; const LAS float* bb = biasl + wid * 256 + cl;
        f32x4 bv[2][2];
#pragma unroll
        for (int bj = 0; bj < 2; ++bj)
#pragma unroll
            for (int n = 0; n < 2; ++n) bv[bj][n] = *(const LAS f32x4*)(bb + bj * HALF + 4 * n);
#pragma unroll
        for (int ai = 0; ai < 2; ++ai)
#pragma unroll
            for (int m = 0; m < 4; ++m) {
                const int aid = aidx[ui * 256 + ai * HALF + wr * 64 + m * 16 + fr];
#pragma unroll
                for (int bj = 0; bj < 2; ++bj) { const f32x4 v0 = acc[ai][bj][m][0] * 0.03125f + bv[bj][0], v1 = acc[ai][bj][m][1] * 0.03125f + bv[bj][1];
                    u32x4 w; w.x = cvt_pk_bf16(v0[0], v0[1]); w.y = cvt_pk_bf16(v0[2], v0[3]); w.z = cvt_pk_bf16(v1[0], v1[1]); w.w = cvt_pk_bf16(v1[2], v1[3]);
                    *(u32x4*)(Y + (size_t)aid * DM + col0 + bj * HALF) = w; }
            }
    }
};
}

namespace att {
constexpr int STG_F = 16384, STG_D = 32768;
constexpr int LDS_NCK = 98304;
typedef LAS const char* lds_cptr;
typedef short v4i16_t __attribute__((ext_vector_type(4)));
typedef __bf16 bf16x2_t __attribute__((ext_vector_type(2)));
__device__ __forceinline__ void glds16(const void* gsrc, unsigned lds_dst) { unsigned keep;
    asm volatile("s_mov_b32 %0, m0\n\ts_mov_b32 m0, %2\n\ts_nop 0\n\tglobal_load_lds_dwordx4 %1, off\n\ts_mov_b32 m0, %0" : "=&s"(keep) : "v"(gsrc), "s"(lds_dst) : "memory"); }
__device__ __forceinline__ unsigned cvtpk(float lo, float hi) { f32x2 v = {lo, hi}; bf16x2_t b = __builtin_convertvector(v, bf16x2_t); return __builtin_bit_cast(unsigned, b); }
__device__ __forceinline__ s16x4 vtr(lds_cptr p) { return __builtin_bit_cast(s16x4, __builtin_amdgcn_ds_read_tr16_b64_v4i16((LAS v4i16_t*)p)); }
__device__ __forceinline__ float swapmax(float m) { auto rr = __builtin_amdgcn_permlane32_swap(__float_as_uint(m), __float_as_uint(m), false, false); return fmaxf(__uint_as_float(rr[0]), __uint_as_float(rr[1])); }
__device__ __forceinline__ float swapsum(float m) { auto rr = __builtin_amdgcn_permlane32_swap(__float_as_uint(m), __float_as_uint(m), false, false); return __uint_as_float(rr[0]) + __uint_as_float(rr[1]); }
__device__ __forceinline__ u32x4 widen_pair(u32x2 a, u32x2 b) {
    auto r0 = __builtin_amdgcn_permlane32_swap(a.x, b.x, false, false); auto r1 = __builtin_amdgcn_permlane32_swap(a.y, b.y, false, false);
    return (u32x4){r0[0], r1[0], r0[1], r1[1]};
}
#define ATT_WAIT_BAR(N) asm volatile("s_waitcnt vmcnt(" #N ") lgkmcnt(0)\n\ts_barrier" ::: "memory")
#define ATT_BAR() asm volatile("s_waitcnt lgkmcnt(0)\n\ts_barrier" ::: "memory")

__device__ __forceinline__ float max3f(float a, float b, float c) { float r; asm("v_max3_f32 %0, %1, %2, %3" : "=v"(r) : "v"(a), "v"(b), "v"(c)); return r; }
template <int NO, bool REL>
__device__ __forceinline__ void softmax_tile(f32x16& p0, f32x16& p1, float& m, float& l, f32x16 (&o)[NO], u32x4 (&pw)[4], f32x16& negm, bool first) {
    float mx = max3f(p0[0], p1[0], p0[1]);
    mx = max3f(mx, p1[1], p0[2]); mx = max3f(mx, p1[2], p0[3]); mx = max3f(mx, p1[3], p0[4]); mx = max3f(mx, p1[4], p0[5]); mx = max3f(mx, p1[5], p0[6]); mx = max3f(mx, p1[6], p0[7]);
    float my = max3f(p1[7], p0[8], p1[8]);
    my = max3f(my, p0[9], p1[9]); my = max3f(my, p0[10], p1[10]); my = max3f(my, p0[11], p1[11]); my = max3f(my, p0[12], p1[12]); my = max3f(my, p0[13], p1[13]); my = max3f(my, p0[14], p1[14]);
    mx = max3f(mx, my, p0[15]); mx = fmaxf(mx, p1[15]);
    mx = swapmax(mx);
    if constexpr (REL) {
        if (first || __any(mx > 8.0f)) {
            const float dl = first ? mx : fmaxf(mx, 0.f); const float al = __builtin_amdgcn_exp2f(-dl); m += dl; l *= al;
#pragma unroll
            for (int r = 0; r < 16; ++r) { p0[r] -= dl; p1[r] -= dl; negm[r] = -m; }
#pragma unroll
            for (int d = 0; d < NO; ++d)
#pragma unroll
                for (int r = 0; r < 16; ++r) o[d][r] *= al;
        }
    } else {
        if (__any(mx > m + 8.0f)) {
            const float mn = fmaxf(m, mx); const float al = __builtin_amdgcn_exp2f(m - mn); m = mn; l *= al;
#pragma unroll
            for (int d = 0; d < NO; ++d)
#pragma unroll
                for (int r = 0; r < 16; ++r) o[d][r] *= al;
        }
#pragma unroll
        for (int r = 0; r < 16; ++r) { p0[r] -= m; p1[r] -= m; }
    }
    float ls0 = 0.f, ls1 = 0.f;
#pragma unroll
    for (int r = 0; r < 16; ++r) { p0[r] = __builtin_amdgcn_exp2f(p0[r]); p1[r] = __builtin_amdgcn_exp2f(p1[r]); ls0 += p0[r]; ls1 += p1[r]; }
    l += ls0 + ls1;
    pw[0] = (u32x4){cvtpk(p0[0], p0[1]), cvtpk(p0[2], p0[3]), cvtpk(p0[4], p0[5]), cvtpk(p0[6], p0[7])};
    pw[1] = (u32x4){cvtpk(p0[8], p0[9]), cvtpk(p0[10], p0[11]), cvtpk(p0[12], p0[13]), cvtpk(p0[14], p0[15])};
    pw[2] = (u32x4){cvtpk(p1[0], p1[1]), cvtpk(p1[2], p1[3]), cvtpk(p1[4], p1[5]), cvtpk(p1[6], p1[7])};
    pw[3] = (u32x4){cvtpk(p1[8], p1[9]), cvtpk(p1[10], p1[11]), cvtpk(p1[12], p1[13]), cvtpk(p1[14], p1[15])};
}
#define ATT_SBAR() __builtin_amdgcn_sched_barrier(0)
struct VFrag { s16x4 lo[4], hi[4]; };
__device__ __forceinline__ void vload(VFrag& f, lds_cptr vp, int d) {
#pragma unroll
    for (int ks = 0; ks < 4; ++ks) { f.lo[ks] = vtr(vp + d * 4096 + ks * 1024); f.hi[ks] = vtr(vp + d * 4096 + ks * 1024 + 512); }
}
__device__ __forceinline__ void pv_block(f32x16& o, const VFrag& f, const u32x4 (&pw)[4]) {
#pragma unroll
    for (int ks = 0; ks < 4; ++ks) {
        const bf16x8 vf = (bf16x8){f.lo[ks][0], f.lo[ks][1], f.lo[ks][2], f.lo[ks][3], f.hi[ks][0], f.hi[ks][1], f.hi[ks][2], f.hi[ks][3]};
        o = __builtin_amdgcn_mfma_f32_32x32x16_bf16(vf, __builtin_bit_cast(bf16x8, pw[ks]), o, 0, 0, 0);
    }
}
__device__ __forceinline__ void kload(bf16x8 (&kf)[8], lds_cptr kb, int hi, int sw) {
#pragma unroll
    for (int d0 = 0; d0 < 4; ++d0) { const int co = ((2 * d0 + hi) ^ sw) << 4; kf[2 * d0] = *(const LAS bf16x8*)(kb + co); kf[2 * d0 + 1] = *(const LAS bf16x8*)(kb + co + 4096); }
}
__device__ __forceinline__ void qk_mma(f32x16& p0, f32x16& p1, const bf16x8 (&kf)[8], const bf16x8 (&qr)[4]) {
#pragma unroll
    for (int d0 = 0; d0 < 4; ++d0) {
        p0 = __builtin_amdgcn_mfma_f32_32x32x16_bf16(kf[2 * d0], qr[d0], p0, 0, 0, 0);
        p1 = __builtin_amdgcn_mfma_f32_32x32x16_bf16(kf[2 * d0 + 1], qr[d0], p1, 0, 0, 0);
    }
}

template <int PV, bool F8O>
__device__ __forceinline__ void fox_unit(int b, int h, int qb, const bf16_t* FQ, const bf16_t* FK, const bf16_t* FV, const float* NCK, const unsigned* KN, bf16_t* AO, char* shm) {
    const int tid = fresh_tid(), lane = tid & 63, r32 = lane & 31, hi = lane >> 5; const int wid = __builtin_amdgcn_readfirstlane(tid >> 6);
    const long rowbase = (long)b * SEQ; const int q0 = qb * 256;
    const int NT = 4 * (qb + 1), tl = 4 * qb + (wid >> 1), i0 = NT - 1 - tl;
    const unsigned lds0 = (unsigned)(uintptr_t)shm;
    const lds_cptr shm3 = (lds_cptr)shm;
    LAS float* nckl = (LAS float*)(shm3 + LDS_NCK);
    LAS unsigned* vote = (LAS unsigned*)(shm3 + L_VOTE);
    const int krow = wid * 8 + (lane >> 3);
    const bf16_t* ksrc = FK + (rowbase + krow) * 512 + h * 64 + (((lane & 7) ^ ((krow >> 1) & 7)) << 3);
    const bf16_t* vsrc = FV + (rowbase + 16 * (wid & 3) + (lane >> 2)) * 512 + h * 64 + (wid >> 2) * 32 + (lane & 3) * 8;
    const unsigned kdst = lds0 + wid * 1024, vdst = lds0 + 8192 + wid * 1024;
#define FOX_DMA(t, so) do { glds16(ksrc + (long)(t) * 64 * 512, (unsigned)__builtin_amdgcn_readfirstlane(kdst + (so))); glds16(vsrc + (long)(t) * 64 * 512, (unsigned)__builtin_amdgcn_readfirstlane(vdst + (so))); } while (0)
    FOX_DMA(NT - 1, 0); FOX_DMA(NT - 2, STG_F);
    { const f32x4* src = (const f32x4*)(NCK + (size_t)(b * 8 + h) * SEQ); const int n4 = 16 * NT;
      f32x4 c0 = {0.f, 0.f, 0.f, 0.f}, c1 = c0; if (tid < n4) c0 = src[tid]; if (tid + NTHR < n4) c1 = src[tid + NTHR];
      if (tid < n4) ((LAS f32x4*)nckl)[tid] = c0; if (tid + NTHR < n4) ((LAS f32x4*)nckl)[tid + NTHR] = c1; }
    const bf16_t* Qw = FQ + (rowbase + q0 + wid * 32 + r32) * 512 + h * 64;
    bf16x8 qr[4];
#pragma unroll
    for (int d0 = 0; d0 < 4; ++d0) qr[d0] = *(const bf16x8*)(Qw + d0 * 16 + hi * 8);
    const float kn2 = __uint_as_float(KN[(b * 8 + h) * 2]) + __uint_as_float(KN[(b * 8 + h) * 2 + 1]);
    asm volatile("" : "+v"(qr[0]), "+v"(qr[1]), "+v"(qr[2]), "+v"(qr[3]));
    float qn2 = 0.f;
#pragma unroll
    for (int d0 = 0; d0 < 4; ++d0) { const u32x4 w = __builtin_bit_cast(u32x4, qr[d0]);
#pragma unroll
        for (int j = 0; j < 4; ++j) { const float a = bf_lo(w[j]), c = bf_hi(w[j]); qn2 += a * a + c * c; } }
    qn2 = swapsum(qn2);
    const float Bq = sqrtf(qn2 * kn2) * 1.02f + 0.01f;
    const lds_cptr kp0 = shm3 + r32 * 128; const int ksw = (r32 >> 1) & 7;
    const lds_cptr vp0 = shm3 + 8192 + ((lane >> 4) & 1) * 32 + (lane & 3) * 8 + (4 * hi + ((lane & 15) >> 2)) * 64;
    float m = -1e30f, l = 0.f; f32x16 o[2]; o[0] = f32x16{}; o[1] = f32x16{};
    const int qrow = q0 + wid * 32 + r32;
    int so = 0, so2 = 2 * STG_F;
    for (int i = 0; i < NT; ++i) {
        const int t = NT - 1 - i;
        if (i + 1 < NT) ATT_WAIT_BAR(2); else ATT_WAIT_BAR(0);
        if (i > 0) {
            const LAS unsigned* vv = vote + ((i - 1) & 1) * 8; const u32x4 va4 = *(const LAS u32x4*)vv, vb4 = *(const LAS u32x4*)(vv + 4);
            if (((va4[0] | va4[1]) | (va4[2] | va4[3]) | (vb4[0] | vb4[1]) | (vb4[2] | vb4[3])) == 0u) break;
        }
        bf16x8 kf[8];
        if (i >= i0) kload(kf, kp0 + so, hi, ksw);
        if (i + 2 < NT) FOX_DMA(t - 2, so2);
        unsigned myvote = 1u;
        if (i >= i0) {
            f32x16 p0, p1; VFrag va, vb;
            const LAS float* nk = nckl + 64 * t + 4 * hi;
#pragma unroll
            for (int g = 0; g < 4; ++g) { const f32x4 a = *(const LAS f32x4*)(nk + 8 * g), c = *(const LAS f32x4*)(nk + 32 + 8 * g);
                p0[4 * g] = a[0]; p0[4 * g + 1] = a[1]; p0[4 * g + 2] = a[2]; p0[4 * g + 3] = a[3]; p1[4 * g] = c[0]; p1[4 * g + 1] = c[1]; p1[4 * g + 2] = c[2]; p1[4 * g + 3] = c[3]; }
            vload(va, vp0 + so, 0);
            ATT_SBAR();
            qk_mma(p0, p1, kf, qr);
            asm volatile("s_nop 15\n\ts_nop 7" : "+v"(p0), "+v"(p1));
            ATT_SBAR();
            if (i == i0) { const int kb = 64 * t + 4 * hi;
#pragma unroll
                for (int r = 0; r < 16; ++r) { const int kv = kb + (r & 3) + 8 * (r >> 2); if (kv > qrow) p0[r] = -INFINITY; if (kv + 32 > qrow) p1[r] = -INFINITY; } }
            u32x4 pw[4];
            softmax_tile<2, false>(p0, p1, m, l, o, pw, p0, false);
            ATT_SBAR();
            vload(vb, vp0 + so, 1);
            pv_block(o[0], va, pw);
            ATT_SBAR();
            pv_block(o[1], vb, pw);
            ATT_SBAR();
            myvote = (t > 0 && __any(Bq + nckl[64 * t - 1] - m > -48.0f)) ? 1u : 0u;
        }
        if (lane == 0) vote[(i & 1) * 8 + wid] = myvote;
        so = (so == 2 * STG_F) ? 0 : so + STG_F; so2 = (so2 == 2 * STG_F) ? 0 : so2 + STG_F;
    }
#undef FOX_DMA
    asm volatile("s_waitcnt vmcnt(0)" ::: "memory");
    ATT_BAR();
    l = swapsum(l);
    const float inv = __builtin_amdgcn_rcpf(l);
    if constexpr (F8O) {
        unsigned char* Ow = (unsigned char*)AO + (rowbase + qrow) * 1024 + 512 + h * 64 + 8 * hi;
#pragma unroll
        for (int d = 0; d < 2; ++d)
#pragma unroll
            for (int g = 0; g < 4; g += 2) {
                const unsigned wa = pack4_fp8(o[d][4 * g] * inv, o[d][4 * g + 1] * inv, o[d][4 * g + 2] * inv, o[d][4 * g + 3] * inv), wb = pack4_fp8(o[d][4 * g + 4] * inv, o[d][4 * g + 5] * inv, o[d][4 * g + 6] * inv, o[d][4 * g + 7] * inv);
                auto r = __builtin_amdgcn_permlane32_swap(wa, wb, false, false);
                *(u32x2*)(Ow + d * 32 + 8 * g) = (u32x2){r[0], r[1]}; }
    } else {
    bf16_t* Ow = AO + (rowbase + qrow) * 1024 + 512 + h * 64 + 8 * hi;
#pragma unroll
    for (int d = 0; d < 2; ++d)
#pragma unroll
        for (int g = 0; g < 4; g += 2) { u32x2 wa, wb;
            wa.x = cvt_pk_bf16(o[d][4 * g] * inv, o[d][4 * g + 1] * inv); wa.y = cvt_pk_bf16(o[d][4 * g + 2] * inv, o[d][4 * g + 3] * inv);
            wb.x = cvt_pk_bf16(o[d][4 * g + 4] * inv, o[d][4 * g + 5] * inv); wb.y = cvt_pk_bf16(o[d][4 * g + 6] * inv, o[d][4 * g + 7] * inv);
            *(u32x4*)(Ow + d * 32 + 8 * g) = widen_pair(wa, wb); }
    }
}

template <int PV, bool F8O>
__device__ __forceinline__ void diff_unit(int b, int h, int qb, const bf16_t* DQ, const bf16_t* DK, const bf16_t* DV, const float* subg, float lam, float post, bf16_t* AO, char* shm) {
    const int tid = fresh_tid(), lane = tid & 63, r32 = lane & 31, hi = lane >> 5; const int wid = __builtin_amdgcn_readfirstlane(tid >> 6);
    const int map = wid >> 2, wq = wid & 3;
    const long rowbase = (long)b * SEQ; const int q0 = qb * 128;
    const int NT = 2 * (qb + 1), tl = 2 * qb + (wq >> 1);
    const unsigned lds0 = (unsigned)(uintptr_t)shm;
    const lds_cptr shm3 = (lds_cptr)shm;
    const int qrow = q0 + wq * 32 + r32;
    const int krow = wid * 8 + (lane >> 3);
    const bf16_t* ksrc = DK + (rowbase + krow) * 512 + h * 128 + (((lane & 7) ^ ((krow >> 1) & 7)) << 3);
    const bf16_t* vsrc = DV + (rowbase + 16 * (wid & 3) + (lane >> 2)) * 512 + h * 128 + (wid >> 2) * 32 + (lane & 3) * 8;
    const unsigned kdst = lds0 + wid * 1024, vdst = lds0 + 16384 + wid * 1024;
#define DIFF_DMA(t, so) do { glds16(ksrc + (long)(t) * 64 * 512, (unsigned)__builtin_amdgcn_readfirstlane(kdst + (so))); glds16(ksrc + (long)(t) * 64 * 512 + 64, (unsigned)__builtin_amdgcn_readfirstlane(kdst + 8192 + (so))); \
        glds16(vsrc + (long)(t) * 64 * 512, (unsigned)__builtin_amdgcn_readfirstlane(vdst + (so))); glds16(vsrc + (long)(t) * 64 * 512 + 64, (unsigned)__builtin_amdgcn_readfirstlane(vdst + 8192 + (so))); } while (0)
    if ((PV & 8) == 0) { DIFF_DMA(0, 0); DIFF_DMA(1, STG_D); }
    const bf16_t* Qw = DQ + (rowbase + qrow) * 512 + h * 128 + map * 64;
    bf16x8 qr[4];
#pragma unroll
    for (int d0 = 0; d0 < 4; ++d0) qr[d0] = *(const bf16x8*)(Qw + d0 * 16 + hi * 8);
    asm volatile("" : "+v"(qr[0]), "+v"(qr[1]), "+v"(qr[2]), "+v"(qr[3]));
    const lds_cptr kp0 = shm3 + map * 8192 + r32 * 128; const int ksw = (r32 >> 1) & 7;
    const lds_cptr vp0 = shm3 + 16384 + ((lane >> 4) & 1) * 32 + (lane & 3) * 8 + (4 * hi + ((lane & 15) >> 2)) * 64;
    float m = 0.f, l = 0.f; f32x16 o[4]; o[0] = f32x16{}; o[1] = f32x16{}; o[2] = f32x16{}; o[3] = f32x16{};
    f32x16 negm = f32x16{}; asm volatile("" : "+v"(negm));
    int so = 0, so2 = 2 * STG_D;
    for (int t = 0; t < NT; ++t) {
        if ((PV & 8) == 0) { if (t + 1 < NT) ATT_WAIT_BAR(4); else ATT_WAIT_BAR(0); } else ATT_BAR();
        bf16x8 kf[8];
        if ((PV & 4) == 0 && t <= tl) kload(kf, kp0 + so, hi, ksw);
        if ((PV & 8) == 0 && t + 2 < NT) DIFF_DMA(t + 2, so2);
        if (t <= tl) {
            f32x16 p0 = negm, p1 = negm; VFrag va, vb;
            if ((PV & 1) == 0) vload(va, vp0 + so, 0);
            ATT_SBAR();
            if ((PV & 4) == 0) qk_mma(p0, p1, kf, qr);
            asm volatile("s_nop 15\n\ts_nop 7" : "+v"(p0), "+v"(p1));
            ATT_SBAR();
            u32x4 pw[4];
            if ((PV & 2) == 0) softmax_tile<4, true>(p0, p1, m, l, o, pw, negm, t == 0); else { pw[0] = (u32x4){__float_as_uint(p0[0]), __float_as_uint(p0[1]), __float_as_uint(p1[0]), __float_as_uint(p1[1])}; pw[1] = pw[0]; pw[2] = pw[0]; pw[3] = pw[0]; }
            ATT_SBAR();
            if ((PV & 1) == 0) { vload(vb, vp0 + so, 1);
            pv_block(o[0], va, pw);
            ATT_SBAR();
            vload(va, vp0 + so, 2);
            pv_block(o[1], vb, pw);
            ATT_SBAR();
            vload(vb, vp0 + so, 3);
            pv_block(o[2], va, pw);
            ATT_SBAR();
            pv_block(o[3], vb, pw); } else { o[0][0] += __uint_as_float(pw[0][0]); o[1][0] += __uint_as_float(pw[1][1]); }
            ATT_SBAR();
        }
        so = (so == 2 * STG_D) ? 0 : so + STG_D; so2 = (so2 == 2 * STG_D) ? 0 : so2 + STG_D;
    }
#undef DIFF_DMA
    l = swapsum(l);
    const float inv = __builtin_amdgcn_rcpf(l);
    ATT_BAR();
    LAS float* xch = (LAS float*)shm3 + (wq * 64) * 64 + lane;
    if (map == 1) {
#pragma unroll
        for (int d = 0; d < 4; ++d)
#pragma unroll
            for (int r = 0; r < 16; ++r) xch[(d * 16 + r) * 64] = o[d][r] * inv;
    }
    ATT_BAR();
    if (map == 0) {
        float ss = 0.f;
#pragma unroll
        for (int d = 0; d < 4; ++d)
#pragma unroll
            for (int r = 0; r < 16; ++r) { const float a = o[d][r] * inv - lam * xch[(d * 16 + r) * 64]; o[d][r] = a; ss += a * a; }
        ss = swapsum(ss);
        const float rn = __builtin_amdgcn_rsqf(ss * (1.0f / 128.0f) + NORM_EPS) * post;
        if constexpr (F8O) {
            unsigned char* Ow = (unsigned char*)AO + (rowbase + qrow) * 1024 + h * 128 + 8 * hi;
#pragma unroll
            for (int d = 0; d < 4; ++d)
#pragma unroll
                for (int g = 0; g < 4; g += 2) { const f32x4 sa = *(const f32x4*)(subg + d * 32 + 8 * g + 4 * hi), sb = *(const f32x4*)(subg + d * 32 + 8 * g + 8 + 4 * hi);
                    const unsigned wa = pack4_fp8(o[d][4 * g] * rn * sa[0], o[d][4 * g + 1] * rn * sa[1], o[d][4 * g + 2] * rn * sa[2], o[d][4 * g + 3] * rn * sa[3]);
                    const unsigned wb = pack4_fp8(o[d][4 * g + 4] * rn * sb[0], o[d][4 * g + 5] * rn * sb[1], o[d][4 * g + 6] * rn * sb[2], o[d][4 * g + 7] * rn * sb[3]);
                    auto r = __builtin_amdgcn_permlane32_swap(wa, wb, false, false);
                    *(u32x2*)(Ow + d * 32 + 8 * g) = (u32x2){r[0], r[1]}; }
        } else {
        bf16_t* Ow = AO + (rowbase + qrow) * 1024 + h * 128 + 8 * hi;
#pragma unroll
        for (int d = 0; d < 4; ++d)
#pragma unroll
            for (int g = 0; g < 4; g += 2) { const f32x4 sa = *(const f32x4*)(subg + d * 32 + 8 * g + 4 * hi), sb = *(const f32x4*)(subg + d * 32 + 8 * g + 8 + 4 * hi);
                u32x2 wa, wb;
                wa.x = cvt_pk_bf16(o[d][4 * g] * rn * sa[0], o[d][4 * g + 1] * rn * sa[1]); wa.y = cvt_pk_bf16(o[d][4 * g + 2] * rn * sa[2], o[d][4 * g + 3] * rn * sa[3]);
                wb.x = cvt_pk_bf16(o[d][4 * g + 4] * rn * sb[0], o[d][4 * g + 5] * rn * sb[1]); wb.y = cvt_pk_bf16(o[d][4 * g + 6] * rn * sb[2], o[d][4 * g + 7] * rn * sb[3]);
                *(u32x4*)(Ow + d * 32 + 8 * g) = widen_pair(wa, wb); }
        }
    }
    ATT_BAR();
}
}

struct Args {
    const float* x; const float* c; const int* pos; const float* ada_w; const float* ada_b; const float* norm_mix; const float* norm_ffn; const float* w_in;
    const float* b_forget; const float* lq1; const float* lk1; const float* lq2; const float* lk2; const float* subln; const float* w_out; const float* router_w;
    const float* router_b; const float* w1; const float* b1; const float* w2; const float* b2; const float* final_norm;
    float* out; unsigned char* ws; int ph_lo, ph_hi;
};

__device__ __forceinline__ void transpose_item(const float* W, int ldw, int K, bf16_t* WT, int k0, int n0, int drow, LAS float* scr, int lane) {
    float ld_[32];
#pragma unroll
    for (int i = 0; i < 32; ++i) ld_[i] = W[(size_t)(k0 + 2 * i + (lane >> 5)) * ldw + n0 + (lane & 31)];
#pragma unroll
    for (int i = 0; i < 32; ++i) scr[(2 * i + (lane >> 5)) * 33 + (lane & 31)] = ld_[i];
    asm volatile("s_waitcnt lgkmcnt(0)" ::: "memory");
    const int c = lane & 7;
#pragma unroll
    for (int j = 0; j < 4; ++j) { const int n = (lane >> 3) + 8 * j; const LAS float* s = scr + (8 * c) * 33 + n;
        u32x4 o; o.x = cvt_pk_bf16(s[0 * 33], s[1 * 33]); o.y = cvt_pk_bf16(s[2 * 33], s[3 * 33]); o.z = cvt_pk_bf16(s[4 * 33], s[5 * 33]); o.w = cvt_pk_bf16(s[6 * 33], s[7 * 33]);
        *(u32x4*)(WT + (size_t)(drow + n) * K + k0 + 8 * c) = o; }
    asm volatile("s_waitcnt lgkmcnt(0)" ::: "memory");
}

__device__ __forceinline__ void transpose_item_f8(const float* W, int ldw, int K, unsigned char* WT, int k0, int n0, int drow, LAS float* scr, int lane) {
    float ld_[32];
#pragma unroll
    for (int i = 0; i < 32; ++i) ld_[i] = W[(size_t)(k0 + 2 * i + (lane >> 5)) * ldw + n0 + (lane & 31)];
#pragma unroll
    for (int i = 0; i < 32; ++i) scr[(2 * i + (lane >> 5)) * 33 + (lane & 31)] = ld_[i];
    asm volatile("s_waitcnt lgkmcnt(0)" ::: "memory");
    const int c = lane & 7;
#pragma unroll
    for (int j = 0; j < 4; ++j) { const int n = (lane >> 3) + 8 * j; const LAS float* s = scr + (8 * c) * 33 + n;
        u32x2 o; o.x = pack4_fp8(s[0 * 33] * 32.f, s[1 * 33] * 32.f, s[2 * 33] * 32.f, s[3 * 33] * 32.f); o.y = pack4_fp8(s[4 * 33] * 32.f, s[5 * 33] * 32.f, s[6 * 33] * 32.f, s[7 * 33] * 32.f);
        *(u32x2*)(WT + (size_t)(drow + n) * K + k0 + 8 * c) = o; }
    asm volatile("s_waitcnt lgkmcnt(0)" ::: "memory");
}

#define CB(j) (512 * ((j) >> 1) + 8 * lane + 4 * ((j) & 1))
template <bool F8OUT>
__device__ __forceinline__ void norm1_row(const f32x4 (&v)[4], const f32x4 (&gm)[4], const f32x4 (&sh)[4], const LAS float* wft, const float* bfor, bf16_t* xnrow, float* LF, int b, int s, int lane) {
    float ss = 0.f;
#pragma unroll
    for (int j = 0; j < 4; ++j) ss += (v[j][0] * v[j][0] + v[j][1] * v[j][1]) + (v[j][2] * v[j][2] + v[j][3] * v[j][3]);
    const float rstd = __builtin_amdgcn_rsqf(wave_sum(ss) * (1.0f / DM) + NORM_EPS);
    f32x4 hv[4];
#pragma unroll
    for (int j = 0; j < 4; ++j) hv[j] = v[j] * rstd * gm[j] + sh[j];
#pragma unroll
    for (int jj = 0; jj < 2; ++jj) { const f32x4 a = hv[2 * jj], c = hv[2 * jj + 1];
        if constexpr (F8OUT) { u32x2 w; w.x = pack4_fp8(a[0], a[1], a[2], a[3]); w.y = pack4_fp8(c[0], c[1], c[2], c[3]); *(u32x2*)((unsigned char*)xnrow + 512 * jj + 8 * lane) = w; }
        else { u32x4 w; w.x = cvt_pk_bf16(a[0], a[1]); w.y = cvt_pk_bf16(a[2], a[3]); w.z = cvt_pk_bf16(c[0], c[1]); w.w = cvt_pk_bf16(c[2], c[3]); *(u32x4*)(xnrow + 512 * jj + 8 * lane) = w; } }
    float a8[8];
#pragma unroll
    for (int hh = 0; hh < 8; ++hh) { float a = 0.f;
#pragma unroll
        for (int j = 0; j < 4; ++j) { const f32x4 w = *(const LAS f32x4*)(wft + hh * DM + CB(j)); a += (hv[j][0] * w[0] + hv[j][1] * w[1]) + (hv[j][2] * w[2] + hv[j][3] * w[3]); }
        a8[hh] = a; }
    float a4[4], a2[2], a1;
    { const bool up = (lane & 32) != 0;
#pragma unroll
      for (int i = 0; i < 4; ++i) { const float snd = up ? a8[i] : a8[i + 4], kp = up ? a8[i + 4] : a8[i]; a4[i] = kp + __shfl_xor(snd, 32); } }
    { const bool up = (lane & 16) != 0;
#pragma unroll
      for (int i = 0; i < 2; ++i) { const float snd = up ? a4[i] : a4[i + 2], kp = up ? a4[i + 2] : a4[i]; a2[i] = kp + __shfl_xor(snd, 16); } }
    { const bool up = (lane & 8) != 0; const float snd = up ? a2[0] : a2[1], kp = up ? a2[1] : a2[0]; a1 = kp + __shfl_xor(snd, 8); }
    a1 += __shfl_xor(a1, 4); a1 += __shfl_xor(a1, 2); a1 += __shfl_xor(a1, 1);
    if ((lane & 7) == 0) { const int hd = lane >> 3; const float z = a1 + bfor[hd];
        const float lf = (z >= 0.f) ? -log1pf(__expf(-z)) : (z - log1pf(__expf(z)));
        LF[(size_t)(b * 8 + hd) * SEQ + s] = lf; }
}

__global__ void __launch_bounds__(NTHR, 2) fwd_kernel(Args args) {
    extern __shared__ __attribute__((aligned(16))) unsigned char lds[];
    LAS unsigned char* L = (LAS unsigned char*)lds;
    int tid = threadIdx.x, lane = tid & 63, wave = __builtin_amdgcn_readfirstlane(tid >> 6);
#define FRESH_IDS() do { tid = fresh_tid(); lane = tid & 63; wave = __builtin_amdgcn_readfirstlane(tid >> 6); gw = vcu * NWAVES + wave; } while (0)
    const int G = gridDim.x; const int bx = blockIdx.x; const int vcu = (G % 8 == 0) ? (bx % 8) * (G / 8) + bx / 8 : bx;
#define WSPTRS() unsigned char* ws = args.ws; asm volatile("" : "+s"(ws)); \
    unsigned* ctl = (unsigned*)(ws + WS_CTL); (void)ctl; \
    bf16_t* WQ = (bf16_t*)(ws + WS_WQ); float* BQ = (float*)(ws + WS_BQ); (void)WQ; (void)BQ; \
    float* MOD = (float*)(ws + WS_MOD); float* RWT = (float*)(ws + WS_RWT); float* WFT = (float*)(ws + WS_WFT); float* ROPE = (float*)(ws + WS_ROPE); \
    float* NCK = (float*)(ws + WS_NCK); float* LF = (float*)(ws + WS_LF); float* GATES = (float*)(ws + WS_GATES); int* ROWL = (int*)(ws + WS_ROWL); \
    bf16_t* WIN = (bf16_t*)(ws + WS_WIN); bf16_t* WOUT = (bf16_t*)(ws + WS_WOUT); unsigned char* W1T = ws + WS_W1; unsigned char* W2T = ws + WS_W2; \
    bf16_t* XN = (bf16_t*)(ws + WS_XN); bf16_t* QKV = (bf16_t*)(ws + WS_QKV); bf16_t* AO = (bf16_t*)(ws + WS_AO); \
    float* X1 = (float*)(ws + WS_X1); float* X2 = (float*)(ws + WS_X2); unsigned char* XN2 = ws + WS_XN2; unsigned char* HID = ws + WS_HID; bf16_t* Y = (bf16_t*)(ws + WS_Y); \
    (void)MOD; (void)RWT; (void)WFT; (void)ROPE; (void)NCK; (void)LF; (void)GATES; (void)ROWL; (void)WIN; (void)WOUT; (void)W1T; (void)W2T; (void)XN; (void)QKV; (void)AO; (void)X1; (void)X2; (void)XN2; (void)HID; (void)Y
    for (int u = tid; u < 256; u += NTHR) ((LAS unsigned*)(L + MISC_OFF))[u] = 0u;
    __syncthreads();
#if MK_MULTI
#define GRID_BAR() do { } while (0)
#else
    XcdBarrier bar = xcd_barrier_post((unsigned*)(args.ws + WS_CTL) + CW_BAR, (volatile LAS unsigned*)(L + L_XBST));
#define GRID_BAR() xcd_barrier(bar)
#endif
    long tacc = 0;
    TP_BEGIN(30)
    const int lo = args.ph_lo, hi_ = args.ph_hi;
#ifndef PH_MASK
#define PH_MASK 0x1ff
#endif
#define IN(k) (lo <= (k) && (k) < hi_)
#define ON(j) (((PH_MASK) >> (j)) & 1)
#ifndef REP_MASK
#define REP_MASK 0
#endif
#define NREP(j) (1 + (((REP_MASK) >> (j)) & 1))
#define BOTH(k) (IN(k) && IN((k) + 1))
    int gw = vcu * NWAVES + wave; const int NGW = G * NWAVES;

    if (ON(0) && IN(0)) { TP_BEGIN(20)
        FRESH_IDS(); WSPTRS();
        for (int rep_ = 0; rep_ < NREP(0); ++rep_) {
        TP_BEGIN(31)
        {
            LAS float* cact = (LAS float*)(L + 73728);
            LAS float* part = (LAS float*)(L + 73728 + 32768);
            for (int i = tid; i < 8 * DM; i += NTHR) { const float cv = args.c[i]; cact[i] = cv / (1.0f + __expf(-cv)); }
            __syncthreads();
            for (int it = vcu; it < 256; it += G) {
                const int l = it >> 7, j0 = (it & 127) * 48; const bool on = lane < 48;
                const float* aw = args.ada_w + (size_t)l * DM * 6144 + j0 + (on ? lane : 0);
                float a8[8] = {0.f, 0.f, 0.f, 0.f, 0.f, 0.f, 0.f, 0.f};
                for (int kc = 0; kc < 4; ++kc) { const int kb = wave * 128 + kc * 32; float av[32];
#pragma unroll
                    for (int i = 0; i < 32; ++i) av[i] = aw[(size_t)(kb + i) * 6144];
#pragma unroll
                    for (int i = 0; i < 32; ++i)
#pragma unroll
                        for (int b = 0; b < 8; ++b) a8[b] += cact[b * DM + kb + i] * av[i]; }
#pragma unroll
                for (int b = 0; b < 8; ++b) part[(wave * 8 + b) * 64 + lane] = a8[b];
                __syncthreads();
                { const int b = tid >> 6; float s = 0.f;
#pragma unroll
                  for (int w = 0; w < 8; ++w) s += part[(w * 8 + b) * 64 + lane];
                  if (on) MOD[((size_t)l * 8 + b) * 6144 + j0 + lane] = s + args.ada_b[l * 6144 + j0 + lane]; }
                __syncthreads();
            }
        }
        TP_END(31) TP_BEGIN(32)
        {
            const int gt = vcu * NTHR + tid, NGT = G * NTHR;
            const double invf[8] = {1.0, 0.1939227432012558, 0.03760603070259094, 0.007292664609849453, 0.0014142135623842478, 0.00027424818836152554, 5.3182957344688475e-05, 1.0313385246263351e-05};
            for (int i = gt; i < NTOK * 8; i += NGT) { const int tok = i >> 3, j = i & 7;
                double iv = invf[0];
#pragma unroll
                for (int q = 1; q < 8; ++q) iv = (j == q) ? invf[q] : iv;
                double rev = (double)args.pos[tok] * iv * 0.15915494309189535; rev -= rint(rev); const float fr_ = (float)rev;
                ROPE[(size_t)tok * 16 + j] = __builtin_amdgcn_cosf(fr_); ROPE[(size_t)tok * 16 + 8 + j] = __builtin_amdgcn_sinf(fr_); }
            for (int i = gt; i < DEPTH * NEXP * DM; i += NGT) { const int l = i / (NEXP * DM), r = i % (NEXP * DM), e = r / DM, k = r % DM; RWT[i] = args.router_w[((size_t)l * DM + k) * NEXP + e]; }
            for (int i = gt; i < DEPTH * 8 * DM; i += NGT) { const int l = i / (8 * DM), r = i % (8 * DM), hh = r / DM, k = r % DM; WFT[i] = args.w_in[((size_t)l * DM + k) * INCOLS + 3072 + hh]; }
        }
        TP_END(32) TP_BEGIN(33)
        {
            LAS float* tile = (LAS float*)L;
            constexpr int TS = 265;
            constexpr int I_IN = 16 * 12, I_OUT = 16 * 4, I_1 = 16 * 8, I_2 = 16 * 4;
            constexpr int T_IN = DEPTH * I_IN, T_OUT = DEPTH * I_OUT, T_1 = DEPTH * NEXP * I_1, T_2 = DEPTH * NEXP * I_2, T_ALL = T_IN + T_OUT + T_1 + T_2;
            struct Desc { const float* W; unsigned char* WT; int ldw, k0, n0, kind; };
            auto desc = [&](int it) { Desc d; int r = it;
                if (r < T_IN) { const int l = r / I_IN, q = r % I_IN, kb = q / 12, nb = q % 12;
                    d.W = args.w_in + (size_t)l * DM * INCOLS; d.ldw = INCOLS; d.k0 = kb * 64; d.n0 = nb * 256; d.kind = (l != 0) ? 1 : 0;
                    d.WT = (l == 0) ? (unsigned char*)WIN : (unsigned char*)(WIN + (size_t)3072 * DM); return d; }
                r -= T_IN;
                if (r < T_OUT) { const int l = r / I_OUT, q = r % I_OUT, kb = q / 4, nb = q % 4;
                    d.W = args.w_out + (size_t)l * DM * DM; d.ldw = DM; d.k0 = kb * 64; d.n0 = nb * 256; d.kind = (l != 0) ? 1 : 0; d.WT = (unsigned char*)(WOUT + (size_t)l * DM * DM); return d; }
                r -= T_OUT;
                if (r < T_1) { const int le = r / I_1, q = r % I_1, kb = q / 8, nb = q % 8;
                    d.W = args.w1 + (size_t)le * DM * 2048; d.ldw = 2048; d.k0 = kb * 64; d.n0 = nb * 256; d.kind = 2; d.WT = W1T + (size_t)le * 2048 * DM; return d; }
                r -= T_1;
                { const int le = r / I_2, q = r % I_2, kb = q / 4, nb = q % 4;
                    d.W = args.w2 + (size_t)le * DM * DM; d.ldw = DM; d.k0 = kb * 64; d.n0 = nb * 256; d.kind = 1; d.WT = W2T + (size_t)le * DM * DM; return d; } };
            f32x4 lda[8], ldb[8], ldq[8]; Desc da, db, dq;
#define P0_LOAD(ld_, d_, it_) do { d_ = desc((it_) < T_ALL ? (it_) : 0); if ((it_) < T_ALL) { _Pragma("unroll") for (int i = 0; i < 8; ++i) ld_[i] = *(const f32x4*)(d_.W + (size_t)(d_.k0 + 8 * wave + i) * d_.ldw + d_.n0 + 4 * lane); } } while (0)
#define P0_PROC(ld_, d_) do { \
                _Pragma("unroll") for (int i = 0; i < 8; ++i) { LAS float* tp = tile + (8 * wave + i) * TS + 4 * lane + (lane >> 3); tp[0] = ld_[i][0]; tp[1] = ld_[i][1]; tp[2] = ld_[i][2]; tp[3] = ld_[i][3]; } \
                __syncthreads(); \
                { const int c = lane & 7; \
                _Pragma("unroll") for (int r2 = 0; r2 < 4; ++r2) { const int nr = 32 * wave + 8 * r2 + (lane >> 3); const LAS float* sp = tile + (8 * c) * TS + nr + (nr >> 5); \
                    const int n = d_.n0 + nr; \
                    const int drow = (d_.kind == 2) ? ((n < 1024) ? ((n >> 7) * 256 + (n & 127)) : ((((n - 1024) >> 7) * 256) + 128 + ((n - 1024) & 127))) : n; \
                    if (d_.kind != 0) { u32x2 o; o.x = pack4_fp8(sp[0 * TS] * 32.f, sp[1 * TS] * 32.f, sp[2 * TS] * 32.f, sp[3 * TS] * 32.f); o.y = pack4_fp8(sp[4 * TS] * 32.f, sp[5 * TS] * 32.f, sp[6 * TS] * 32.f, sp[7 * TS] * 32.f); \
                        *(u32x2*)(d_.WT + (size_t)drow * DM + d_.k0 + 8 * c) = o; } \
                    else { u32x4 o; o.x = cvt_pk_bf16(sp[0 * TS], sp[1 * TS]); o.y = cvt_pk_bf16(sp[2 * TS], sp[3 * TS]); o.z = cvt_pk_bf16(sp[4 * TS], sp[5 * TS]); o.w = cvt_pk_bf16(sp[6 * TS], sp[7 * TS]); \
                        *(u32x4*)((bf16_t*)d_.WT + (size_t)drow * DM + d_.k0 + 8 * c) = o; } } } \
                __syncthreads(); } while (0)
            int it = vcu;
            P0_LOAD(lda, da, it); P0_LOAD(ldb, db, it + G);
            __syncthreads();
            for (; it < T_ALL; it += 3 * G) {
                P0_LOAD(ldq, dq, it + 2 * G);
                P0_PROC(lda, da);
                if (it + G >= T_ALL) break;
                P0_LOAD(lda, da, it + 3 * G);
                P0_PROC(ldb, db);
                if (it + 2 * G >= T_ALL) break;
                P0_LOAD(ldb, db, it + 4 * G);
                P0_PROC(ldq, dq);
            }
#undef P0_LOAD
#undef P0_PROC
        }
        TP_END(33)
        } if (BOTH(0)) GRID_BAR(); TP_END(20)
    }

    if (ON(1) && IN(1)) { TP_BEGIN(21)
        FRESH_IDS(); WSPTRS();
        for (int rep_ = 0; rep_ < NREP(1); ++rep_) {
        for (int i = vcu * NTHR + tid; i < DEPTH * 8 * 32 * 2 * 64; i += G * NTHR) {
            const int ln = i & 63, blk = (i >> 6) & 1, sq = (i >> 7) & 31, bb = (i >> 12) & 7, ll = i >> 15;
            const int e = 16 * blk + (ln & 15), k0 = 32 * sq + 8 * (ln >> 4);
            const float* md = MOD + ((size_t)ll * 8 + bb) * 6144 + 4 * 1024;
            float w[8]; unsigned hi4[4], lo4[4];
#pragma unroll
            for (int j = 0; j < 8; ++j) w[j] = args.router_w[((size_t)ll * DM + k0 + j) * NEXP + e] * args.norm_ffn[ll * DM + k0 + j] * (1.0f + md[k0 + j]);
#pragma unroll
            for (int j = 0; j < 4; ++j) { hi4[j] = cvt_pk_bf16(w[2 * j], w[2 * j + 1]); lo4[j] = cvt_pk_bf16(w[2 * j] - bf_lo(hi4[j]), w[2 * j + 1] - bf_hi(hi4[j])); }
            u32x4* dst = (u32x4*)(WQ + ((((size_t)(ll * 8 + bb) * 32 + sq) * 2 + blk) * 2) * 64 * 8);
            dst[ln] = (u32x4){hi4[0], hi4[1], hi4[2], hi4[3]}; dst[64 + ln] = (u32x4){lo4[0], lo4[1], lo4[2], lo4[3]};
        }
        for (int i = gw; i < DEPTH * 8 * 32; i += NGW) { const int e = i & 31, bb = (i >> 5) & 7, ll = i >> 8;
            const float* md = MOD + ((size_t)ll * 8 + bb) * 6144 + 3 * 1024; float a = 0.f;
#pragma unroll 4
            for (int j = 0; j < 16; ++j) { const int k = lane + 64 * j; a += md[k] * args.router_w[((size_t)ll * DM + k) * NEXP + e]; }
            a = wave_sum(a); if (lane == 0) BQ[i] = a + args.router_b[ll * NEXP + e]; }
        LAS float* wft = (LAS float*)L;
        for (int i = tid; i < 8 * DM; i += NTHR) wft[i] = WFT[i];
        __syncthreads();
        for (int ch = gw; ch < NTOK / 16; ch += NGW) {
            const int b = ch >> 8; const float* mod = MOD + (size_t)b * 6144;
            f32x4 gm[4], sh[4];
#pragma unroll
            for (int j = 0; j < 4; ++j) { const int c0 = CB(j); const f32x4 g = *(const f32x4*)(args.norm_mix + c0), sc = *(const f32x4*)(mod + 1024 + c0); gm[j] = g * (sc + 1.0f); sh[j] = *(const f32x4*)(mod + c0); }
#pragma unroll 2
            for (int rr = 0; rr < 16; ++rr) { const int mrow = ch * 16 + rr;
                f32x4 v[4];
#pragma unroll
                for (int j = 0; j < 4; ++j) v[j] = *(const f32x4*)(args.x + (size_t)mrow * DM + CB(j));
                norm1_row<false>(v, gm, sh, wft, args.b_forget, XN + (size_t)mrow * DM, LF, b, mrow & (SEQ - 1), lane); }
        }
        __syncthreads();
        } if (BOTH(1)) GRID_BAR(); TP_END(21)
    }

    for (int l = 0; l < DEPTH; ++l) {
        const int pb = 2 + 7 * l;
#define modl (MOD + (size_t)l * 8 * 6144)
#define xin ((l == 0) ? args.x : (const float*)X2)
        if (ON(2) && IN(pb + 0)) { TP_BEGIN(22)
            FRESH_IDS(); WSPTRS();
        for (int rep_ = 0; rep_ < NREP(2); ++rep_) {
            if (vcu < 64) {
                const float* src = LF + (size_t)vcu * SEQ + 8 * tid; float* dst = NCK + (size_t)vcu * SEQ + 8 * tid;
                f32x4 a = *(const f32x4*)src, c2 = *(const f32x4*)(src + 4);
                float e[8] = {a[0], a[1], a[2], a[3], c2[0], c2[1], c2[2], c2[3]};
#pragma unroll
                for (int i = 1; i < 8; ++i) e[i] += e[i - 1];
                float tot = e[7], inc = tot;
#pragma unroll
                for (int o = 1; o < 64; o <<= 1) { const float n = __shfl_up(inc, o); if (lane >= o) inc += n; }
                LAS float* sc = (LAS float*)(L + L_SCAN);
                if (lane == 63) sc[wave] = inc;
                __syncthreads();
                float pre = inc - tot;
                for (int w = 0; w < wave; ++w) pre += sc[w];
                f32x4 o0, o1;
                o0[0] = -(e[0] + pre) * LOG2E; o0[1] = -(e[1] + pre) * LOG2E; o0[2] = -(e[2] + pre) * LOG2E; o0[3] = -(e[3] + pre) * LOG2E;
                o1[0] = -(e[4] + pre) * LOG2E; o1[1] = -(e[5] + pre) * LOG2E; o1[2] = -(e[6] + pre) * LOG2E; o1[3] = -(e[7] + pre) * LOG2E;
                *(f32x4*)dst = o0; *(f32x4*)(dst + 4) = o1;
            }
            __syncthreads();
            if (l == 0) {
                pg8::SchedDense S{(const char*)XN, (const char*)WIN, 12, (NTOK / 256) * 12, G, vcu, DM};
                const pg8::EpiInProj E{QKV, ROPE, ctl + CW_KN + l * 128, 1.0f};
                pg8::gemm_phase<pg8::EpiInProj, pg8::SchedDense, true>(L, DM, S, E, tacc);
            } else {
                pg8::SchedDenseG S{(const char*)XN, (const char*)(WIN + (size_t)3072 * DM), 12, (NTOK / 256) * 12, G, vcu, DM};
                const pg8::EpiInProj E{QKV, ROPE, ctl + CW_KN + l * 128, 0.03125f};
                pg8::gemm_phase<pg8::EpiInProj, pg8::SchedDenseG, true, true>(L, DM, S, E, tacc);
            }
            } if (BOTH(pb + 0)) GRID_BAR(); TP_END(22)
        }
        if (ON(3) && IN(pb + 1)) { TP_BEGIN(23)
            FRESH_IDS(); WSPTRS();
        for (int rep_ = 0; rep_ < NREP(3); ++rep_) {
            const bf16_t* DQ = QKV; const bf16_t* DK = QKV + (size_t)NTOK * 512; const bf16_t* DV = QKV + (size_t)2 * NTOK * 512;
            const bf16_t* FQ = QKV + (size_t)3 * NTOK * 512; const bf16_t* FK = QKV + (size_t)4 * NTOK * 512; const bf16_t* FV = QKV + (size_t)5 * NTOK * 512;
            const float lam_init = 0.8f - 0.6f * expf(-0.3f * (float)l);
            const float s1 = wave_sum(args.lq1[l * 64 + lane] * args.lk1[l * 64 + lane]), s2 = wave_sum(args.lq2[l * 64 + lane] * args.lk2[l * 64 + lane]);
            const float lam = expf(s1) - expf(s2) + lam_init;
#ifndef ATT_PV
#define ATT_PV 0
#endif
            if (l == 0) {
            for (int p = vcu; p < 512; p += G) { const int bh = p >> 3, s = p & 7;
                att::fox_unit<0, false>(bh >> 3, bh & 7, 15 - s, FQ, FK, FV, NCK, ctl + CW_KN + l * 128, AO, (char*)lds);
                att::fox_unit<0, false>(bh >> 3, bh & 7, s, FQ, FK, FV, NCK, ctl + CW_KN + l * 128, AO, (char*)lds); }
            for (int p = vcu; p < 512; p += G) { const int bh = p >> 4, s = p & 15;
                att::diff_unit<0, false>(bh >> 2, bh & 3, 31 - s, DQ, DK, DV, args.subln + l * 128, lam, 1.0f - lam_init, AO, (char*)lds);
                att::diff_unit<0, false>(bh >> 2, bh & 3, s, DQ, DK, DV, args.subln + l * 128, lam, 1.0f - lam_init, AO, (char*)lds); }
            } else {
            for (int p = vcu; p < 512; p += G) { const int bh = p >> 3, s = p & 7;
                att::fox_unit<0, true>(bh >> 3, bh & 7, 15 - s, FQ, FK, FV, NCK, ctl + CW_KN + l * 128, AO, (char*)lds);
                att::fox_unit<0, true>(bh >> 3, bh & 7, s, FQ, FK, FV, NCK, ctl + CW_KN + l * 128, AO, (char*)lds); }
            for (int p = vcu; p < 512; p += G) { const int bh = p >> 4, s = p & 15;
                att::diff_unit<0, true>(bh >> 2, bh & 3, 31 - s, DQ, DK, DV, args.subln + l * 128, lam, 1.0f - lam_init, AO, (char*)lds);
                att::diff_unit<0, true>(bh >> 2, bh & 3, s, DQ, DK, DV, args.subln + l * 128, lam, 1.0f - lam_init, AO, (char*)lds); }
            }
            } if (BOTH(pb + 1)) GRID_BAR(); TP_END(23)
        }
        if (ON(4) && IN(pb + 2)) { TP_BEGIN(24)
            FRESH_IDS(); WSPTRS();
        for (int rep_ = 0; rep_ < NREP(4); ++rep_) {
            if (l == 0) {
                pg8::SchedDense S{(const char*)AO, (const char*)WOUT, 4, (NTOK / 256) * 4, G, vcu, DM};
                const pg8::EpiOutProj E{xin, X1, modl + 2 * 1024, 1.0f};
                pg8::gemm_phase<pg8::EpiOutProj, pg8::SchedDense, true>(L, DM, S, E, tacc);
            } else {
                pg8::SchedDenseG S{(const char*)AO, (const char*)(WOUT + (size_t)DM * DM), 4, (NTOK / 256) * 4, G, vcu, DM};
                const pg8::EpiOutProj E{xin, X1, modl + 2 * 1024, 0.03125f};
                pg8::gemm_phase<pg8::EpiOutProj, pg8::SchedDenseG, true, true>(L, DM, S, E, tacc);
            }
            } if (BOTH(pb + 2)) GRID_BAR(); TP_END(24)
        }
        if (ON(5) && IN(pb + 3)) { TP_BEGIN(25)
            FRESH_IDS(); WSPTRS();
            LAS u32x4* wq = (LAS u32x4*)L;
            LAS float* rsl = (LAS float*)(L + IDX_OFF) + wave * 16;
            LAS float* bql = (LAS float*)(L + IDX_OFF + 1024);
            LAS int* hist = (LAS int*)(L + L_HIST); LAS int* basel = (LAS int*)(L + L_BASE);
            const int nch = NTOK / 16, niter = (nch + NGW - 1) / NGW;
            int bcur = -1;
            if (tid < 32) hist[tid] = 0;
            unsigned* cntg = ctl + CW_CNT + l * 32 * 64;
            for (int itr = 0; itr < niter; ++itr) {
                const int ch = itr * NGW + gw; const bool act = ch < nch;
                const int bwg = ((itr * NGW + vcu * NWAVES) >> 8) & 7;
                if (bwg != bcur) { __syncthreads(); bcur = bwg;
                    const u32x4* src = (const u32x4*)(WQ + (size_t)(l * 8 + bwg) * 32 * 2 * 2 * 64 * 8);
                    for (int i = tid; i < 32 * 2 * 2 * 64; i += NTHR) wq[i] = src[i];
                    if (tid < 32) bql[tid] = BQ[(l * 8 + bwg) * 32 + tid];
                    __syncthreads(); }
                int te[4] = {0, 0, 0, 0}, lr[4] = {0, 0, 0, 0}; float tg[4] = {0.f, 0.f, 0.f, 0.f};
                for (int rep_ = 0; rep_ < NREP(5); ++rep_)
                if (act) {
                    const int b = ch >> 8; const float* mod = modl + (size_t)b * 6144;
                    const int tk = lane & 15, kg = lane >> 4;
                    const float* xr = X1 + (size_t)(ch * 16 + tk) * DM + 8 * kg;
                    f32x4 acc0 = {0.f, 0.f, 0.f, 0.f}, acc1 = acc0; float ssq = 0.f;
#pragma unroll 4
                    for (int sq = 0; sq < 32; ++sq) {
                        const f32x4 xa = *(const f32x4*)(xr + 32 * sq), xb = *(const f32x4*)(xr + 32 * sq + 4);
                        ssq += (xa[0] * xa[0] + xa[1] * xa[1]) + (xa[2] * xa[2] + xa[3] * xa[3]) + (xb[0] * xb[0] + xb[1] * xb[1]) + (xb[2] * xb[2] + xb[3] * xb[3]);
                        u32x4 xh, xl;
                        xh[0] = cvt_pk_bf16(xa[0], xa[1]); xh[1] = cvt_pk_bf16(xa[2], xa[3]); xh[2] = cvt_pk_bf16(xb[0], xb[1]); xh[3] = cvt_pk_bf16(xb[2], xb[3]);
                        xl[0] = cvt_pk_bf16(xa[0] - bf_lo(xh[0]), xa[1] - bf_hi(xh[0])); xl[1] = cvt_pk_bf16(xa[2] - bf_lo(xh[1]), xa[3] - bf_hi(xh[1]));
                        xl[2] = cvt_pk_bf16(xb[0] - bf_lo(xh[2]), xb[1] - bf_hi(xh[2])); xl[3] = cvt_pk_bf16(xb[2] - bf_lo(xh[3]), xb[3] - bf_hi(xh[3]));
                        const bf16x8 bh = __builtin_bit_cast(bf16x8, xh), bl = __builtin_bit_cast(bf16x8, xl);
                        const LAS u32x4* wp = wq + sq * 256 + lane;
                        const bf16x8 w0h = __builtin_bit_cast(bf16x8, wp[0]), w0l = __builtin_bit_cast(bf16x8, wp[64]), w1h = __builtin_bit_cast(bf16x8, wp[128]), w1l = __builtin_bit_cast(bf16x8, wp[192]);
                        acc0 = __builtin_amdgcn_mfma_f32_16x16x32_bf16(w0h, bh, acc0, 0, 0, 0); acc1 = __builtin_amdgcn_mfma_f32_16x16x32_bf16(w1h, bh, acc1, 0, 0, 0);
                        acc0 = __builtin_amdgcn_mfma_f32_16x16x32_bf16(w0l, bh, acc0, 0, 0, 0); acc1 = __builtin_amdgcn_mfma_f32_16x16x32_bf16(w1l, bh, acc1, 0, 0, 0);
                        acc0 = __builtin_amdgcn_mfma_f32_16x16x32_bf16(w0h, bl, acc0, 0, 0, 0); acc1 = __builtin_amdgcn_mfma_f32_16x16x32_bf16(w1h, bl, acc1, 0, 0, 0);
                    }
                    ssq += __shfl_xor(ssq, 16); ssq += __shfl_xor(ssq, 32);
                    const float rstd = __builtin_amdgcn_rsqf(ssq * (1.0f / DM) + NORM_EPS);
                    if (lane < 16) rsl[lane] = rstd;
                    float v0 = -INFINITY, v1 = -INFINITY, v2 = -INFINITY, v3 = -INFINITY; int i0 = 0, i1 = 0, i2 = 0, i3 = 0;
#define TOPK_INS(x_, e_) do { const float xx_ = (x_); const int ee_ = (e_); \
                        if (xx_ > v3 || (xx_ == v3 && ee_ < i3)) { v3 = xx_; i3 = ee_; \
                            if (v3 > v2 || (v3 == v2 && i3 < i2)) { float tf = v2; v2 = v3; v3 = tf; int ti = i2; i2 = i3; i3 = ti; \
                                if (v2 > v1 || (v2 == v1 && i2 < i1)) { tf = v1; v1 = v2; v2 = tf; ti = i1; i1 = i2; i2 = ti; \
                                    if (v1 > v0 || (v1 == v0 && i1 < i0)) { tf = v0; v0 = v1; v1 = tf; ti = i0; i0 = i1; i1 = ti; } } } } } while (0)
#pragma unroll
                    for (int r = 0; r < 4; ++r) { TOPK_INS(acc0[r] * rstd + bql[4 * kg + r], 4 * kg + r); }
#pragma unroll
                    for (int r = 0; r < 4; ++r) { TOPK_INS(acc1[r] * rstd + bql[16 + 4 * kg + r], 16 + 4 * kg + r); }
#pragma unroll
                    for (int st = 16; st <= 32; st <<= 1) {
                        const float p0 = __shfl_xor(v0, st), p1 = __shfl_xor(v1, st), p2 = __shfl_xor(v2, st), p3 = __shfl_xor(v3, st);
                        const int q0 = __shfl_xor(i0, st), q1 = __shfl_xor(i1, st), q2 = __shfl_xor(i2, st), q3 = __shfl_xor(i3, st);
                        TOPK_INS(p0, q0); TOPK_INS(p1, q1); TOPK_INS(p2, q2); TOPK_INS(p3, q3);
                    }
#undef TOPK_INS
                    if (lane < 16) {
                        const float e1 = __expf(v1 - v0), e2 = __expf(v2 - v0), e3 = __expf(v3 - v0); const float rs = 1.0f / (1.0f + e1 + e2 + e3);
                        te[0] = i0; te[1] = i1; te[2] = i2; te[3] = i3; tg[0] = rs; tg[1] = e1 * rs; tg[2] = e2 * rs; tg[3] = e3 * rs;
#pragma unroll
                        for (int k = 0; k < 4; ++k) if (rep_ == NREP(5) - 1) lr[k] = atomicAdd((int*)(lds + L_HIST) + te[k], 1);
                    }
                    f32x4 gm[4], sh[4];
#pragma unroll
                    for (int j = 0; j < 4; ++j) { const int c0 = CB(j); const f32x4 g = *(const f32x4*)(args.norm_ffn + l * DM + c0), sc = *(const f32x4*)(mod + 4 * 1024 + c0); gm[j] = g * (sc + 1.0f); sh[j] = *(const f32x4*)(mod + 3 * 1024 + c0); }
                    asm volatile("s_waitcnt lgkmcnt(0)" ::: "memory");
#pragma unroll 2
                    for (int rr = 0; rr < 16; ++rr) { const int mrow = ch * 16 + rr; const float rs2 = rsl[rr];
#pragma unroll
                        for (int jj = 0; jj < 2; ++jj) { const int c0 = 512 * jj + 8 * lane;
                            const f32x4 va = *(const f32x4*)(X1 + (size_t)mrow * DM + c0) * rs2 * gm[2 * jj] + sh[2 * jj], vc = *(const f32x4*)(X1 + (size_t)mrow * DM + c0 + 4) * rs2 * gm[2 * jj + 1] + sh[2 * jj + 1];
                            u32x2 w; w.x = pack4_fp8(va[0], va[1], va[2], va[3]); w.y = pack4_fp8(vc[0], vc[1], vc[2], vc[3]); *(u32x2*)(XN2 + (size_t)mrow * DM + c0) = w; } }
                }
                __syncthreads();
                if (tid < 32) { const int c = hist[tid]; int base = 0; if (c > 0) base = (int)__hip_atomic_fetch_add(cntg + tid * 64, (unsigned)c, __ATOMIC_RELAXED, __HIP_MEMORY_SCOPE_AGENT); basel[tid] = base; hist[tid] = 0; }
                __syncthreads();
                if (act && lane < 16) { const int mrow = ch * 16 + lane;
#pragma unroll
                    for (int k = 0; k < 4; ++k) { ROWL[(size_t)te[k] * ROWCAP + basel[te[k]] + lr[k]] = mrow * 4 + k; GATES[mrow * 4 + k] = tg[k]; } }
                __syncthreads();
            }
            if (BOTH(pb + 3)) GRID_BAR(); TP_END(25)
        }
        if ((ON(6) && IN(pb + 4)) || (ON(7) && IN(pb + 5))) {
            FRESH_IDS(); WSPTRS();
            LAS int* lcnt = (LAS int*)(L + L_CNT); LAS int* lblk = (LAS int*)(L + L_BLK); LAS int* idx = (LAS int*)(L + IDX_OFF);
            unsigned* cntg = ctl + CW_CNT + l * 32 * 64;
            __syncthreads();
            if (tid < 32) lcnt[tid] = (int)__hip_atomic_load(cntg + tid * 64, __ATOMIC_RELAXED, __HIP_MEMORY_SCOPE_AGENT);
            __syncthreads();
            if (tid == 0) { int s = 0; for (int e = 0; e < 32; ++e) { lblk[e] = s; s += (lcnt[e] + 255) >> 8; } lblk[32] = s; }
            __syncthreads();
            const int nrb = lblk[32];
            if (ON(6) && IN(pb + 4)) { TP_BEGIN(26)
        for (int rep_ = 0; rep_ < NREP(6); ++rep_) {
                const int nU = nrb * 8;
                for (int i = 0; i * G + vcu < nU; ++i) { const int rb = (i * G + vcu) >> 3; const int e = pg8::find_expert(lblk, rb);
                    if (tid < 256) { const int r = (rb - lblk[e]) * 256 + tid; idx[i * 256 + tid] = (r < lcnt[e]) ? (ROWL[(size_t)e * ROWCAP + r] >> 2) : 0; } }
                __syncthreads();
                pg8::SchedMoe1 S{(const char*)XN2, (const char*)(W1T + (size_t)l * NEXP * 2048 * DM), lblk, idx, nU, G, vcu};
                pg8::EpiMoe1 E{HID, args.b1 + (size_t)l * NEXP * 2048, (LAS float*)(L + BIAS_OFF)};
                pg8::gemm_phase<pg8::EpiMoe1, pg8::SchedMoe1, true, true>(L, DM, S, E, tacc);
                } if (BOTH(pb + 4)) GRID_BAR(); TP_END(26)
            }
            if (ON(7) && IN(pb + 5)) { TP_BEGIN(27)
        for (int rep_ = 0; rep_ < NREP(7); ++rep_) {
                const int nU = nrb * 4;
                __syncthreads();
                for (int i = 0; i * G + vcu < nU; ++i) { const int rb = (i * G + vcu) >> 2; const int e = pg8::find_expert(lblk, rb);
                    if (tid < 256) { const int r = (rb - lblk[e]) * 256 + tid; idx[i * 256 + tid] = (r < lcnt[e]) ? ROWL[(size_t)e * ROWCAP + r] : NTOK * TOPK; } }
                __syncthreads();
                pg8::SchedMoe2 S{(const char*)HID, (const char*)(W2T + (size_t)l * NEXP * DM * DM), lblk, nU, G, vcu};
                pg8::EpiMoe2 E{Y, args.b2 + (size_t)l * NEXP * DM, idx, (LAS float*)(L + BIAS_OFF)};
                pg8::gemm_phase<pg8::EpiMoe2, pg8::SchedMoe2, true, true>(L, DM, S, E, tacc);
                } if (BOTH(pb + 5)) GRID_BAR(); TP_END(27)
            }
        }
        if (ON(8) && IN(pb + 6)) { TP_BEGIN(28)
            FRESH_IDS(); WSPTRS();
        for (int rep_ = 0; rep_ < NREP(8); ++rep_) {
            LAS float* wft = (LAS float*)L;
            if (l + 1 < DEPTH) { for (int i = tid; i < 8 * DM; i += NTHR) wft[i] = WFT[(size_t)(l + 1) * 8 * DM + i]; }
            __syncthreads();
            for (int ch = gw; ch < NTOK / 16; ch += NGW) {
                const int b = ch >> 8; const float* mod = modl + (size_t)b * 6144;
                f32x4 g2[4], gm[4], sh[4];
#pragma unroll
                for (int j = 0; j < 4; ++j) { const int c0 = CB(j); g2[j] = *(const f32x4*)(mod + 5 * 1024 + c0);
                    if (l + 1 < DEPTH) { const float* mod2 = MOD + ((size_t)(l + 1) * 8 + b) * 6144; const f32x4 g = *(const f32x4*)(args.norm_mix + (l + 1) * DM + c0), sc = *(const f32x4*)(mod2 + 1024 + c0); gm[j] = g * (sc + 1.0f); sh[j] = *(const f32x4*)(mod2 + c0); }
                    else { gm[j] = *(const f32x4*)(args.final_norm + c0); sh[j] = (f32x4){0.f, 0.f, 0.f, 0.f}; } }
#pragma unroll 4
                for (int rr = 0; rr < 16; ++rr) { const int mrow = ch * 16 + rr;
                    const f32x4 gt = *(const f32x4*)(GATES + (size_t)mrow * 4);
                    f32x4 v[4];
#pragma unroll
                    for (int jj = 0; jj < 2; ++jj) { const int c0 = 512 * jj + 8 * lane;
                        f32x4 a = {0.f, 0.f, 0.f, 0.f}, c = a;
#pragma unroll
                        for (int k = 0; k < 4; ++k) { const u32x4 yw = *(const u32x4*)(Y + ((size_t)mrow * 4 + k) * DM + c0); const float gk = gt[k];
                            a[0] += gk * bf_lo(yw.x); a[1] += gk * bf_hi(yw.x); a[2] += gk * bf_lo(yw.y); a[3] += gk * bf_hi(yw.y);
                            c[0] += gk * bf_lo(yw.z); c[1] += gk * bf_hi(yw.z); c[2] += gk * bf_lo(yw.w); c[3] += gk * bf_hi(yw.w); }
                        v[2 * jj] = *(const f32x4*)(X1 + (size_t)mrow * DM + c0) + g2[2 * jj] * a; v[2 * jj + 1] = *(const f32x4*)(X1 + (size_t)mrow * DM + c0 + 4) + g2[2 * jj + 1] * c; }
                    if (l + 1 < DEPTH) {
#pragma unroll
                        for (int j = 0; j < 4; ++j) *(f32x4*)(X2 + (size_t)mrow * DM + CB(j)) = v[j];
                        norm1_row<true>(v, gm, sh, wft, args.b_forget + (l + 1) * 8, (bf16_t*)((unsigned char*)XN + (size_t)mrow * DM), LF, b, mrow & (SEQ - 1), lane);
                    } else {
                        float ss = 0.f;
#pragma unroll
                        for (int j = 0; j < 4; ++j) ss += (v[j][0] * v[j][0] + v[j][1] * v[j][1]) + (v[j][2] * v[j][2] + v[j][3] * v[j][3]);
                        const float rstd = __builtin_amdgcn_rsqf(wave_sum(ss) * (1.0f / DM) + NORM_EPS);
#pragma unroll
                        for (int j = 0; j < 4; ++j) *(f32x4*)(args.out + (size_t)mrow * DM + CB(j)) = v[j] * rstd * gm[j];
                    }
                }
            }
            __syncthreads();
            } if (BOTH(pb + 6)) GRID_BAR(); TP_END(28)
        }
    }
    TP_END(30)
    if (TPROBE != 0 && blockIdx.x == 0 && threadIdx.x == 0) { const long t0 = (long)__builtin_amdgcn_s_memtime(); while ((long)__builtin_amdgcn_s_memtime() - t0 < tacc * TP_MULT) __builtin_amdgcn_s_sleep(8); }
#undef IN
#undef BOTH
}

extern "C" void kernel_launch(void* const* d_in, const int* in_sizes, int n_in, void* d_out, int out_size, void* d_ws, size_t ws_size, hipStream_t stream) {
    static int grid = 0;
    if (grid == 0) {
        if (n_in != 22 || in_sizes[0] != NTOK * DM || out_size != NTOK * DM || ws_size < WS_END) {
            fprintf(stderr, "kernel_launch: unexpected shapes: n_in %d in0 %d out %d ws %zu (need %zu)\n", n_in, n_in > 0 ? in_sizes[0] : -1, out_size, ws_size, (size_t)WS_END); grid = -1; return; }
        int dev = 0, cus = 0, per_cu = 0;
        if (hipGetDevice(&dev) != hipSuccess || hipDeviceGetAttribute(&cus, hipDeviceAttributeMultiprocessorCount, dev) != hipSuccess) { grid = -1; return; }
        if (hipFuncSetAttribute((const void*)fwd_kernel, hipFuncAttributeMaxDynamicSharedMemorySize, LDS_BYTES) != hipSuccess) { fprintf(stderr, "kernel_launch: hipFuncSetAttribute failed\n"); grid = -1; return; }
        if (hipOccupancyMaxActiveBlocksPerMultiprocessor(&per_cu, (const void*)fwd_kernel, NTHR, LDS_BYTES) != hipSuccess || per_cu < 1)
            fprintf(stderr, "kernel_launch: occupancy query reports %d blocks per CU\n", per_cu);
        (void)hipGetLastError();
        grid = cus;
    }
    if (grid < 0) return;
    (void)hipMemsetAsync((char*)d_ws + WS_CTL, 0, CTL_ZERO_BYTES, stream);
    Args a{};
    a.x = (const float*)d_in[0]; a.c = (const float*)d_in[1]; a.pos = (const int*)d_in[2]; a.ada_w = (const float*)d_in[3]; a.ada_b = (const float*)d_in[4];
    a.norm_mix = (const float*)d_in[5]; a.norm_ffn = (const float*)d_in[6]; a.w_in = (const float*)d_in[7]; a.b_forget = (const float*)d_in[8];
    a.lq1 = (const float*)d_in[9]; a.lk1 = (const float*)d_in[10]; a.lq2 = (const float*)d_in[11]; a.lk2 = (const float*)d_in[12]; a.subln = (const float*)d_in[13];
    a.w_out = (const float*)d_in[14]; a.router_w = (const float*)d_in[15]; a.router_b = (const float*)d_in[16]; a.w1 = (const float*)d_in[17]; a.b1 = (const float*)d_in[18];
    a.w2 = (const float*)d_in[19]; a.b2 = (const float*)d_in[20]; a.final_norm = (const float*)d_in[21];
    a.out = (float*)d_out; a.ws = (unsigned char*)d_ws;
    constexpr int NPH = 2 + 7 * DEPTH;
#if MK_MULTI
    for (int p = 0; p < NPH; ++p) { a.ph_lo = p; a.ph_hi = p + 1; hipLaunchKernelGGL(fwd_kernel, dim3(grid), dim3(NTHR), LDS_BYTES, stream, a); }
#else
    a.ph_lo = 0; a.ph_hi = NPH;
    hipLaunchKernelGGL(fwd_kernel, dim3(grid), dim3(NTHR), LDS_BYTES, stream, a);
#endif
    const hipError_t le = hipPeekAtLastError();
    if (le != hipSuccess) fprintf(stderr, "kernel_launch: launch failed: %s\n", hipGetErrorName(le));
}
```

```cpp
#include <hip/hip_runtime.h>
#include <hip/hip_bf16.h>
#include <cstdio>
#include <cstdint>
#include <cmath>

#ifndef MK_MULTI
#define MK_MULTI 0
#endif

constexpr int BATCH = 8, SEQ = 4096, DM = 1024, NTOK = BATCH * SEQ, DEPTH = 2, NEXP = 32, TOPK = 4;
constexpr int INCOLS = 3080, DFF = 1024;
constexpr int NWAVES = 8, NTHR = 512;
constexpr float NORM_EPS = 1e-6f;
constexpr float LOG2E = 1.4426950408889634f;
constexpr float QSCALE = 0.125f * LOG2E;
constexpr float YSCALE = 4.0f;
constexpr int ROWCAP = NTOK;
constexpr int MAXRB = (NTOK * TOPK) / 256 + NEXP;

constexpr size_t MiB = 1u << 20;
constexpr size_t WS_CTL = 0, CTL_ZERO_BYTES = 2 * MiB;
constexpr size_t WS_MOD = 2 * MiB;
constexpr size_t WS_RWT = 3 * MiB;
constexpr size_t WS_WFT = 3 * MiB + 512 * 1024;
constexpr size_t WS_ROPE = 4 * MiB;
constexpr size_t WS_NCK = 6 * MiB;
constexpr size_t WS_LF = 7 * MiB;
constexpr size_t WS_GATES = 8 * MiB;
constexpr size_t WS_ROWL = 9 * MiB;
constexpr size_t WS_WQ = 13 * MiB;
constexpr size_t WS_BQ = 15 * MiB;
constexpr size_t WS_WIN = 16 * MiB;
constexpr size_t WS_WOUT = 28 * MiB;
constexpr size_t WS_W1 = 32 * MiB;
constexpr size_t WS_W2 = 288 * MiB;
constexpr size_t WS_XN = 416 * MiB;
constexpr size_t WS_QKV = 480 * MiB;
constexpr size_t WS_AO = 672 * MiB;
constexpr size_t WS_X1 = 736 * MiB;
constexpr size_t WS_X2 = 864 * MiB;
constexpr size_t WS_XN2 = 992 * MiB;
constexpr size_t WS_HID = 1056 * MiB;
constexpr size_t WS_Y = 1328 * MiB;
constexpr size_t WS_END = 1585 * MiB;
constexpr int CW_BAR = 4096;
constexpr int CW_KN = 12288;
constexpr int CW_AQ = 24576;
constexpr int CW_CNT = 16384;

constexpr int RING_BYTES = 131072;
constexpr int MISC_OFF = RING_BYTES;
constexpr int L_XBST = MISC_OFF;
constexpr int L_CNT = MISC_OFF + 64;
constexpr int L_BLK = MISC_OFF + 192;
constexpr int L_HIST = MISC_OFF + 384;
constexpr int L_BASE = MISC_OFF + 512;
constexpr int L_SCAN = MISC_OFF + 640;
constexpr int L_QSLOT = MISC_OFF + 672;
constexpr int L_VOTE = MISC_OFF + 704;
constexpr int IDX_OFF = MISC_OFF + 1024;
constexpr int IDX_BYTES = 18432;
constexpr int BIAS_OFF = IDX_OFF + IDX_BYTES;
constexpr int PF_OFF = BIAS_OFF + 8192;
constexpr int LDS_BYTES = PF_OFF + 2048;

#define GAS __attribute__((address_space(1)))
#define LAS __attribute__((address_space(3)))
typedef unsigned short bf16_t;
typedef short bf16x8 __attribute__((ext_vector_type(8)));
typedef short s16x4 __attribute__((ext_vector_type(4)));
typedef float f32x4 __attribute__((ext_vector_type(4)));
typedef float f32x2 __attribute__((ext_vector_type(2)));
typedef float f32x16 __attribute__((ext_vector_type(16)));
typedef unsigned u32x4 __attribute__((ext_vector_type(4)));
typedef unsigned u32x2 __attribute__((ext_vector_type(2)));

__device__ __forceinline__ unsigned cvt_pk_bf16(float lo, float hi) { unsigned r; asm volatile("v_cvt_pk_bf16_f32 %0, %1, %2" : "=v"(r) : "v"(lo), "v"(hi)); return r; }
constexpr int L_WTAB_ABS = 131072 + 768;
__device__ __forceinline__ unsigned hw_slot() { unsigned hw; asm volatile("s_getreg_b32 %0, hwreg(HW_REG_HW_ID, 0, 6)" : "=s"(hw)); return hw; }
__device__ __forceinline__ int fresh_tid() {
    int lane; asm volatile("v_mbcnt_lo_u32_b32 %0, -1, 0\n\tv_mbcnt_hi_u32_b32 %0, -1, %0" : "=v"(lane));
    const int w = *(volatile LAS int*)(size_t)(L_WTAB_ABS + 4 * hw_slot());
    return __builtin_amdgcn_readfirstlane(w) * 64 + lane; }
__device__ __forceinline__ unsigned pack4_fp8(float a, float b, float c, float d) {
    int w = __builtin_amdgcn_cvt_pk_fp8_f32(a, b, 0, false); w = __builtin_amdgcn_cvt_pk_fp8_f32(c, d, w, true); return (unsigned)w; }
__device__ __forceinline__ float bf_lo(unsigned w) { return __uint_as_float(w << 16); }
__device__ __forceinline__ float bf_hi(unsigned w) { return __uint_as_float(w & 0xffff0000u); }
__device__ __forceinline__ float wave_sum(float v) {
#pragma unroll
    for (int o = 1; o < 64; o <<= 1) v += __shfl_xor(v, o);
    return v;
}

#define XB_TMO      128
#define XB_XCNT(j)  (256  + 64 * (j))
#define XB_XSUB(j)  (1280 + 64 * (j))
#define XB_XGEN(j)  (2304 + 64 * (j))
#define XB_TOP      3328
#define XB_TOPGEN   3392
#define XCD_BAR_WORDS 3456
#define XB_SPIN_CAP (1u << 18)
__device__ __forceinline__ unsigned xb_ld(unsigned* p)              { return __hip_atomic_load(p, __ATOMIC_RELAXED, __HIP_MEMORY_SCOPE_AGENT); }
__device__ __forceinline__ unsigned xb_add(unsigned* p, unsigned v) { return __hip_atomic_fetch_add(p, v, __ATOMIC_RELAXED, __HIP_MEMORY_SCOPE_AGENT); }
__device__ __forceinline__ unsigned xb_xcc_id() { return (unsigned)__builtin_amdgcn_s_getreg((3 << 11) | 20) & 0xFu; }
#define XB_SPIN(cond, bar) do { unsigned _sp = 0; while (cond) { __builtin_amdgcn_s_sleep(1); \
    if ((++_sp & 255u) == 0u) { if (xb_ld(&(bar)[XB_TMO])) break; if (_sp > XB_SPIN_CAP) { atomicAdd(&(bar)[XB_TMO], 1u); break; } } } } while (0)
struct XcdBarrier { unsigned* bar; unsigned x; volatile LAS unsigned* st; };
__device__ __forceinline__ XcdBarrier xcd_barrier_post(unsigned* bar, volatile LAS unsigned* st) {
    XcdBarrier b; b.bar = bar; b.x = xb_xcc_id(); b.st = st;
    if (threadIdx.x == 0) (void)xb_add(&bar[XB_XCNT(b.x)], 1u);
    return b;
}
__device__ __forceinline__ void xcd_barrier_complete(unsigned* bar, unsigned x, unsigned& nloc, unsigned& nx) {
    const unsigned G = gridDim.x * gridDim.y * gridDim.z;
    unsigned sum, cnt, mine, sp = 0u;
    for (;;) {
        sum = 0u; cnt = 0u; mine = 0u;
#pragma unroll
        for (unsigned j = 0; j < 16; ++j) { const unsigned c = xb_ld(&bar[XB_XCNT(j)]); sum += c; cnt += (c > 0u) ? 1u : 0u; mine = (j == x) ? c : mine; }
        if (sum == G) break;
        __builtin_amdgcn_s_sleep(1);
        if ((++sp & 255u) == 0u) { if (xb_ld(&bar[XB_TMO])) break; if (sp > XB_SPIN_CAP) { atomicAdd(&bar[XB_TMO], 1u); break; } }
    }
    nloc = mine > 0u ? mine : 1u; nx = cnt > 0u ? cnt : 1u;
}
__device__ __forceinline__ void xcd_barrier(const XcdBarrier& b) {
    asm volatile("s_waitcnt vmcnt(0)" ::: "memory");
    __syncthreads();
    if (threadIdx.x == 0) {
        unsigned* bar = b.bar;
        __builtin_amdgcn_s_waitcnt(0);
        unsigned nloc = b.st[0], nx = b.st[1];
        if (nloc == 0u) { xcd_barrier_complete(bar, b.x, nloc, nx); b.st[0] = nloc; b.st[1] = nx; }
        const unsigned old = xb_add(&bar[XB_XSUB(b.x)], 1u);
        const unsigned gen = old / nloc;
        if (old + 1u == (gen + 1u) * nloc) {
            __builtin_amdgcn_fence(__ATOMIC_RELEASE, "agent");
            asm volatile("s_waitcnt vmcnt(0)" ::: "memory");
            const unsigned og = xb_add(&bar[XB_TOP], 1u);
            const unsigned tg = og / nx;
            if (og + 1u == (tg + 1u) * nx) xb_add(&bar[XB_TOPGEN], 1u);
            else XB_SPIN(xb_ld(&bar[XB_TOPGEN]) == tg, bar);
            __builtin_amdgcn_fence(__ATOMIC_ACQUIRE, "agent");
            xb_add(&bar[XB_XGEN(b.x)], 1u);
            asm volatile("s_waitcnt vmcnt(0)" ::: "memory");
        } else {
            XB_SPIN(xb_ld(&bar[XB_XGEN(b.x)]) == gen, bar);
            __builtin_amdgcn_fence(__ATOMIC_ACQUIRE, "agent");
            asm volatile("s_waitcnt vmcnt(0)" ::: "memory");
        }
    }
    __syncthreads();
}

#define GAS __attribute__((address_space(1)))
#ifndef TPROBE
#define TPROBE 0
#endif
#define TP_MULT 4
#define TP_BEGIN(id) long tp_t0_##id = 0; if (TPROBE == (id)) { tp_t0_##id = (long)__builtin_amdgcn_s_memtime(); }
#define TP_END(id) if (TPROBE == (id)) { tacc += (long)__builtin_amdgcn_s_memtime() - tp_t0_##id; }
namespace pg8 {
constexpr int BM = 256, BK = 64, HALF = 128, HTB = HALF * BK * 2, STAGE_BYTES = 8 * HTB;
__host__ __device__ __forceinline__ int lds_byte(int r, int c) { const int st = (r >> 4) * 2 + (c >> 5), rr = r & 15, cc = c & 31, ob = rr * 64 + cc * 2; return st * 1024 + (ob ^ (((ob >> 9) & 1) << 5)); }
__host__ __device__ __forceinline__ void stage_rc(int b, int& R, int& C) { const int st = b / 1024, sb = b % 1024, swz = sb ^ (((sb >> 9) & 1) << 5); R = (st >> 1) * 16 + swz / 64; C = (st & 1) * 32 + (swz % 64) / 2; }
__host__ __device__ __forceinline__ int perm32(int rho) { const int n = rho >> 4, i = rho & 15; return 8 * (i >> 2) + 4 * n + (i & 3); }

typedef int i32x8 __attribute__((ext_vector_type(8)));
typedef int i32x4 __attribute__((ext_vector_type(4)));
__device__ __forceinline__ i32x8 cat8(bf16x8 lo, bf16x8 hi) { const i32x4 a = __builtin_bit_cast(i32x4, lo), b = __builtin_bit_cast(i32x4, hi); return (i32x8){a[0], a[1], a[2], a[3], b[0], b[1], b[2], b[3]}; }
struct Unit { int pm, pn, e; };

template <class Epi, class Sched, bool ALIGN_EPI, bool F8 = false>
__device__ __forceinline__ void gemm_phase(LAS unsigned char* lds, const int K, const Sched& S, const Epi& E, long& tacc) {
    const int tid = fresh_tid(), wid = __builtin_amdgcn_readfirstlane(tid >> 6), lane = tid & 63, wr = wid >> 2, wc = wid & 3, fr = lane & 15, fq = lane >> 4;
    const int nt = F8 ? K / (2 * BK) : K / BK;
    const int rowb = F8 ? K : 2 * K;
    int Rp[2]; unsigned voffA[2], voffB[2];
#pragma unroll
    for (int i = 0; i < 2; ++i) { int R, C; stage_rc(tid * 16 + i * 8192, R, C); Rp[i] = R; const int Rb = Epi::PERM == 2 ? ((R >> 5) * 64 + perm32(R & 31)) : Epi::PERM ? ((R & ~31) + perm32(R & 31)) : R;
        voffA[i] = Sched::GATHER ? (unsigned)C * 2u : (unsigned)(R * rowb + C * 2); voffB[i] = (unsigned)(Rb * rowb + C * 2); }
    const size_t kstep = (size_t)(BK * 2);
    const size_t hstep = (size_t)HALF * rowb;
    const size_t hstepB = Epi::PERM == 2 ? (size_t)32 * rowb : hstep;
    const unsigned ldsw = (unsigned)wid * 1024u;
    const int aoff = lds_byte(wr * 64 + fr, fq * 8), boff = lds_byte(wc * 32 + fr, fq * 8);
#define PG8_SA(b, h) (((b) * 2 + (h)) * HTB)
#define PG8_SB(b, h) ((4 + (b) * 2 + (h)) * HTB)
#define PG8_STAGE(bufoff, gbase, v0, v1) do { \
        __builtin_amdgcn_global_load_lds((const unsigned*)((const char*)(gbase) + (v0)), (LAS unsigned*)(lds + (bufoff) + ldsw), 16, 0, 0); \
        __builtin_amdgcn_global_load_lds((const unsigned*)((const char*)(gbase) + (v1)), (LAS unsigned*)(lds + (bufoff) + ldsw + 8192), 16, 0, 0); } while (0)
#define PG8_STAGE_A(bufoff, gbase, h) do { if constexpr (Sched::GATHER) { PG8_STAGE(bufoff, gbase, (unsigned)tok[h][0] * (unsigned)rowb + voffA[0], (unsigned)tok[h][1] * (unsigned)rowb + voffA[1]); } \
        else { PG8_STAGE(bufoff, (gbase) + (h) * hstep, voffA[0], voffA[1]); } } while (0)
#define PG8_LDA_(dst, b, h) do { if constexpr (F8) { _Pragma("unroll") for (int m = 0; m < 4; ++m) { const i32x4 lo_ = *(const LAS i32x4*)(lds + PG8_SA(b, h) + aoff + m * 2048), hi_ = *(const LAS i32x4*)(lds + PG8_SA(b, h) + aoff + m * 2048 + 1024); \
            dst##8[m] = __builtin_shufflevector(lo_, hi_, 0, 1, 2, 3, 4, 5, 6, 7); } } \
        else { _Pragma("unroll") for (int m = 0; m < 4; ++m) _Pragma("unroll") for (int k = 0; k < 2; ++k) dst[m][k] = *(const LAS bf16x8*)(lds + PG8_SA(b, h) + aoff + m * 2048 + k * 1024); } } while (0)
#define PG8_LDB_(dst, b, h) do { if constexpr (F8) { _Pragma("unroll") for (int n = 0; n < 2; ++n) { const i32x4 lo_ = *(const LAS i32x4*)(lds + PG8_SB(b, h) + boff + n * 2048), hi_ = *(const LAS i32x4*)(lds + PG8_SB(b, h) + boff + n * 2048 + 1024); \
            dst##8[n] = __builtin_shufflevector(lo_, hi_, 0, 1, 2, 3, 4, 5, 6, 7); } } \
        else { _Pragma("unroll") for (int n = 0; n < 2; ++n) _Pragma("unroll") for (int k = 0; k < 2; ++k) dst[n][k] = *(const LAS bf16x8*)(lds + PG8_SB(b, h) + boff + n * 2048 + k * 1024); } } while (0)
#define PG8_LDA(dst, b, h) PG8_LDA_(dst, b, h)
#define PG8_LDB(dst, b, h) PG8_LDB_(dst, b, h)
#define PG8_MMA(ai, bj, At, Bt) do { __builtin_amdgcn_s_setprio(1); \
        if constexpr (F8) { _Pragma("unroll") for (int m = 0; m < 4; ++m) _Pragma("unroll") for (int n = 0; n < 2; ++n) \
            acc[ai][bj][m][n] = __builtin_amdgcn_mfma_scale_f32_16x16x128_f8f6f4(Bt##8[n], At##8[m], acc[ai][bj][m][n], 0, 0, 0, 0x7f7f7f7f, 0, 0x7f7f7f7f); } \
        else { _Pragma("unroll") for (int m = 0; m < 4; ++m) _Pragma("unroll") for (int n = 0; n < 2; ++n) _Pragma("unroll") for (int k = 0; k < 2; ++k) \
            acc[ai][bj][m][n] = __builtin_amdgcn_mfma_f32_16x16x32_bf16(Bt[n][k], At[m][k], acc[ai][bj][m][n], 0, 0, 0); } \
        __builtin_amdgcn_s_setprio(0); } while (0)
#define PG8_WAIT_V(n) asm volatile("s_waitcnt vmcnt(" #n ")" ::: "memory")
#define PG8_WAIT_V8X(nrm) asm volatile("v_cmp_ne_u32_e32 vcc, 0, %0\n\ts_cbranch_vccnz 1f\n\ts_waitcnt vmcnt(%1)\n\ts_branch 2f\n1:\n\ts_waitcnt vmcnt(8)\n2:" :: "v"(nrm), "n"(8 + Epi::NST + (Epi::PRE == 1 ? 1 : 0) + Sched::NPF) : "memory", "vcc")
#define PG8_WAIT_L(n) asm volatile("s_waitcnt lgkmcnt(" #n ")" ::: "memory")
#define PG8_BAR __builtin_amdgcn_s_barrier()
#define PG8_SCHED __builtin_amdgcn_sched_barrier(0)
    Unit cur, nxt; int ui = 0;
    if (!S.next(0, cur)) return;
    f32x4 acc[2][2][4][2];
#pragma unroll
    for (int a = 0; a < 2; ++a)
#pragma unroll
        for (int b = 0; b < 2; ++b)
#pragma unroll
            for (int m = 0; m < 4; ++m)
#pragma unroll
                for (int n = 0; n < 2; ++n) acc[a][b][m][n] = (f32x4){0.f, 0.f, 0.f, 0.f};
    bf16x8 At[4][2], B0[2][2], B1[2][2]; i32x8 At8[4], B08[2], B18[2];
    int tok[2][2] = {{0, 0}, {0, 0}};
    if constexpr (Sched::GATHER) S.load_tok(cur, 0, Rp, tok);
    const char* cA = S.a_ptr(cur); const char* cB = S.b_ptr(cur);
    PG8_STAGE(PG8_SB(0, 0), cB, voffB[0], voffB[1]); PG8_STAGE(PG8_SB(0, 1), cB + hstepB, voffB[0], voffB[1]); PG8_STAGE_A(PG8_SA(0, 0), cA, 0); PG8_STAGE_A(PG8_SA(0, 1), cA, 1);
    if (wr == 1) PG8_BAR;
    PG8_WAIT_V(2); PG8_BAR;
    PG8_STAGE(PG8_SB(1, 0), cB + kstep, voffB[0], voffB[1]); PG8_STAGE_A(PG8_SA(1, 0), cA + kstep, 0); PG8_STAGE(PG8_SB(1, 1), cB + hstepB + kstep, voffB[0], voffB[1]);
    PG8_WAIT_V(6); PG8_BAR;
    for (;;) {
        if constexpr (Epi::PRE == 1) E.pre(cur, wid, lane);
        const bool has_next = S.next(ui + 1, nxt);
        const char* nA = has_next ? S.a_ptr(nxt) : cA; const char* nB = has_next ? S.b_ptr(nxt) : cB;
        TP_BEGIN(40) long tpk_ = 0; if (TPROBE == Epi::TPK) tpk_ = (long)__builtin_amdgcn_s_memtime();
#pragma unroll 1
        for (int t = 0; t < nt; t += 2) {
            const bool last = (t == nt - 2); const int nrm = (t != 0 || ui == 0) ? 1 : 0;
            const char* a1 = cA + (size_t)(t + 1) * kstep;
            const char* a2 = last ? nA : cA + (size_t)(t + 2) * kstep; const char* b2 = last ? nB : cB + (size_t)(t + 2) * kstep;
            const char* a3 = a2 + kstep; const char* b3 = b2 + kstep;
            PG8_LDB(B0, 0, 0); PG8_LDB(B1, 0, 1); PG8_SCHED; PG8_LDA(At, 0, 0); PG8_STAGE_A(PG8_SA(1, 1), a1, 1);
            if constexpr (Sched::GATHER) { if (last && has_next) S.load_tok(nxt, ui + 1, Rp, tok); }
            PG8_WAIT_V8X(nrm); PG8_WAIT_L(0); PG8_BAR;
            if constexpr (Epi::PRE == 2) { if (t == 0) E.pre(cur, wid, lane); }
            PG8_MMA(0, 0, At, B0); PG8_MMA(0, 1, At, B1); PG8_BAR; PG8_SCHED;
            PG8_LDA(At, 0, 1); PG8_STAGE(PG8_SB(0, 0), b2, voffB[0], voffB[1]); PG8_STAGE(PG8_SB(0, 1), b2 + hstepB, voffB[0], voffB[1]); PG8_STAGE_A(PG8_SA(0, 0), a2, 0);
            PG8_WAIT_V8X(nrm); PG8_WAIT_L(0); PG8_BAR; PG8_MMA(1, 0, At, B0); PG8_MMA(1, 1, At, B1); PG8_BAR; PG8_SCHED;
            PG8_LDB(B0, 1, 0); PG8_LDB(B1, 1, 1); PG8_SCHED; PG8_LDA(At, 1, 0); PG8_STAGE_A(PG8_SA(0, 1), a2, 1);
            PG8_WAIT_V(8); PG8_WAIT_L(0); PG8_BAR; PG8_MMA(0, 0, At, B0); PG8_MMA(0, 1, At, B1); PG8_BAR; PG8_SCHED;
            PG8_LDA(At, 1, 1); PG8_STAGE(PG8_SB(1, 0), b3, voffB[0], voffB[1]); PG8_STAGE(PG8_SB(1, 1), b3 + hstepB, voffB[0], voffB[1]); PG8_STAGE_A(PG8_SA(1, 0), a3, 0);
            PG8_WAIT_V(8); PG8_WAIT_L(0); PG8_BAR; PG8_MMA(1, 0, At, B0); PG8_MMA(1, 1, At, B1); PG8_BAR; PG8_SCHED;
        }
        TP_END(40) if (TPROBE == Epi::TPK) tacc += (long)__builtin_amdgcn_s_memtime() - tpk_;
        if constexpr (Sched::NPF > 0) { if (has_next) S.prefetch(nxt, (LAS unsigned*)(lds + PF_OFF + wid * 256)); }
        TP_BEGIN(41) long tpe_ = 0; if (TPROBE == Epi::TPE) tpe_ = (long)__builtin_amdgcn_s_memtime();
        if constexpr (ALIGN_EPI) { if (wr == 0) PG8_BAR; }
        { int fr_ = fr, fq_ = fq; asm volatile("" : "+v"(fr_), "+v"(fq_));
          E(acc, cur, ui, wr, wc, fr_, fq_); }
        TP_END(41) if (TPROBE == Epi::TPE) tacc += (long)__builtin_amdgcn_s_memtime() - tpe_;
        if (!has_next) break;
#pragma unroll
        for (int a = 0; a < 2; ++a)
#pragma unroll
            for (int b = 0; b < 2; ++b)
#pragma unroll
                for (int m = 0; m < 4; ++m)
#pragma unroll
                    for (int n = 0; n < 2; ++n) acc[a][b][m][n] = (f32x4){0.f, 0.f, 0.f, 0.f};
        cur = nxt; cA = nA; cB = nB; ++ui;
        if constexpr (ALIGN_EPI) { if (wr == 1) PG8_BAR; }
    }
    PG8_WAIT_V(0);
    if constexpr (!ALIGN_EPI) { if (wr == 0) PG8_BAR; }
    PG8_BAR;
#undef PG8_SA
#undef PG8_SB
#undef PG8_STAGE
#undef PG8_STAGE_A
#undef PG8_LDA
#undef PG8_LDB
#undef PG8_LDA_
#undef PG8_LDB_
#undef PG8_MMA
#undef PG8_WAIT_V
#undef PG8_WAIT_V8X
#undef PG8_WAIT_L
#undef PG8_BAR
#undef PG8_SCHED
}

struct SchedDense {
    const char* A; const char* B; int nN, nUnits, G, vcu, K;
    __device__ __forceinline__ bool next(int i, Unit& u) const { const int L = i * G + vcu; if (L >= nUnits) return false;
        if ((nN & 3) == 0) { const int st = L >> 5, j = L & 31, ng = nN >> 2, rbg = st / ng, png = st - rbg * ng; u.pm = rbg * 8 + (j >> 2); u.pn = png * 4 + (j & 3); }
        else { u.pm = L / nN; u.pn = L - u.pm * nN; }
        u.e = 0; return true; }
    __device__ __forceinline__ const char* a_ptr(const Unit& u) const { return A + (size_t)u.pm * BM * K * 2; }
    __device__ __forceinline__ const char* b_ptr(const Unit& u) const { return B + (size_t)u.pn * BM * K * 2; }
    static constexpr bool GATHER = false; static constexpr int NPF = 0;
    __device__ __forceinline__ void load_tok(const Unit&, int, const int (&)[2], int (&)[2][2]) const {}
};
struct SchedDenseG {
    const char* A; const char* B; int nN, nUnits, G, vcu, K;
    __device__ __forceinline__ bool next(int i, Unit& u) const { const int L = i * G + vcu; if (L >= nUnits) return false;
        if ((nN & 3) == 0) { const int st = L >> 5, j = L & 31, ng = nN >> 2, rbg = st / ng, png = st - rbg * ng; u.pm = rbg * 8 + (j >> 2); u.pn = png * 4 + (j & 3); }
        else { u.pm = L / nN; u.pn = L - u.pm * nN; }
        u.e = 0; return true; }
    __device__ __forceinline__ const char* a_ptr(const Unit&) const { return A; }
    __device__ __forceinline__ const char* b_ptr(const Unit& u) const { return B + (size_t)u.pn * BM * K; }
    static constexpr bool GATHER = true; static constexpr int NPF = 0;
    __device__ __forceinline__ void load_tok(const Unit& u, int, const int (&Rp)[2], int (&tok)[2][2]) const {
#pragma unroll
        for (int h = 0; h < 2; ++h)
#pragma unroll
            for (int i = 0; i < 2; ++i) tok[h][i] = u.pm * BM + h * HALF + Rp[i];
    }
};
__device__ __forceinline__ int find_expert(const LAS int* blk, int rb) { int e = 0;
#pragma unroll
    for (int j = 1; j < NEXP; ++j) e += (rb >= blk[j]) ? 1 : 0;
    return e; }
struct SchedMoe1 {
    const char* A; const char* W; const LAS int* blk; const LAS int* idx; int nUnits, G, vcu;
    __device__ __forceinline__ bool next(int i, Unit& u) const { const int L = i * G + vcu; if (L >= nUnits) return false; u.pm = L >> 3; u.pn = L & 7; u.e = find_expert(blk, u.pm); return true; }
    __device__ __forceinline__ const char* a_ptr(const Unit&) const { return A; }
    __device__ __forceinline__ const char* b_ptr(const Unit& u) const { return W + ((size_t)u.e * 2048 + (size_t)u.pn * 256) * DM; }
    static constexpr bool GATHER = true; static constexpr int NPF = 0;
    __device__ __forceinline__ void load_tok(const Unit&, int ui, const int (&Rp)[2], int (&tok)[2][2]) const {
#pragma unroll
        for (int h = 0; h < 2; ++h)
#pragma unroll
            for (int i = 0; i < 2; ++i) tok[h][i] = idx[ui * 256 + h * HALF + Rp[i]];
    }
};
struct SchedMoe2 {
    const char* A; const char* W; const LAS int* blk; int nUnits, G, vcu;
    __device__ __forceinline__ bool next(int i, Unit& u) const { const int L = i * G + vcu; if (L >= nUnits) return false; u.pm = L >> 2; u.pn = L & 3; u.e = find_expert(blk, u.pm); return true; }
    __device__ __forceinline__ const char* a_ptr(const Unit&) const { return A; }
    __device__ __forceinline__ const char* b_ptr(const Unit& u) const { return W + ((size_t)u.e * 1024 + (size_t)u.pn * 256) * DM; }
    static constexpr bool GATHER = true; static constexpr int NPF = 1;
    __device__ __forceinline__ void prefetch(const Unit& n, LAS unsigned* pad) const {
        int t_ = fresh_tid();
        const unsigned off = ((unsigned)(n.pm * BM + n.pn * 64) + ((unsigned)t_ >> 3)) * (unsigned)DM + ((unsigned)t_ & 7u) * 128u;
        __builtin_amdgcn_global_load_lds((const unsigned*)(A + off), pad, 4, 0, 0); }
    __device__ __forceinline__ void load_tok(const Unit& u, int, const int (&Rp)[2], int (&tok)[2][2]) const {
#pragma unroll
        for (int h = 0; h < 2; ++h)
#pragma unroll
            for (int i = 0; i < 2; ++i) tok[h][i] = u.pm * BM + h * HALF + Rp[i];
    }
};

struct EpiInProj {
    static constexpr int PERM = 1, PRE = 2; static constexpr int NST = 16; static constexpr int TPK = 46, TPE = 47;
    bf16_t* QKV; const float* rope; unsigned* kn; float ws; LAS float* ropel;
    __device__ __forceinline__ void pre(const Unit& u, int wid, int lane) const {
#pragma unroll
        for (int j = 0; j < 2; ++j) __builtin_amdgcn_global_load_lds((const unsigned*)(rope + ((size_t)u.pm * BM + 32 * wid + 16 * j) * 16 + 4 * lane), (LAS unsigned*)(ropel + (32 * wid + 16 * j) * 16), 16, 0, 0);
    }
    __device__ __forceinline__ void operator()(const f32x4 (&acc)[2][2][4][2], const Unit& u, int, int wr, int wc, int fr, int fq) const {
        const int t = u.pn >> 1; bf16_t* base = QKV + (size_t)t * NTOK * 512;
        const float sc = (t == 0 || t == 3) ? QSCALE : 1.0f;
        const bool dorope = (t < 2) && ((wc & 1) == 0);
        const int col0 = (u.pn & 1) * 256 + wc * 32 + 8 * fq;
        const float sgn = (fq == 0) ? -1.0f : 1.0f; const bool rl = fq < 2;
        float kmx0 = 0.f, kmx1 = 0.f;
#pragma unroll
        for (int ai = 0; ai < 2; ++ai)
#pragma unroll
            for (int m = 0; m < 4; ++m) {
                const int row = u.pm * BM + ai * HALF + wr * 64 + m * 16 + fr;
                f32x4 cs0 = {1.f, 1.f, 1.f, 1.f}, cs1 = cs0, sn0 = {0.f, 0.f, 0.f, 0.f}, sn1 = sn0;
                if (dorope) { const LAS f32x4* rp = (const LAS f32x4*)(ropel + (ai * HALF + wr * 64 + m * 16 + fr) * 16); cs0 = rp[0]; cs1 = rp[1]; sn0 = rp[2]; sn1 = rp[3]; }
#pragma unroll
                for (int bj = 0; bj < 2; ++bj) {
                    f32x4 v0 = acc[ai][bj][m][0] * ws, v1 = acc[ai][bj][m][1] * ws;
                    if (dorope) {
#pragma unroll
                        for (int i = 0; i < 4; ++i) { const float p0 = __shfl_xor(v0[i], 16), p1 = __shfl_xor(v1[i], 16);
                            const float r0 = v0[i] * cs0[i] + sgn * p0 * sn0[i], r1 = v1[i] * cs1[i] + sgn * p1 * sn1[i];
                            v0[i] = rl ? r0 : v0[i]; v1[i] = rl ? r1 : v1[i]; }
                    }
                    v0 = v0 * sc; v1 = v1 * sc;
                    if (t == 4) { float ss = (v0[0] * v0[0] + v0[1] * v0[1]) + (v0[2] * v0[2] + v0[3] * v0[3]) + (v1[0] * v1[0] + v1[1] * v1[1]) + (v1[2] * v1[2] + v1[3] * v1[3]);
                        ss += __shfl_xor(ss, 16); ss += __shfl_xor(ss, 32); if (bj == 0) kmx0 = fmaxf(kmx0, ss); else kmx1 = fmaxf(kmx1, ss); }
                    u32x4 w; w.x = cvt_pk_bf16(v0[0], v0[1]); w.y = cvt_pk_bf16(v0[2], v0[3]); w.z = cvt_pk_bf16(v1[0], v1[1]); w.w = cvt_pk_bf16(v1[2], v1[3]);
                    *(u32x4*)(base + (size_t)row * 512 + col0 + bj * HALF) = w;
                }
            }
        if (t == 4) {
#pragma unroll
            for (int bj = 0; bj < 2; ++bj) { float v = (bj == 0) ? kmx0 : kmx1;
#pragma unroll
                for (int o = 1; o < 16; o <<= 1) v = fmaxf(v, __shfl_xor(v, o));
                unsigned* const kp = kn + (((u.pm >> 4) * 8 + (u.pn & 1) * 4 + bj * 2 + (wc >> 1)) * 2 + (wc & 1));
                if (fr == 0 && fq == 0) __hip_atomic_fetch_max(kp, __float_as_uint(v), __ATOMIC_RELAXED, __HIP_MEMORY_SCOPE_AGENT); }
        }
    }
};
template <bool XBF>
struct EpiOutProj {
    static constexpr int PERM = 1, PRE = 0; static constexpr int NST = 16; static constexpr int TPK = 48, TPE = 49;
    const void* xin; bf16_t* xout; const float* g1; float ws;
    __device__ __forceinline__ void operator()(const f32x4 (&acc)[2][2][4][2], const Unit& u, int, int wr, int wc, int fr, int fq) const {
        const int b = u.pm >> 4; const int col0 = u.pn * BM + wc * 32 + 8 * fq;
        f32x4 gv[2][2];
#pragma unroll
        for (int bj = 0; bj < 2; ++bj)
#pragma unroll
            for (int n = 0; n < 2; ++n) gv[bj][n] = *(const f32x4*)(g1 + (size_t)b * 6144 + col0 + bj * HALF + n * 4) * ws;
        const size_t off0 = (size_t)(u.pm * BM + wr * 64 + fr) * DM + col0;
        if constexpr (XBF) {
            u32x4 xw[2][4][2];
#pragma unroll
            for (int ai = 0; ai < 2; ++ai)
#pragma unroll
                for (int m = 0; m < 4; ++m)
#pragma unroll
                    for (int bj = 0; bj < 2; ++bj) xw[ai][m][bj] = *(const u32x4*)((const bf16_t*)xin + off0 + (size_t)(ai * HALF + m * 16) * DM + bj * HALF);
#pragma unroll
            for (int ai = 0; ai < 2; ++ai)
#pragma unroll
                for (int m = 0; m < 4; ++m) asm volatile("" : "+v"(xw[ai][m][0]), "+v"(xw[ai][m][1]));
#pragma unroll
            for (int ai = 0; ai < 2; ++ai)
#pragma unroll
                for (int m = 0; m < 4; ++m)
#pragma unroll
                    for (int bj = 0; bj < 2; ++bj) { const u32x4 t = xw[ai][m][bj];
                        const f32x4 v0 = (f32x4){bf_lo(t.x), bf_hi(t.x), bf_lo(t.y), bf_hi(t.y)} + gv[bj][0] * acc[ai][bj][m][0], v1 = (f32x4){bf_lo(t.z), bf_hi(t.z), bf_lo(t.w), bf_hi(t.w)} + gv[bj][1] * acc[ai][bj][m][1];
                        u32x4 w; w.x = cvt_pk_bf16(v0[0], v0[1]); w.y = cvt_pk_bf16(v0[2], v0[3]); w.z = cvt_pk_bf16(v1[0], v1[1]); w.w = cvt_pk_bf16(v1[2], v1[3]);
                        *(u32x4*)(xout + off0 + (size_t)(ai * HALF + m * 16) * DM + bj * HALF) = w; }
        } else {
#pragma unroll
            for (int ai = 0; ai < 2; ++ai) {
                f32x4 xf[4][2][2];
#pragma unroll
                for (int m = 0; m < 4; ++m)
#pragma unroll
                    for (int bj = 0; bj < 2; ++bj)
#pragma unroll
                        for (int n = 0; n < 2; ++n) xf[m][bj][n] = *(const f32x4*)((const float*)xin + off0 + (size_t)(ai * HALF + m * 16) * DM + bj * HALF + 4 * n);
#pragma unroll
                for (int m = 0; m < 4; ++m) asm volatile("" : "+v"(xf[m][0][0]), "+v"(xf[m][0][1]), "+v"(xf[m][1][0]), "+v"(xf[m][1][1]));
#pragma unroll
                for (int m = 0; m < 4; ++m)
#pragma unroll
                    for (int bj = 0; bj < 2; ++bj) { const f32x4 v0 = xf[m][bj][0] + gv[bj][0] * acc[ai][bj][m][0], v1 = xf[m][bj][1] + gv[bj][1] * acc[ai][bj][m][1];
                        u32x4 w; w.x = cvt_pk_bf16(v0[0], v0[1]); w.y = cvt_pk_bf16(v0[2], v0[3]); w.z = cvt_pk_bf16(v1[0], v1[1]); w.w = cvt_pk_bf16(v1[2], v1[3]);
                        *(u32x4*)(xout + off0 + (size_t)(ai * HALF + m * 16) * DM + bj * HALF) = w; }
            }
        }
    }
};
struct EpiMoe1 {
    static constexpr int PERM = 1, PRE = 1; static constexpr int NST = 8; static constexpr int TPK = 44, TPE = 45;
    unsigned char* HID; const float* b1; LAS float* biasl;
    __device__ __forceinline__ void pre(const Unit& u, int wid, int lane) const {
        const float* g = b1 + (size_t)u.e * 2048 + u.pn * HALF + ((lane < 32) ? 4 * lane : 1024 + 4 * (lane - 32));
        __builtin_amdgcn_global_load_lds((const unsigned*)g, (LAS unsigned*)(biasl + wid * 256), 16, 0, 0);
    }
    __device__ __forceinline__ void operator()(const f32x4 (&acc)[2][2][4][2], const Unit& u, int, int wr, int wc, int fr, int fq) const {
        const int wid = wr * 4 + wc; const int hl = wc * 32 + 8 * fq; const int hc = u.pn * HALF + hl; const LAS float* bb = biasl + wid * 256 + hl;
        const f32x4 bg0 = *(const LAS f32x4*)(bb), bg1 = *(const LAS f32x4*)(bb + 4), bu0 = *(const LAS f32x4*)(bb + 128), bu1 = *(const LAS f32x4*)(bb + 132);
#pragma unroll
        for (int ai = 0; ai < 2; ++ai)
#pragma unroll
            for (int m = 0; m < 4; ++m) {
                const size_t row = (size_t)u.pm * BM + ai * HALF + wr * 64 + m * 16 + fr;
                float o[8];
#pragma unroll
                for (int n = 0; n < 2; ++n) { const f32x4 ag = acc[ai][0][m][n], au = acc[ai][1][m][n], bgv = n ? bg1 : bg0, buv = n ? bu1 : bu0;
#pragma unroll
                    for (int h = 0; h < 2; ++h) {
                        const f32x2 g = (f32x2){ag[2 * h], ag[2 * h + 1]} * 0.03125f + (f32x2){bgv[2 * h], bgv[2 * h + 1]}, up = (f32x2){au[2 * h], au[2 * h + 1]} * 0.03125f + (f32x2){buv[2 * h], buv[2 * h + 1]};
                        const f32x2 gt = {fminf(g[0], 7.0f), fminf(g[1], 7.0f)}, uu = {__builtin_amdgcn_fmed3f(up[0], -7.0f, 7.0f), __builtin_amdgcn_fmed3f(up[1], -7.0f, 7.0f)};
                        const f32x2 x = gt * (-1.702f * LOG2E);
                        const f32x2 d = (f32x2){__builtin_amdgcn_exp2f(x[0]), __builtin_amdgcn_exp2f(x[1])} + 1.0f;
                        const f32x2 sg = {__builtin_amdgcn_rcpf(d[0]), __builtin_amdgcn_rcpf(d[1])};
                        const f32x2 r = (uu * gt + gt) * sg;
                        o[n * 4 + 2 * h] = r[0]; o[n * 4 + 2 * h + 1] = r[1]; } }
                u32x2 w; w.x = pack4_fp8(o[0], o[1], o[2], o[3]); w.y = pack4_fp8(o[4], o[5], o[6], o[7]);
                *(u32x2*)(HID + row * DM + hc) = w;
            }
    }
};
struct EpiMoe2 {
    static constexpr int PERM = 2, PRE = 1; static constexpr int NST = 8; static constexpr int TPK = 42, TPE = 43;
    unsigned char* Y; const float* b2; const LAS int* aidx; LAS float* biasl;
    __device__ __forceinline__ void pre(const Unit& u, int wid, int lane) const {
        __builtin_amdgcn_global_load_lds((const unsigned*)(b2 + (size_t)u.e * 1024 + u.pn * BM + 4 * lane), (LAS unsigned*)(biasl + wid * 256), 16, 0, 0);
    }
    __device__ __forceinline__ void operator()(const f32x4 (&acc)[2][2][4][2], const Unit& u, int ui, int wr, int wc, int fr, int fq) const {
        const int wid = wr * 4 + wc; LAS float* slot = biasl + wid * 256; const LAS float* bb = slot + wc * 64 + 8 * fq;
        f32x4 bv[2][2];
#pragma unroll
        for (int bj = 0; bj < 2; ++bj)
#pragma unroll
            for (int n = 0; n < 2; ++n) bv[bj][n] = *(const LAS f32x4*)(bb + bj * 32 + 4 * n) * YSCALE;
        LAS unsigned char* stg = (LAS unsigned char*)slot; const int lane = fq * 16 + fr, rl = lane >> 2, ch = lane & 3;
        unsigned char* const yb = Y + u.pn * BM + wc * 64 + ch * 16;
#pragma unroll
        for (int ai = 0; ai < 2; ++ai)
#pragma unroll
            for (int m = 0; m < 4; ++m) {
                const int aid = aidx[ui * 256 + ai * HALF + wr * 64 + m * 16 + rl];
#pragma unroll
                for (int bj = 0; bj < 2; ++bj) { const f32x4 v0 = acc[ai][bj][m][0] * (0.03125f * YSCALE) + bv[bj][0], v1 = acc[ai][bj][m][1] * (0.03125f * YSCALE) + bv[bj][1];
                    u32x2 w; w.x = pack4_fp8(v0[0], v0[1], v0[2], v0[3]); w.y = pack4_fp8(v1[0], v1[1], v1[2], v1[3]);
                    *(LAS u32x2*)(stg + fr * 64 + bj * 32 + fq * 8) = w; }
                asm volatile("" ::: "memory");
                const u32x4 t = *(const LAS u32x4*)(stg + lane * 16);
                asm volatile("" ::: "memory");
                *(u32x4*)(yb + (size_t)aid * DM) = t;
            }
    }
};
}

namespace att {
constexpr int STG_F = 16384, STG_D = 32768;
constexpr int LDS_NCK = 98304;
typedef LAS const char* lds_cptr;
typedef short v4i16_t __attribute__((ext_vector_type(4)));
typedef __bf16 bf16x2_t __attribute__((ext_vector_type(2)));
__device__ __forceinline__ void glds16(const void* gsrc, unsigned lds_dst) { unsigned keep;
    asm volatile("s_mov_b32 %0, m0\n\ts_mov_b32 m0, %2\n\ts_nop 0\n\tglobal_load_lds_dwordx4 %1, off\n\ts_mov_b32 m0, %0" : "=&s"(keep) : "v"(gsrc), "s"(lds_dst) : "memory"); }
__device__ __forceinline__ unsigned cvtpk(float lo, float hi) { f32x2 v = {lo, hi}; bf16x2_t b = __builtin_convertvector(v, bf16x2_t); return __builtin_bit_cast(unsigned, b); }
__device__ __forceinline__ s16x4 vtr(lds_cptr p) { return __builtin_bit_cast(s16x4, __builtin_amdgcn_ds_read_tr16_b64_v4i16((LAS v4i16_t*)p)); }
__device__ __forceinline__ float swapmax(float m) { auto rr = __builtin_amdgcn_permlane32_swap(__float_as_uint(m), __float_as_uint(m), false, false); return fmaxf(__uint_as_float(rr[0]), __uint_as_float(rr[1])); }
__device__ __forceinline__ float swapsum(float m) { auto rr = __builtin_amdgcn_permlane32_swap(__float_as_uint(m), __float_as_uint(m), false, false); return __uint_as_float(rr[0]) + __uint_as_float(rr[1]); }
__device__ __forceinline__ u32x4 widen_pair(u32x2 a, u32x2 b) {
    auto r0 = __builtin_amdgcn_permlane32_swap(a.x, b.x, false, false); auto r1 = __builtin_amdgcn_permlane32_swap(a.y, b.y, false, false);
    return (u32x4){r0[0], r1[0], r0[1], r1[1]};
}
#define ATT_WAIT_BAR(N) asm volatile("s_waitcnt vmcnt(" #N ") lgkmcnt(0)\n\ts_barrier" ::: "memory")
#define ATT_BAR() asm volatile("s_waitcnt lgkmcnt(0)\n\ts_barrier" ::: "memory")

__device__ __forceinline__ float max3f(float a, float b, float c) { float r; asm("v_max3_f32 %0, %1, %2, %3" : "=v"(r) : "v"(a), "v"(b), "v"(c)); return r; }
template <int NO, bool REL>
__device__ __forceinline__ void softmax_tile(f32x16& p0, f32x16& p1, float& m, float& l, f32x16 (&o)[NO], u32x4 (&pw)[4], f32x16& negm, bool first) {
    float mx = max3f(p0[0], p1[0], p0[1]);
    mx = max3f(mx, p1[1], p0[2]); mx = max3f(mx, p1[2], p0[3]); mx = max3f(mx, p1[3], p0[4]); mx = max3f(mx, p1[4], p0[5]); mx = max3f(mx, p1[5], p0[6]); mx = max3f(mx, p1[6], p0[7]);
    float my = max3f(p1[7], p0[8], p1[8]);
    my = max3f(my, p0[9], p1[9]); my = max3f(my, p0[10], p1[10]); my = max3f(my, p0[11], p1[11]); my = max3f(my, p0[12], p1[12]); my = max3f(my, p0[13], p1[13]); my = max3f(my, p0[14], p1[14]);
    mx = max3f(mx, my, p0[15]); mx = fmaxf(mx, p1[15]);
    mx = swapmax(mx);
    if constexpr (REL) {
        if (first || __any(mx > 8.0f)) {
            const float dl = first ? mx : fmaxf(mx, 0.f); const float al = __builtin_amdgcn_exp2f(-dl); m += dl; l *= al;
#pragma unroll
            for (int r = 0; r < 16; ++r) { p0[r] -= dl; p1[r] -= dl; negm[r] = -m; }
#pragma unroll
            for (int d = 0; d < NO; ++d)
#pragma unroll
                for (int r = 0; r < 16; ++r) o[d][r] *= al;
        }
    } else {
        if (__any(mx > m + 8.0f)) {
            const float mn = fmaxf(m, mx); const float al = __builtin_amdgcn_exp2f(m - mn); m = mn; l *= al;
#pragma unroll
            for (int d = 0; d < NO; ++d)
#pragma unroll
                for (int r = 0; r < 16; ++r) o[d][r] *= al;
        }
#pragma unroll
        for (int r = 0; r < 16; ++r) { p0[r] -= m; p1[r] -= m; }
    }
    float ls0 = 0.f;
#pragma unroll
    for (int r = 0; r < 16; ++r) { p0[r] = __builtin_amdgcn_exp2f(p0[r]); p1[r] = __builtin_amdgcn_exp2f(p1[r]); ls0 += p0[r]; ls0 += p1[r]; }
    l += ls0;
    pw[0] = (u32x4){cvtpk(p0[0], p0[1]), cvtpk(p0[2], p0[3]), cvtpk(p0[4], p0[5]), cvtpk(p0[6], p0[7])};
    pw[1] = (u32x4){cvtpk(p0[8], p0[9]), cvtpk(p0[10], p0[11]), cvtpk(p0[12], p0[13]), cvtpk(p0[14], p0[15])};
    pw[2] = (u32x4){cvtpk(p1[0], p1[1]), cvtpk(p1[2], p1[3]), cvtpk(p1[4], p1[5]), cvtpk(p1[6], p1[7])};
    pw[3] = (u32x4){cvtpk(p1[8], p1[9]), cvtpk(p1[10], p1[11]), cvtpk(p1[12], p1[13]), cvtpk(p1[14], p1[15])};
}
#define ATT_SBAR() __builtin_amdgcn_sched_barrier(0)
struct VFrag { s16x4 lo[4], hi[4]; };
__device__ __forceinline__ void vload(VFrag& f, lds_cptr vp, int d) {
#pragma unroll
    for (int ks = 0; ks < 4; ++ks) { f.lo[ks] = vtr(vp + d * 4096 + ks * 1024); f.hi[ks] = vtr(vp + d * 4096 + ks * 1024 + 512); }
}
__device__ __forceinline__ void pv_block(f32x16& o, const VFrag& f, const u32x4 (&pw)[4]) {
#pragma unroll
    for (int ks = 0; ks < 4; ++ks) {
        const bf16x8 vf = (bf16x8){f.lo[ks][0], f.lo[ks][1], f.lo[ks][2], f.lo[ks][3], f.hi[ks][0], f.hi[ks][1], f.hi[ks][2], f.hi[ks][3]};
        o = __builtin_amdgcn_mfma_f32_32x32x16_bf16(vf, __builtin_bit_cast(bf16x8, pw[ks]), o, 0, 0, 0);
    }
}
__device__ __forceinline__ void kload(bf16x8 (&kf)[8], lds_cptr kb, int hi, int sw) {
#pragma unroll
    for (int d0 = 0; d0 < 4; ++d0) { const int co = ((2 * d0 + hi) ^ sw) << 4; kf[2 * d0] = *(const LAS bf16x8*)(kb + co); kf[2 * d0 + 1] = *(const LAS bf16x8*)(kb + co + 4096); }
}
__device__ __forceinline__ void qk_mma(f32x16& p0, f32x16& p1, const bf16x8 (&kf)[8], const bf16x8 (&qr)[4]) {
#pragma unroll
    for (int d0 = 0; d0 < 4; ++d0) {
        p0 = __builtin_amdgcn_mfma_f32_32x32x16_bf16(kf[2 * d0], qr[d0], p0, 0, 0, 0);
        p1 = __builtin_amdgcn_mfma_f32_32x32x16_bf16(kf[2 * d0 + 1], qr[d0], p1, 0, 0, 0);
    }
}

template <int PV, bool F8O>
__device__ __forceinline__ void fox_unit(int b, int h, int qb, const bf16_t* FQ, const bf16_t* FK, const bf16_t* FV, const float* NCK, const unsigned* KN, bf16_t* AO, char* shm) {
    const int tid = fresh_tid(), lane = tid & 63, r32 = lane & 31, hi = lane >> 5; const int wid = __builtin_amdgcn_readfirstlane(tid >> 6);
    const long rowbase = (long)b * SEQ; const int q0 = qb * 256;
    const int NT = 4 * (qb + 1), tl = 4 * qb + (wid >> 1), i0 = NT - 1 - tl;
    const unsigned lds0 = (unsigned)(uintptr_t)shm;
    const lds_cptr shm3 = (lds_cptr)shm;
    LAS float* nckl = (LAS float*)(shm3 + LDS_NCK);
    LAS unsigned* vote = (LAS unsigned*)(shm3 + L_VOTE);
    const int krow = wid * 8 + (lane >> 3);
    const bf16_t* ksrc = FK + (rowbase + krow) * 512 + h * 64 + (((lane & 7) ^ ((krow >> 1) & 7)) << 3);
    const bf16_t* vsrc = FV + (rowbase + 16 * (wid & 3) + (lane >> 2)) * 512 + h * 64 + (wid >> 2) * 32 + (lane & 3) * 8;
    const unsigned kdst = lds0 + wid * 1024, vdst = lds0 + 8192 + wid * 1024;
#define FOX_DMA(t, so) do { glds16(ksrc + (long)(t) * 64 * 512, (unsigned)__builtin_amdgcn_readfirstlane(kdst + (so))); glds16(vsrc + (long)(t) * 64 * 512, (unsigned)__builtin_amdgcn_readfirstlane(vdst + (so))); } while (0)
    FOX_DMA(NT - 1, 0); FOX_DMA(NT - 2, STG_F);
    { const f32x4* src = (const f32x4*)(NCK + (size_t)(b * 8 + h) * SEQ); const int n4 = 16 * NT;
      f32x4 c0 = {0.f, 0.f, 0.f, 0.f}, c1 = c0; if (tid < n4) c0 = src[tid]; if (tid + NTHR < n4) c1 = src[tid + NTHR];
      if (tid < n4) ((LAS f32x4*)nckl)[tid] = c0; if (tid + NTHR < n4) ((LAS f32x4*)nckl)[tid + NTHR] = c1; }
    const bf16_t* Qw = FQ + (rowbase + q0 + wid * 32 + r32) * 512 + h * 64;
    bf16x8 qr[4];
#pragma unroll
    for (int d0 = 0; d0 < 4; ++d0) qr[d0] = *(const bf16x8*)(Qw + d0 * 16 + hi * 8);
    const float kn2 = __uint_as_float(KN[(b * 8 + h) * 2]) + __uint_as_float(KN[(b * 8 + h) * 2 + 1]);
    asm volatile("" : "+v"(qr[0]), "+v"(qr[1]), "+v"(qr[2]), "+v"(qr[3]));
    float qn2 = 0.f;
#pragma unroll
    for (int d0 = 0; d0 < 4; ++d0) { const u32x4 w = __builtin_bit_cast(u32x4, qr[d0]);
#pragma unroll
        for (int j = 0; j < 4; ++j) { const float a = bf_lo(w[j]), c = bf_hi(w[j]); qn2 += a * a + c * c; } }
    qn2 = swapsum(qn2);
    const float Bq = sqrtf(qn2 * kn2) * 1.02f + 0.01f;
    const lds_cptr kp0 = shm3 + r32 * 128; const int ksw = (r32 >> 1) & 7;
    const lds_cptr vp0 = shm3 + 8192 + ((lane >> 4) & 1) * 32 + (lane & 3) * 8 + (4 * hi + ((lane & 15) >> 2)) * 64;
    float m = -1e30f, l = 0.f; f32x16 o[2]; o[0] = f32x16{}; o[1] = f32x16{};
    const int qrow = q0 + wid * 32 + r32;
    int so = 0, so2 = 2 * STG_F;
    for (int i = 0; i < NT; ++i) {
        const int t = NT - 1 - i;
        if (i + 1 < NT) ATT_WAIT_BAR(2); else ATT_WAIT_BAR(0);
        if (i > 0) {
            const LAS unsigned* vv = vote + ((i - 1) & 1) * 8; const u32x4 va4 = *(const LAS u32x4*)vv, vb4 = *(const LAS u32x4*)(vv + 4);
            if (((va4[0] | va4[1]) | (va4[2] | va4[3]) | (vb4[0] | vb4[1]) | (vb4[2] | vb4[3])) == 0u) break;
        }
        bf16x8 kf[8];
        if (i >= i0) kload(kf, kp0 + so, hi, ksw);
        if (i + 2 < NT) FOX_DMA(t - 2, so2);
        unsigned myvote = 1u;
        if (i >= i0) {
            f32x16 p0, p1; VFrag va, vb;
            const LAS float* nk = nckl + 64 * t + 4 * hi;
#pragma unroll
            for (int g = 0; g < 4; ++g) { const f32x4 a = *(const LAS f32x4*)(nk + 8 * g), c = *(const LAS f32x4*)(nk + 32 + 8 * g);
                p0[4 * g] = a[0]; p0[4 * g + 1] = a[1]; p0[4 * g + 2] = a[2]; p0[4 * g + 3] = a[3]; p1[4 * g] = c[0]; p1[4 * g + 1] = c[1]; p1[4 * g + 2] = c[2]; p1[4 * g + 3] = c[3]; }
            vload(va, vp0 + so, 0);
            ATT_SBAR();
            qk_mma(p0, p1, kf, qr);
            asm volatile("s_nop 15\n\ts_nop 7" : "+v"(p0), "+v"(p1));
            ATT_SBAR();
            if (i == i0) { const int kb = 64 * t + 4 * hi;
#pragma unroll
                for (int r = 0; r < 16; ++r) { const int kv = kb + (r & 3) + 8 * (r >> 2); if (kv > qrow) p0[r] = -INFINITY; if (kv + 32 > qrow) p1[r] = -INFINITY; } }
            u32x4 pw[4];
            softmax_tile<2, false>(p0, p1, m, l, o, pw, p0, false);
            ATT_SBAR();
            vload(vb, vp0 + so, 1);
            pv_block(o[0], va, pw);
            ATT_SBAR();
            pv_block(o[1], vb, pw);
            ATT_SBAR();
            myvote = (t > 0 && __any(Bq + nckl[64 * t - 1] - m > -48.0f)) ? 1u : 0u;
        }
        if (lane == 0) vote[(i & 1) * 8 + wid] = myvote;
        so = (so == 2 * STG_F) ? 0 : so + STG_F; so2 = (so2 == 2 * STG_F) ? 0 : so2 + STG_F;
    }
#undef FOX_DMA
    asm volatile("s_waitcnt vmcnt(0)" ::: "memory");
    ATT_BAR();
    l = swapsum(l);
    const float inv = __builtin_amdgcn_rcpf(l);
    if constexpr (F8O) {
        unsigned char* Ow = (unsigned char*)AO + (rowbase + qrow) * 1024 + 512 + h * 64 + 8 * hi;
#pragma unroll
        for (int d = 0; d < 2; ++d)
#pragma unroll
            for (int g = 0; g < 4; g += 2) {
                const unsigned wa = pack4_fp8(o[d][4 * g] * inv, o[d][4 * g + 1] * inv, o[d][4 * g + 2] * inv, o[d][4 * g + 3] * inv), wb = pack4_fp8(o[d][4 * g + 4] * inv, o[d][4 * g + 5] * inv, o[d][4 * g + 6] * inv, o[d][4 * g + 7] * inv);
                auto r = __builtin_amdgcn_permlane32_swap(wa, wb, false, false);
                *(u32x2*)(Ow + d * 32 + 8 * g) = (u32x2){r[0], r[1]}; }
    } else {
    bf16_t* Ow = AO + (rowbase + qrow) * 1024 + 512 + h * 64 + 8 * hi;
#pragma unroll
    for (int d = 0; d < 2; ++d)
#pragma unroll
        for (int g = 0; g < 4; g += 2) { u32x2 wa, wb;
            wa.x = cvt_pk_bf16(o[d][4 * g] * inv, o[d][4 * g + 1] * inv); wa.y = cvt_pk_bf16(o[d][4 * g + 2] * inv, o[d][4 * g + 3] * inv);
            wb.x = cvt_pk_bf16(o[d][4 * g + 4] * inv, o[d][4 * g + 5] * inv); wb.y = cvt_pk_bf16(o[d][4 * g + 6] * inv, o[d][4 * g + 7] * inv);
            *(u32x4*)(Ow + d * 32 + 8 * g) = widen_pair(wa, wb); }
    }
}

template <int PV, bool F8O>
__device__ __forceinline__ void diff_unit(int b, int h, int qb, const bf16_t* DQ, const bf16_t* DK, const bf16_t* DV, const float* subg, float lam, float post, bf16_t* AO, char* shm) {
    const int tid = fresh_tid(), lane = tid & 63, r32 = lane & 31, hi = lane >> 5; const int wid = __builtin_amdgcn_readfirstlane(tid >> 6);
    const int map = wid >> 2, wq = wid & 3;
    const long rowbase = (long)b * SEQ; const int q0 = qb * 128;
    const int NT = 2 * (qb + 1), tl = 2 * qb + (wq >> 1);
    const unsigned lds0 = (unsigned)(uintptr_t)shm;
    const lds_cptr shm3 = (lds_cptr)shm;
    const int qrow = q0 + wq * 32 + r32;
    const int krow = wid * 8 + (lane >> 3);
    const bf16_t* ksrc = DK + (rowbase + krow) * 512 + h * 128 + (((lane & 7) ^ ((krow >> 1) & 7)) << 3);
    const bf16_t* vsrc = DV + (rowbase + 16 * (wid & 3) + (lane >> 2)) * 512 + h * 128 + (wid >> 2) * 32 + (lane & 3) * 8;
    const unsigned kdst = lds0 + wid * 1024, vdst = lds0 + 16384 + wid * 1024;
#define DIFF_DMA(t, so) do { glds16(ksrc + (long)(t) * 64 * 512, (unsigned)__builtin_amdgcn_readfirstlane(kdst + (so))); glds16(ksrc + (long)(t) * 64 * 512 + 64, (unsigned)__builtin_amdgcn_readfirstlane(kdst + 8192 + (so))); \
        glds16(vsrc + (long)(t) * 64 * 512, (unsigned)__builtin_amdgcn_readfirstlane(vdst + (so))); glds16(vsrc + (long)(t) * 64 * 512 + 64, (unsigned)__builtin_amdgcn_readfirstlane(vdst + 8192 + (so))); } while (0)
    if ((PV & 8) == 0) { DIFF_DMA(0, 0); DIFF_DMA(1, STG_D); }
    const bf16_t* Qw = DQ + (rowbase + qrow) * 512 + h * 128 + map * 64;
    bf16x8 qr[4];
#pragma unroll
    for (int d0 = 0; d0 < 4; ++d0) qr[d0] = *(const bf16x8*)(Qw + d0 * 16 + hi * 8);
    asm volatile("" : "+v"(qr[0]), "+v"(qr[1]), "+v"(qr[2]), "+v"(qr[3]));
    const lds_cptr kp0 = shm3 + map * 8192 + r32 * 128; const int ksw = (r32 >> 1) & 7;
    const lds_cptr vp0 = shm3 + 16384 + ((lane >> 4) & 1) * 32 + (lane & 3) * 8 + (4 * hi + ((lane & 15) >> 2)) * 64;
    float m = 0.f, l = 0.f; f32x16 o[4]; o[0] = f32x16{}; o[1] = f32x16{}; o[2] = f32x16{}; o[3] = f32x16{};
    f32x16 negm = f32x16{}; asm volatile("" : "+v"(negm));
    int so = 0, so2 = 2 * STG_D;
    for (int t = 0; t < NT; ++t) {
        if ((PV & 8) == 0) { if (t + 1 < NT) ATT_WAIT_BAR(4); else ATT_WAIT_BAR(0); } else ATT_BAR();
        bf16x8 kf[8];
        if ((PV & 4) == 0 && t <= tl) kload(kf, kp0 + so, hi, ksw);
        if ((PV & 8) == 0 && t + 2 < NT) DIFF_DMA(t + 2, so2);
        if (t <= tl) {
            f32x16 p0 = negm, p1 = negm; VFrag va, vb;
            if ((PV & 1) == 0) vload(va, vp0 + so, 0);
            ATT_SBAR();
            if ((PV & 4) == 0) qk_mma(p0, p1, kf, qr);
            asm volatile("s_nop 15\n\ts_nop 7" : "+v"(p0), "+v"(p1));
            ATT_SBAR();
            u32x4 pw[4];
            if ((PV & 2) == 0) softmax_tile<4, true>(p0, p1, m, l, o, pw, negm, t == 0); else { pw[0] = (u32x4){__float_as_uint(p0[0]), __float_as_uint(p0[1]), __float_as_uint(p1[0]), __float_as_uint(p1[1])}; pw[1] = pw[0]; pw[2] = pw[0]; pw[3] = pw[0]; }
            ATT_SBAR();
            if ((PV & 1) == 0) { vload(vb, vp0 + so, 1);
            pv_block(o[0], va, pw);
            ATT_SBAR();
            vload(va, vp0 + so, 2);
            pv_block(o[1], vb, pw);
            ATT_SBAR();
            vload(vb, vp0 + so, 3);
            pv_block(o[2], va, pw);
            ATT_SBAR();
            pv_block(o[3], vb, pw); } else { o[0][0] += __uint_as_float(pw[0][0]); o[1][0] += __uint_as_float(pw[1][1]); }
            ATT_SBAR();
        }
        so = (so == 2 * STG_D) ? 0 : so + STG_D; so2 = (so2 == 2 * STG_D) ? 0 : so2 + STG_D;
    }
#undef DIFF_DMA
    l = swapsum(l);
    const float inv = __builtin_amdgcn_rcpf(l);
    ATT_BAR();
    LAS float* xch = (LAS float*)shm3 + (wq * 64) * 64 + lane;
    if (map == 1) {
#pragma unroll
        for (int d = 0; d < 4; ++d)
#pragma unroll
            for (int r = 0; r < 16; ++r) xch[(d * 16 + r) * 64] = o[d][r] * inv;
    }
    ATT_BAR();
    if (map == 0) {
        float ss = 0.f;
#pragma unroll
        for (int d = 0; d < 4; ++d)
#pragma unroll
            for (int r = 0; r < 16; ++r) { const float a = o[d][r] * inv - lam * xch[(d * 16 + r) * 64]; o[d][r] = a; ss += a * a; }
        ss = swapsum(ss);
        const float rn = __builtin_amdgcn_rsqf(ss * (1.0f / 128.0f) + NORM_EPS) * post;
        if constexpr (F8O) {
            unsigned char* Ow = (unsigned char*)AO + (rowbase + qrow) * 1024 + h * 128 + 8 * hi;
#pragma unroll
            for (int d = 0; d < 4; ++d)
#pragma unroll
                for (int g = 0; g < 4; g += 2) { const f32x4 sa = *(const f32x4*)(subg + d * 32 + 8 * g + 4 * hi), sb = *(const f32x4*)(subg + d * 32 + 8 * g + 8 + 4 * hi);
                    const unsigned wa = pack4_fp8(o[d][4 * g] * rn * sa[0], o[d][4 * g + 1] * rn * sa[1], o[d][4 * g + 2] * rn * sa[2], o[d][4 * g + 3] * rn * sa[3]);
                    const unsigned wb = pack4_fp8(o[d][4 * g + 4] * rn * sb[0], o[d][4 * g + 5] * rn * sb[1], o[d][4 * g + 6] * rn * sb[2], o[d][4 * g + 7] * rn * sb[3]);
                    auto r = __builtin_amdgcn_permlane32_swap(wa, wb, false, false);
                    *(u32x2*)(Ow + d * 32 + 8 * g) = (u32x2){r[0], r[1]}; }
        } else {
        bf16_t* Ow = AO + (rowbase + qrow) * 1024 + h * 128 + 8 * hi;
#pragma unroll
        for (int d = 0; d < 4; ++d)
#pragma unroll
            for (int g = 0; g < 4; g += 2) { const f32x4 sa = *(const f32x4*)(subg + d * 32 + 8 * g + 4 * hi), sb = *(const f32x4*)(subg + d * 32 + 8 * g + 8 + 4 * hi);
                u32x2 wa, wb;
                wa.x = cvt_pk_bf16(o[d][4 * g] * rn * sa[0], o[d][4 * g + 1] * rn * sa[1]); wa.y = cvt_pk_bf16(o[d][4 * g + 2] * rn * sa[2], o[d][4 * g + 3] * rn * sa[3]);
                wb.x = cvt_pk_bf16(o[d][4 * g + 4] * rn * sb[0], o[d][4 * g + 5] * rn * sb[1]); wb.y = cvt_pk_bf16(o[d][4 * g + 6] * rn * sb[2], o[d][4 * g + 7] * rn * sb[3]);
                *(u32x4*)(Ow + d * 32 + 8 * g) = widen_pair(wa, wb); }
        }
    }
    ATT_BAR();
}
}

struct Args {
    const float* x; const float* c; const int* pos; const float* ada_w; const float* ada_b; const float* norm_mix; const float* norm_ffn; const float* w_in;
    const float* b_forget; const float* lq1; const float* lk1; const float* lq2; const float* lk2; const float* subln; const float* w_out; const float* router_w;
    const float* router_b; const float* w1; const float* b1; const float* w2; const float* b2; const float* final_norm;
    float* out; unsigned char* ws; int ph_lo, ph_hi;
};

__device__ __forceinline__ void transpose_item(const float* W, int ldw, int K, bf16_t* WT, int k0, int n0, int drow, LAS float* scr, int lane) {
    float ld_[32];
#pragma unroll
    for (int i = 0; i < 32; ++i) ld_[i] = W[(size_t)(k0 + 2 * i + (lane >> 5)) * ldw + n0 + (lane & 31)];
#pragma unroll
    for (int i = 0; i < 32; ++i) scr[(2 * i + (lane >> 5)) * 33 + (lane & 31)] = ld_[i];
    asm volatile("s_waitcnt lgkmcnt(0)" ::: "memory");
    const int c = lane & 7;
#pragma unroll
    for (int j = 0; j < 4; ++j) { const int n = (lane >> 3) + 8 * j; const LAS float* s = scr + (8 * c) * 33 + n;
        u32x4 o; o.x = cvt_pk_bf16(s[0 * 33], s[1 * 33]); o.y = cvt_pk_bf16(s[2 * 33], s[3 * 33]); o.z = cvt_pk_bf16(s[4 * 33], s[5 * 33]); o.w = cvt_pk_bf16(s[6 * 33], s[7 * 33]);
        *(u32x4*)(WT + (size_t)(drow + n) * K + k0 + 8 * c) = o; }
    asm volatile("s_waitcnt lgkmcnt(0)" ::: "memory");
}

__device__ __forceinline__ void transpose_item_f8(const float* W, int ldw, int K, unsigned char* WT, int k0, int n0, int drow, LAS float* scr, int lane) {
    float ld_[32];
#pragma unroll
    for (int i = 0; i < 32; ++i) ld_[i] = W[(size_t)(k0 + 2 * i + (lane >> 5)) * ldw + n0 + (lane & 31)];
#pragma unroll
    for (int i = 0; i < 32; ++i) scr[(2 * i + (lane >> 5)) * 33 + (lane & 31)] = ld_[i];
    asm volatile("s_waitcnt lgkmcnt(0)" ::: "memory");
    const int c = lane & 7;
#pragma unroll
    for (int j = 0; j < 4; ++j) { const int n = (lane >> 3) + 8 * j; const LAS float* s = scr + (8 * c) * 33 + n;
        u32x2 o; o.x = pack4_fp8(s[0 * 33] * 32.f, s[1 * 33] * 32.f, s[2 * 33] * 32.f, s[3 * 33] * 32.f); o.y = pack4_fp8(s[4 * 33] * 32.f, s[5 * 33] * 32.f, s[6 * 33] * 32.f, s[7 * 33] * 32.f);
        *(u32x2*)(WT + (size_t)(drow + n) * K + k0 + 8 * c) = o; }
    asm volatile("s_waitcnt lgkmcnt(0)" ::: "memory");
}

#define CB(j) (512 * ((j) >> 1) + 8 * lane + 4 * ((j) & 1))
template <bool F8OUT>
__device__ __forceinline__ void norm1_row(const f32x4 (&v)[4], const f32x4 (&gm)[4], const f32x4 (&sh)[4], const LAS float* wft, const float bfv, bf16_t* xnrow, float* LF, int b, int s, int lane) {
    float ss = 0.f;
#pragma unroll
    for (int j = 0; j < 4; ++j) ss += (v[j][0] * v[j][0] + v[j][1] * v[j][1]) + (v[j][2] * v[j][2] + v[j][3] * v[j][3]);
    const float rstd = __builtin_amdgcn_rsqf(wave_sum(ss) * (1.0f / DM) + NORM_EPS);
    f32x4 hv[4];
#pragma unroll
    for (int j = 0; j < 4; ++j) hv[j] = v[j] * rstd * gm[j] + sh[j];
#pragma unroll
    for (int jj = 0; jj < 2; ++jj) { const f32x4 a = hv[2 * jj], c = hv[2 * jj + 1];
        if constexpr (F8OUT) { u32x2 w; w.x = pack4_fp8(a[0], a[1], a[2], a[3]); w.y = pack4_fp8(c[0], c[1], c[2], c[3]); *(u32x2*)((unsigned char*)xnrow + 512 * jj + 8 * lane) = w; }
        else { u32x4 w; w.x = cvt_pk_bf16(a[0], a[1]); w.y = cvt_pk_bf16(a[2], a[3]); w.z = cvt_pk_bf16(c[0], c[1]); w.w = cvt_pk_bf16(c[2], c[3]); *(u32x4*)(xnrow + 512 * jj + 8 * lane) = w; } }
    float a8[8];
#pragma unroll
    for (int hh = 0; hh < 8; ++hh) { float a = 0.f;
#pragma unroll
        for (int j = 0; j < 4; ++j) { const f32x4 w = *(const LAS f32x4*)(wft + hh * DM + CB(j)); a += (hv[j][0] * w[0] + hv[j][1] * w[1]) + (hv[j][2] * w[2] + hv[j][3] * w[3]); }
        a8[hh] = a; }
    float a4[4], a2[2], a1;
    { const bool up = (lane & 32) != 0;
#pragma unroll
      for (int i = 0; i < 4; ++i) { const float snd = up ? a8[i] : a8[i + 4], kp = up ? a8[i + 4] : a8[i]; a4[i] = kp + __shfl_xor(snd, 32); } }
    { const bool up = (lane & 16) != 0;
#pragma unroll
      for (int i = 0; i < 2; ++i) { const float snd = up ? a4[i] : a4[i + 2], kp = up ? a4[i + 2] : a4[i]; a2[i] = kp + __shfl_xor(snd, 16); } }
    { const bool up = (lane & 8) != 0; const float snd = up ? a2[0] : a2[1], kp = up ? a2[1] : a2[0]; a1 = kp + __shfl_xor(snd, 8); }
    a1 += __shfl_xor(a1, 4); a1 += __shfl_xor(a1, 2); a1 += __shfl_xor(a1, 1);
    if ((lane & 7) == 0) { const int hd = lane >> 3; const float z = a1 + bfv;
        const float lf = (z >= 0.f) ? -log1pf(__expf(-z)) : (z - log1pf(__expf(z)));
        LF[(size_t)(b * 8 + hd) * SEQ + s] = lf; }
}

__global__ void __launch_bounds__(NTHR, 2) fwd_kernel(Args args) {
    extern __shared__ __attribute__((aligned(16))) unsigned char lds[];
    LAS unsigned char* L = (LAS unsigned char*)lds;
    int tid = threadIdx.x, lane = tid & 63, wave = __builtin_amdgcn_readfirstlane(tid >> 6);
    __builtin_amdgcn_s_setreg(1 | (23 << 6), 1u);
#define FRESH_IDS() do { tid = fresh_tid(); lane = tid & 63; wave = __builtin_amdgcn_readfirstlane(tid >> 6); gw = vcu * NWAVES + wave; } while (0)
    const int G = gridDim.x; const int bx = blockIdx.x; const int vcu = (G % 8 == 0) ? (bx % 8) * (G / 8) + bx / 8 : bx;
#define WSPTRS() GAS unsigned char* ws0_ = (GAS unsigned char*)args.ws; asm volatile("" : "+s"(ws0_)); unsigned char* ws = (unsigned char*)ws0_;       \
    unsigned* ctl = (unsigned*)(ws + WS_CTL); (void)ctl; \
    bf16_t* WQ = (bf16_t*)(ws + WS_WQ); float* BQ = (float*)(ws + WS_BQ); (void)WQ; (void)BQ; \
    float* MOD = (float*)(ws + WS_MOD); float* RWT = (float*)(ws + WS_RWT); float* WFT = (float*)(ws + WS_WFT); float* ROPE = (float*)(ws + WS_ROPE); \
    float* NCK = (float*)(ws + WS_NCK); float* LF = (float*)(ws + WS_LF); float* GATES = (float*)(ws + WS_GATES); int* ROWL = (int*)(ws + WS_ROWL); \
    bf16_t* WIN = (bf16_t*)(ws + WS_WIN); bf16_t* WOUT = (bf16_t*)(ws + WS_WOUT); unsigned char* W1T = ws + WS_W1; unsigned char* W2T = ws + WS_W2; \
    bf16_t* XN = (bf16_t*)(ws + WS_XN); bf16_t* QKV = (bf16_t*)(ws + WS_QKV); bf16_t* AO = (bf16_t*)(ws + WS_AO); \
    bf16_t* X1 = (bf16_t*)(ws + WS_X1); bf16_t* X2 = (bf16_t*)(ws + WS_X2); unsigned char* XN2 = ws + WS_XN2; unsigned char* HID = ws + WS_HID; unsigned char* Y = ws + WS_Y; \
    (void)MOD; (void)RWT; (void)WFT; (void)ROPE; (void)NCK; (void)LF; (void)GATES; (void)ROWL; (void)WIN; (void)WOUT; (void)W1T; (void)W2T; (void)XN; (void)QKV; (void)AO; (void)X1; (void)X2; (void)XN2; (void)HID; (void)Y
    for (int u = tid; u < 256; u += NTHR) ((LAS unsigned*)(L + MISC_OFF))[u] = 0u;
    __syncthreads();
    if (lane == 0) *(volatile LAS int*)(size_t)(L_WTAB_ABS + 4 * hw_slot()) = wave;
    __syncthreads();
#if MK_MULTI
#define GRID_BAR() do { } while (0)
#else
    XcdBarrier bar = xcd_barrier_post((unsigned*)(args.ws + WS_CTL) + CW_BAR, (volatile LAS unsigned*)(L + L_XBST));
#define GRID_BAR() xcd_barrier(bar)
#endif
    long tacc = 0;
    TP_BEGIN(30)
    const int lo = args.ph_lo, hi_ = args.ph_hi;
#ifndef PH_MASK
#define PH_MASK 0x1ff
#endif
#define IN(k) (lo <= (k) && (k) < hi_)
#define ON(j) (((PH_MASK) >> (j)) & 1)
#ifndef REP_MASK
#define REP_MASK 0
#endif
#define NREP(j) (1 + (((REP_MASK) >> (j)) & 1))
#define BOTH(k) (IN(k) && IN((k) + 1))
    int gw = vcu * NWAVES + wave; const int NGW = G * NWAVES;

    if (ON(0) && IN(0)) { TP_BEGIN(20)
        FRESH_IDS(); WSPTRS();
        for (int rep_ = 0; rep_ < NREP(0); ++rep_) {
        const int gt_ = vcu * NTHR + tid, NGT_ = G * NTHR;
        int pb0_ = 0, pb1_ = 0; float rb0_ = 0.f, wb0_ = 0.f;
        if (gt_ < NTOK * 8) pb0_ = args.pos[gt_ >> 3];
        if (gt_ + NGT_ < NTOK * 8) pb1_ = args.pos[(gt_ + NGT_) >> 3];
        if (gt_ < DEPTH * NEXP * DM) { const int l = gt_ / (NEXP * DM), r = gt_ % (NEXP * DM), e = r / DM, k = r % DM; rb0_ = args.router_w[((size_t)l * DM + k) * NEXP + e]; }
        if (gt_ < DEPTH * 8 * DM) { const int l = gt_ / (8 * DM), r = gt_ % (8 * DM), hh = r / DM, k = r % DM; wb0_ = args.w_in[((size_t)l * DM + k) * INCOLS + 3072 + hh]; }
        TP_BEGIN(31)
        {
            LAS float* cact = (LAS float*)(L + 73728);
            LAS float* part = (LAS float*)(L + 73728 + 32768);
            for (int i = tid; i < 8 * DM; i += NTHR) { const float cv = args.c[i]; cact[i] = cv / (1.0f + __expf(-cv)); }
            __syncthreads();
            for (int it = vcu; it < 256; it += G) {
                const int l = it >> 7, j0 = (it & 127) * 48; const bool on = lane < 48;
                const float* aw = args.ada_w + (size_t)l * DM * 6144 + j0 + (on ? lane : 0);
                float a8[8] = {0.f, 0.f, 0.f, 0.f, 0.f, 0.f, 0.f, 0.f};
                for (int kc = 0; kc < 4; ++kc) { const int kb = wave * 128 + kc * 32; float av[32];
#pragma unroll
                    for (int i = 0; i < 32; ++i) av[i] = aw[(size_t)(kb + i) * 6144];
#pragma unroll
                    for (int i = 0; i < 32; ++i)
#pragma unroll
                        for (int b = 0; b < 8; ++b) a8[b] += cact[b * DM + kb + i] * av[i]; }
#pragma unroll
                for (int b = 0; b < 8; ++b) part[(wave * 8 + b) * 64 + lane] = a8[b];
                __syncthreads();
                { const int b = tid >> 6; float s = 0.f;
#pragma unroll
                  for (int w = 0; w < 8; ++w) s += part[(w * 8 + b) * 64 + lane];
                  if (on) MOD[((size_t)l * 8 + b) * 6144 + j0 + lane] = s + args.ada_b[l * 6144 + j0 + lane]; }
                __syncthreads();
            }
        }
        TP_END(31) TP_BEGIN(32)
        {
            const int gt = vcu * NTHR + tid, NGT = G * NTHR;
            const double invf[8] = {1.0, 0.1939227432012558, 0.03760603070259094, 0.007292664609849453, 0.0014142135623842478, 0.00027424818836152554, 5.3182957344688475e-05, 1.0313385246263351e-05};
            auto rope_put = [&](int i, int posv) { const int tok = i >> 3, j = i & 7;
                double iv = invf[0];
#pragma unroll
                for (int q = 1; q < 8; ++q) iv = (j == q) ? invf[q] : iv;
                double rev = (double)posv * iv * 0.15915494309189535; rev -= rint(rev); const float fr_ = (float)rev;
                ROPE[(size_t)tok * 16 + j] = __builtin_amdgcn_cosf(fr_); ROPE[(size_t)tok * 16 + 8 + j] = __builtin_amdgcn_sinf(fr_); };
            if (gt < NTOK * 8) rope_put(gt, pb0_);
            if (gt + NGT < NTOK * 8) rope_put(gt + NGT, pb1_);
            for (int i = gt + 2 * NGT; i < NTOK * 8; i += NGT) rope_put(i, args.pos[i >> 3]);
            if (gt < DEPTH * NEXP * DM) RWT[gt] = rb0_;
            for (int i = gt + NGT; i < DEPTH * NEXP * DM; i += NGT) { const int l = i / (NEXP * DM), r = i % (NEXP * DM), e = r / DM, k = r % DM; RWT[i] = args.router_w[((size_t)l * DM + k) * NEXP + e]; }
            if (gt < DEPTH * 8 * DM) WFT[gt] = wb0_;
            for (int i = gt + NGT; i < DEPTH * 8 * DM; i += NGT) { const int l = i / (8 * DM), r = i % (8 * DM), hh = r / DM, k = r % DM; WFT[i] = args.w_in[((size_t)l * DM + k) * INCOLS + 3072 + hh]; }
        }
        TP_END(32) TP_BEGIN(33)
        {
            LAS float* tile = (LAS float*)L;
            constexpr int TS = 265;
            constexpr int I_IN = 16 * 12, I_OUT = 16 * 4, I_1 = 16 * 8, I_2 = 16 * 4;
            constexpr int T_IN = DEPTH * I_IN, T_OUT = DEPTH * I_OUT, T_1 = DEPTH * NEXP * I_1, T_2 = DEPTH * NEXP * I_2, T_ALL = T_IN + T_OUT + T_1 + T_2;
            struct Desc { const float* W; unsigned char* WT; int ldw, k0, n0, kind; };
            auto desc = [&](int it) { Desc d; int r = it;
                if (r < T_IN) { const int l = r / I_IN, q = r % I_IN, kb = q / 12, nb = q % 12;
                    d.W = args.w_in + (size_t)l * DM * INCOLS; d.ldw = INCOLS; d.k0 = kb * 64; d.n0 = nb * 256; d.kind = (l != 0) ? 1 : 0;
                    d.WT = (l == 0) ? (unsigned char*)WIN : (unsigned char*)(WIN + (size_t)3072 * DM); return d; }
                r -= T_IN;
                if (r < T_OUT) { const int l = r / I_OUT, q = r % I_OUT, kb = q / 4, nb = q % 4;
                    d.W = args.w_out + (size_t)l * DM * DM; d.ldw = DM; d.k0 = kb * 64; d.n0 = nb * 256; d.kind = (l != 0) ? 1 : 0; d.WT = (unsigned char*)(WOUT + (size_t)l * DM * DM); return d; }
                r -= T_OUT;
                if (r < T_1) { const int le = r / I_1, q = r % I_1, kb = q / 8, nb = q % 8;
                    d.W = args.w1 + (size_t)le * DM * 2048; d.ldw = 2048; d.k0 = kb * 64; d.n0 = nb * 256; d.kind = 2; d.WT = W1T + (size_t)le * 2048 * DM; return d; }
                r -= T_1;
                { const int le = r / I_2, q = r % I_2, kb = q / 4, nb = q % 4;
                    d.W = args.w2 + (size_t)le * DM * DM; d.ldw = DM; d.k0 = kb * 64; d.n0 = nb * 256; d.kind = 1; d.WT = W2T + (size_t)le * DM * DM; return d; } };
            f32x4 lda[8], ldb[8], ldq[8]; Desc da, db, dq;
#define P0_LOAD(ld_, d_, it_) do { d_ = desc((it_) < T_ALL ? (it_) : 0); if ((it_) < T_ALL) { _Pragma("unroll") for (int i = 0; i < 8; ++i) ld_[i] = *(const f32x4*)(d_.W + (size_t)(d_.k0 + 8 * wave + i) * d_.ldw + d_.n0 + 4 * lane); } } while (0)
#define P0_PROC(ld_, d_) do { \
                _Pragma("unroll") for (int i = 0; i < 8; ++i) { LAS float* tp = tile + (8 * wave + i) * TS + 4 * lane + (lane >> 3); tp[0] = ld_[i][0]; tp[1] = ld_[i][1]; tp[2] = ld_[i][2]; tp[3] = ld_[i][3]; } \
                __syncthreads(); \
                { const int c = lane & 7; \
                _Pragma("unroll") for (int r2 = 0; r2 < 4; ++r2) { const int nr = 32 * wave + 8 * r2 + (lane >> 3); const LAS float* sp = tile + (8 * c) * TS + nr + (nr >> 5); \
                    const int n = d_.n0 + nr; \
                    const int drow = (d_.kind == 2) ? ((n < 1024) ? ((n >> 7) * 256 + (n & 127)) : ((((n - 1024) >> 7) * 256) + 128 + ((n - 1024) & 127))) : n; \
                    if (d_.kind != 0) { u32x2 o; o.x = pack4_fp8(sp[0 * TS] * 32.f, sp[1 * TS] * 32.f, sp[2 * TS] * 32.f, sp[3 * TS] * 32.f); o.y = pack4_fp8(sp[4 * TS] * 32.f, sp[5 * TS] * 32.f, sp[6 * TS] * 32.f, sp[7 * TS] * 32.f); \
                        *(u32x2*)(d_.WT + (size_t)drow * DM + d_.k0 + 8 * c) = o; } \
                    else { u32x4 o; o.x = cvt_pk_bf16(sp[0 * TS], sp[1 * TS]); o.y = cvt_pk_bf16(sp[2 * TS], sp[3 * TS]); o.z = cvt_pk_bf16(sp[4 * TS], sp[5 * TS]); o.w = cvt_pk_bf16(sp[6 * TS], sp[7 * TS]); \
                        *(u32x4*)((bf16_t*)d_.WT + (size_t)drow * DM + d_.k0 + 8 * c) = o; } } } \
                __syncthreads(); } while (0)
            int it = vcu;
            P0_LOAD(lda, da, it); P0_LOAD(ldb, db, it + G);
            __syncthreads();
            for (; it < T_ALL; it += 3 * G) {
                P0_LOAD(ldq, dq, it + 2 * G);
                P0_PROC(lda, da);
                if (it + G >= T_ALL) break;
                P0_LOAD(lda, da, it + 3 * G);
                P0_PROC(ldb, db);
                if (it + 2 * G >= T_ALL) break;
                P0_LOAD(ldb, db, it + 4 * G);
                P0_PROC(ldq, dq);
            }
#undef P0_LOAD
#undef P0_PROC
        }
        TP_END(33)
        } if (BOTH(0)) GRID_BAR(); TP_END(20)
    }

    if (ON(1) && IN(1)) { TP_BEGIN(21)
        FRESH_IDS(); WSPTRS();
        for (int rep_ = 0; rep_ < NREP(1); ++rep_) {
        for (int i = vcu * NTHR + tid; i < DEPTH * 8 * 32 * 2 * 64; i += G * NTHR) {
            const int ln = i & 63, blk = (i >> 6) & 1, sq = (i >> 7) & 31, bb = (i >> 12) & 7, ll = i >> 15;
            const int e = 16 * blk + (ln & 15), k0 = 32 * sq + 8 * (ln >> 4);
            const float* md = MOD + ((size_t)ll * 8 + bb) * 6144 + 4 * 1024;
            float w[8]; unsigned hi4[4], lo4[4];
#pragma unroll
            for (int j = 0; j < 8; ++j) w[j] = args.router_w[((size_t)ll * DM + k0 + j) * NEXP + e] * args.norm_ffn[ll * DM + k0 + j] * (1.0f + md[k0 + j]);
#pragma unroll
            for (int j = 0; j < 4; ++j) { hi4[j] = cvt_pk_bf16(w[2 * j], w[2 * j + 1]); lo4[j] = cvt_pk_bf16(w[2 * j] - bf_lo(hi4[j]), w[2 * j + 1] - bf_hi(hi4[j])); }
            u32x4* dst = (u32x4*)(WQ + ((((size_t)(ll * 8 + bb) * 32 + sq) * 2 + blk) * 2) * 64 * 8);
            dst[ln] = (u32x4){hi4[0], hi4[1], hi4[2], hi4[3]}; dst[64 + ln] = (u32x4){lo4[0], lo4[1], lo4[2], lo4[3]};
        }
        for (int i = gw; i < DEPTH * 8 * 32; i += NGW) { const int e = i & 31, bb = (i >> 5) & 7, ll = i >> 8;
            const float* md = MOD + ((size_t)ll * 8 + bb) * 6144 + 3 * 1024; float a = 0.f;
#pragma unroll 4
            for (int j = 0; j < 16; ++j) { const int k = lane + 64 * j; a += md[k] * args.router_w[((size_t)ll * DM + k) * NEXP + e]; }
            a = wave_sum(a); if (lane == 0) BQ[i] = a + args.router_b[ll * NEXP + e]; }
        LAS float* wft = (LAS float*)L;
        for (int i = tid; i < 8 * DM; i += NTHR) wft[i] = WFT[i];
        __syncthreads();
        const float bfv = args.b_forget[lane >> 3];
        for (int ch = gw; ch < NTOK / 16; ch += NGW) {
            const int b = ch >> 8; const float* mod = MOD + (size_t)b * 6144;
            f32x4 gm[4], sh[4];
#pragma unroll
            for (int j = 0; j < 4; ++j) { const int c0 = CB(j); const f32x4 g = *(const f32x4*)(args.norm_mix + c0), sc = *(const f32x4*)(mod + 1024 + c0); gm[j] = g * (sc + 1.0f); sh[j] = *(const f32x4*)(mod + c0); }
            f32x4 va[4], vb[4]; const int row0 = ch * 16;
#define A_LOAD(v_, mrow_) do { _Pragma("unroll") for (int j = 0; j < 4; ++j) v_[j] = *(const f32x4*)(args.x + (size_t)(mrow_) * DM + CB(j)); } while (0)
#define A_PIN(v_) asm volatile("" : "+v"(v_[0]), "+v"(v_[1]), "+v"(v_[2]), "+v"(v_[3]))
            A_LOAD(va, row0);
#pragma unroll 1
            for (int rr = 0; rr < 16; rr += 2) {
                A_LOAD(vb, row0 + rr + 1);
                A_PIN(va); norm1_row<false>(va, gm, sh, wft, bfv, XN + (size_t)(row0 + rr) * DM, LF, b, (row0 + rr) & (SEQ - 1), lane);
                const int nx = (rr + 2 < 16) ? rr + 2 : rr;
                A_LOAD(va, row0 + nx);
                A_PIN(vb); norm1_row<false>(vb, gm, sh, wft, bfv, XN + (size_t)(row0 + rr + 1) * DM, LF, b, (row0 + rr + 1) & (SEQ - 1), lane);
            }
#undef A_LOAD
#undef A_PIN
        }
        __syncthreads();
        } if (BOTH(1)) GRID_BAR(); TP_END(21)
    }

    for (int l = 0; l < DEPTH; ++l) {
        const int pb = 2 + 7 * l;
#define modl (MOD + (size_t)l * 8 * 6144)
        if (ON(2) && IN(pb + 0)) { TP_BEGIN(22)
            FRESH_IDS(); WSPTRS();
        for (int rep_ = 0; rep_ < NREP(2); ++rep_) {
            if (vcu < 64) {
                const float* src = LF + (size_t)vcu * SEQ + 8 * tid; float* dst = NCK + (size_t)vcu * SEQ + 8 * tid;
                f32x4 a = *(const f32x4*)src, c2 = *(const f32x4*)(src + 4);
                float e[8] = {a[0], a[1], a[2], a[3], c2[0], c2[1], c2[2], c2[3]};
#pragma unroll
                for (int i = 1; i < 8; ++i) e[i] += e[i - 1];
                float tot = e[7], inc = tot;
#pragma unroll
                for (int o = 1; o < 64; o <<= 1) { const float n = __shfl_up(inc, o); if (lane >= o) inc += n; }
                LAS float* sc = (LAS float*)(L + L_SCAN);
                if (lane == 63) sc[wave] = inc;
                __syncthreads();
                float pre = inc - tot;
                for (int w = 0; w < wave; ++w) pre += sc[w];
                f32x4 o0, o1;
                o0[0] = -(e[0] + pre) * LOG2E; o0[1] = -(e[1] + pre) * LOG2E; o0[2] = -(e[2] + pre) * LOG2E; o0[3] = -(e[3] + pre) * LOG2E;
                o1[0] = -(e[4] + pre) * LOG2E; o1[1] = -(e[5] + pre) * LOG2E; o1[2] = -(e[6] + pre) * LOG2E; o1[3] = -(e[7] + pre) * LOG2E;
                *(f32x4*)dst = o0; *(f32x4*)(dst + 4) = o1;
            }
            __syncthreads();
            if (l == 0) {
                pg8::SchedDense S{(const char*)XN, (const char*)WIN, 12, (NTOK / 256) * 12, G, vcu, DM};
                const pg8::EpiInProj E{QKV, ROPE, ctl + CW_KN + l * 128, 1.0f, (LAS float*)(L + IDX_OFF)};
                pg8::gemm_phase<pg8::EpiInProj, pg8::SchedDense, true>(L, DM, S, E, tacc);
            } else {
                pg8::SchedDenseG S{(const char*)XN, (const char*)(WIN + (size_t)3072 * DM), 12, (NTOK / 256) * 12, G, vcu, DM};
                const pg8::EpiInProj E{QKV, ROPE, ctl + CW_KN + l * 128, 0.03125f, (LAS float*)(L + IDX_OFF)};
                pg8::gemm_phase<pg8::EpiInProj, pg8::SchedDenseG, true, true>(L, DM, S, E, tacc);
            }
            } if (BOTH(pb + 0)) GRID_BAR(); TP_END(22)
        }
        if (ON(3) && IN(pb + 1)) { TP_BEGIN(23)
            FRESH_IDS(); WSPTRS();
        for (int rep_ = 0; rep_ < NREP(3); ++rep_) {
            const bf16_t* DQ = QKV; const bf16_t* DK = QKV + (size_t)NTOK * 512; const bf16_t* DV = QKV + (size_t)2 * NTOK * 512;
            const bf16_t* FQ = QKV + (size_t)3 * NTOK * 512; const bf16_t* FK = QKV + (size_t)4 * NTOK * 512; const bf16_t* FV = QKV + (size_t)5 * NTOK * 512;
            const float lam_init = 0.8f - 0.6f * expf(-0.3f * (float)l);
            const float s1 = wave_sum(args.lq1[l * 64 + lane] * args.lk1[l * 64 + lane]), s2 = wave_sum(args.lq2[l * 64 + lane] * args.lk2[l * 64 + lane]);
            const float lam = expf(s1) - expf(s2) + lam_init;
#ifndef ATT_PV
#define ATT_PV 0
#endif
            unsigned* aq = ctl + CW_AQ + l * 64; LAS int* qslot = (LAS int*)(L + L_QSLOT);
            LAS float* rkey = (LAS float*)(L + IDX_OFF); LAS int* perm = (LAS int*)(L + IDX_OFF + 256);
            if (tid < 64) rkey[tid] = NCK[(size_t)tid * SEQ + SEQ - 1];
            __syncthreads();
            if (tid < 64) { const float v = rkey[tid]; int r = 0;
                for (int j = 0; j < 64; ++j) { const float o = rkey[j]; r += (o < v || (o == v && j < tid)) ? 1 : 0; }
                perm[r] = tid; }
            if (tid == 0) *qslot = (int)__hip_atomic_fetch_add(aq, 1u, __ATOMIC_RELAXED, __HIP_MEMORY_SCOPE_AGENT);
            if (l == 0) {
            for (int p = vcu; p < 512; p += G) { const int bh = p >> 4, s = p & 15;
                att::diff_unit<0, false>(bh >> 2, bh & 3, 31 - s, DQ, DK, DV, args.subln + l * 128, lam, 1.0f - lam_init, AO, (char*)lds);
                att::diff_unit<0, false>(bh >> 2, bh & 3, s, DQ, DK, DV, args.subln + l * 128, lam, 1.0f - lam_init, AO, (char*)lds); }
            } else {
            for (int p = vcu; p < 512; p += G) { const int bh = p >> 4, s = p & 15;
                att::diff_unit<0, true>(bh >> 2, bh & 3, 31 - s, DQ, DK, DV, args.subln + l * 128, lam, 1.0f - lam_init, AO, (char*)lds);
                att::diff_unit<0, true>(bh >> 2, bh & 3, s, DQ, DK, DV, args.subln + l * 128, lam, 1.0f - lam_init, AO, (char*)lds); }
            }
            for (;;) {
                __syncthreads();
                const int u = *qslot;
                __syncthreads();
                if (u >= 1024) break;
                if (tid == 0) *qslot = (int)__hip_atomic_fetch_add(aq, 1u, __ATOMIC_RELAXED, __HIP_MEMORY_SCOPE_AGENT);
                const int bh = perm[u >> 4], qb = 15 - (u & 15);
                if (l == 0) att::fox_unit<0, false>(bh >> 3, bh & 7, qb, FQ, FK, FV, NCK, ctl + CW_KN + l * 128, AO, (char*)lds);
                else att::fox_unit<0, true>(bh >> 3, bh & 7, qb, FQ, FK, FV, NCK, ctl + CW_KN + l * 128, AO, (char*)lds);
            }
            } if (BOTH(pb + 1)) GRID_BAR(); TP_END(23)
        }
        if (ON(4) && IN(pb + 2)) { TP_BEGIN(24)
            FRESH_IDS(); WSPTRS();
        for (int rep_ = 0; rep_ < NREP(4); ++rep_) {
            if (l == 0) {
                pg8::SchedDense S{(const char*)AO, (const char*)WOUT, 4, (NTOK / 256) * 4, G, vcu, DM};
                const pg8::EpiOutProj<false> E{args.x, X1, modl + 2 * 1024, 1.0f};
                pg8::gemm_phase<pg8::EpiOutProj<false>, pg8::SchedDense, true>(L, DM, S, E, tacc);
            } else {
                pg8::SchedDenseG S{(const char*)AO, (const char*)(WOUT + (size_t)DM * DM), 4, (NTOK / 256) * 4, G, vcu, DM};
                const pg8::EpiOutProj<true> E{X2, X1, modl + 2 * 1024, 0.03125f};
                pg8::gemm_phase<pg8::EpiOutProj<true>, pg8::SchedDenseG, true, true>(L, DM, S, E, tacc);
            }
            } if (BOTH(pb + 2)) GRID_BAR(); TP_END(24)
        }
        if (ON(5) && IN(pb + 3)) { TP_BEGIN(25)
            FRESH_IDS(); WSPTRS();
            LAS u32x4* wq = (LAS u32x4*)L;
            LAS float* rsl = (LAS float*)(L + IDX_OFF) + wave * 16;
            LAS float* bql = (LAS float*)(L + IDX_OFF + 1024);
            LAS int* hist = (LAS int*)(L + L_HIST); LAS int* basel = (LAS int*)(L + L_BASE);
            const int nch = NTOK / 16, niter = (nch + NGW - 1) / NGW;
            int bcur = -1;
            if (tid < 32) hist[tid] = 0;
            unsigned* cntg = ctl + CW_CNT + l * 32 * 64;
            for (int itr = 0; itr < niter; ++itr) {
                const int ch = itr * NGW + gw; const bool act = ch < nch;
                const int bwg = ((itr * NGW + vcu * NWAVES) >> 8) & 7;
                if (bwg != bcur) { __syncthreads(); bcur = bwg;
                    const u32x4* src = (const u32x4*)(WQ + (size_t)(l * 8 + bwg) * 32 * 2 * 2 * 64 * 8);
                    { u32x4 t_[16];
#pragma unroll
                      for (int i = 0; i < 16; ++i) t_[i] = src[i * NTHR + tid];
#pragma unroll
                      for (int i = 0; i < 16; ++i) wq[i * NTHR + tid] = t_[i]; }
                    if (tid < 32) bql[tid] = BQ[(l * 8 + bwg) * 32 + tid];
                    __syncthreads(); }
                int te[4] = {0, 0, 0, 0}, lr[4] = {0, 0, 0, 0}; float tg[4] = {0.f, 0.f, 0.f, 0.f};
                for (int rep_ = 0; rep_ < NREP(5); ++rep_)
                if (act) {
                    const int b = ch >> 8; const float* mod = modl + (size_t)b * 6144;
                    const int tk = lane & 15, kg = lane >> 4;
                    const bf16_t* xr = X1 + (size_t)(ch * 16 + tk) * DM + 8 * kg;
                    f32x4 acc0 = {0.f, 0.f, 0.f, 0.f}, acc1 = acc0; float ssq = 0.f;
                    u32x4 xs[32];
#pragma unroll
                    for (int sq = 0; sq < 32; ++sq) xs[sq] = *(const u32x4*)(xr + 32 * sq);
#pragma unroll
                    for (int q = 0; q < 4; ++q) asm volatile("" : "+v"(xs[8 * q]), "+v"(xs[8 * q + 1]), "+v"(xs[8 * q + 2]), "+v"(xs[8 * q + 3]), "+v"(xs[8 * q + 4]), "+v"(xs[8 * q + 5]), "+v"(xs[8 * q + 6]), "+v"(xs[8 * q + 7]));
#pragma unroll
                    for (int sq = 0; sq < 32; ++sq) {
                        const u32x4 xh = xs[sq];
#pragma unroll
                        for (int j = 0; j < 4; ++j) { const float p = bf_lo(xh[j]), q = bf_hi(xh[j]); ssq += p * p + q * q; }
                        const bf16x8 bh = __builtin_bit_cast(bf16x8, xh);
                        const LAS u32x4* wp = wq + sq * 256 + lane;
                        const bf16x8 w0h = __builtin_bit_cast(bf16x8, wp[0]), w0l = __builtin_bit_cast(bf16x8, wp[64]), w1h = __builtin_bit_cast(bf16x8, wp[128]), w1l = __builtin_bit_cast(bf16x8, wp[192]);
                        acc0 = __builtin_amdgcn_mfma_f32_16x16x32_bf16(w0h, bh, acc0, 0, 0, 0); acc1 = __builtin_amdgcn_mfma_f32_16x16x32_bf16(w1h, bh, acc1, 0, 0, 0);
                        acc0 = __builtin_amdgcn_mfma_f32_16x16x32_bf16(w0l, bh, acc0, 0, 0, 0); acc1 = __builtin_amdgcn_mfma_f32_16x16x32_bf16(w1l, bh, acc1, 0, 0, 0);
                    }
                    ssq += __shfl_xor(ssq, 16); ssq += __shfl_xor(ssq, 32);
                    const float rstd = __builtin_amdgcn_rsqf(ssq * (1.0f / DM) + NORM_EPS);
                    if (lane < 16) rsl[lane] = rstd;
                    float v0 = -INFINITY, v1 = -INFINITY, v2 = -INFINITY, v3 = -INFINITY; int i0 = 0, i1 = 0, i2 = 0, i3 = 0;
#define TOPK_INS(x_, e_) do { const float xx_ = (x_); const int ee_ = (e_); \
                        if (xx_ > v3 || (xx_ == v3 && ee_ < i3)) { v3 = xx_; i3 = ee_; \
                            if (v3 > v2 || (v3 == v2 && i3 < i2)) { float tf = v2; v2 = v3; v3 = tf; int ti = i2; i2 = i3; i3 = ti; \
                                if (v2 > v1 || (v2 == v1 && i2 < i1)) { tf = v1; v1 = v2; v2 = tf; ti = i1; i1 = i2; i2 = ti; \
                                    if (v1 > v0 || (v1 == v0 && i1 < i0)) { tf = v0; v0 = v1; v1 = tf; ti = i0; i0 = i1; i1 = ti; } } } } } while (0)
#pragma unroll
                    for (int r = 0; r < 4; ++r) { TOPK_INS(acc0[r] * rstd + bql[4 * kg + r], 4 * kg + r); }
#pragma unroll
                    for (int r = 0; r < 4; ++r) { TOPK_INS(acc1[r] * rstd + bql[16 + 4 * kg + r], 16 + 4 * kg + r); }
#pragma unroll
                    for (int st = 16; st <= 32; st <<= 1) {
                        const float p0 = __shfl_xor(v0, st), p1 = __shfl_xor(v1, st), p2 = __shfl_xor(v2, st), p3 = __shfl_xor(v3, st);
                        const int q0 = __shfl_xor(i0, st), q1 = __shfl_xor(i1, st), q2 = __shfl_xor(i2, st), q3 = __shfl_xor(i3, st);
                        TOPK_INS(p0, q0); TOPK_INS(p1, q1); TOPK_INS(p2, q2); TOPK_INS(p3, q3);
                    }
#undef TOPK_INS
                    if (lane < 16) {
                        const float e1 = __expf(v1 - v0), e2 = __expf(v2 - v0), e3 = __expf(v3 - v0); const float rs = 1.0f / (1.0f + e1 + e2 + e3);
                        te[0] = i0; te[1] = i1; te[2] = i2; te[3] = i3; tg[0] = rs; tg[1] = e1 * rs; tg[2] = e2 * rs; tg[3] = e3 * rs;
#pragma unroll
                        for (int k = 0; k < 4; ++k) if (rep_ == NREP(5) - 1) lr[k] = atomicAdd((int*)(lds + L_HIST) + te[k], 1);
                    }
                    f32x4 gm[4], sh[4];
#pragma unroll
                    for (int j = 0; j < 4; ++j) { const int c0 = CB(j); const f32x4 g = *(const f32x4*)(args.norm_ffn + l * DM + c0), sc = *(const f32x4*)(mod + 4 * 1024 + c0); gm[j] = g * (sc + 1.0f); sh[j] = *(const f32x4*)(mod + 3 * 1024 + c0); }
                    asm volatile("s_waitcnt lgkmcnt(0)" ::: "memory");
                    {
                        u32x4 xr2[16][2];
#pragma unroll
                        for (int rr = 0; rr < 16; ++rr)
#pragma unroll
                            for (int jj = 0; jj < 2; ++jj) xr2[rr][jj] = *(const u32x4*)(X1 + (size_t)(ch * 16 + rr) * DM + 512 * jj + 8 * lane);
#pragma unroll
                        for (int q = 0; q < 4; ++q) asm volatile("" : "+v"(xr2[4 * q][0]), "+v"(xr2[4 * q][1]), "+v"(xr2[4 * q + 1][0]), "+v"(xr2[4 * q + 1][1]), "+v"(xr2[4 * q + 2][0]), "+v"(xr2[4 * q + 2][1]), "+v"(xr2[4 * q + 3][0]), "+v"(xr2[4 * q + 3][1]));
#pragma unroll
                        for (int rr = 0; rr < 16; ++rr) { const int mrow = ch * 16 + rr; const float rs2 = rsl[rr];
#pragma unroll
                            for (int jj = 0; jj < 2; ++jj) { const int c0 = 512 * jj + 8 * lane; const u32x4 xw = xr2[rr][jj];
                                const f32x4 va = (f32x4){bf_lo(xw.x), bf_hi(xw.x), bf_lo(xw.y), bf_hi(xw.y)} * rs2 * gm[2 * jj] + sh[2 * jj], vc = (f32x4){bf_lo(xw.z), bf_hi(xw.z), bf_lo(xw.w), bf_hi(xw.w)} * rs2 * gm[2 * jj + 1] + sh[2 * jj + 1];
                                u32x2 w; w.x = pack4_fp8(va[0], va[1], va[2], va[3]); w.y = pack4_fp8(vc[0], vc[1], vc[2], vc[3]); *(u32x2*)(XN2 + (size_t)mrow * DM + c0) = w; } }
                    }
                }
                __syncthreads();
                if (tid < 32) { const int c = hist[tid]; int base = 0; if (c > 0) base = (int)__hip_atomic_fetch_add(cntg + tid * 64, (unsigned)c, __ATOMIC_RELAXED, __HIP_MEMORY_SCOPE_AGENT); basel[tid] = base; hist[tid] = 0; }
                __syncthreads();
                if (act && lane < 16) { const int mrow = ch * 16 + lane;
#pragma unroll
                    for (int k = 0; k < 4; ++k) { ROWL[(size_t)te[k] * ROWCAP + basel[te[k]] + lr[k]] = mrow * 4 + k; GATES[mrow * 4 + k] = tg[k]; } }
                __syncthreads();
            }
            if (BOTH(pb + 3)) GRID_BAR(); TP_END(25)
        }
        if ((ON(6) && IN(pb + 4)) || (ON(7) && IN(pb + 5))) {
            FRESH_IDS(); WSPTRS();
            LAS int* lcnt = (LAS int*)(L + L_CNT); LAS int* lblk = (LAS int*)(L + L_BLK); LAS int* idx = (LAS int*)(L + IDX_OFF);
            unsigned* cntg = ctl + CW_CNT + l * 32 * 64;
            __syncthreads();
            if (tid < 32) lcnt[tid] = (int)__hip_atomic_load(cntg + tid * 64, __ATOMIC_RELAXED, __HIP_MEMORY_SCOPE_AGENT);
            __syncthreads();
            if (tid == 0) { int s = 0; for (int e = 0; e < 32; ++e) { lblk[e] = s; s += (lcnt[e] + 255) >> 8; } lblk[32] = s; }
            __syncthreads();
            const int nrb = lblk[32];
            if (ON(6) && IN(pb + 4)) { TP_BEGIN(26)
        for (int rep_ = 0; rep_ < NREP(6); ++rep_) {
                const int nU = nrb * 8;
                { int rv[18];
#pragma unroll
                  for (int i = 0; i < 18; ++i) { rv[i] = 0; if (i * G + vcu < nU && tid < 256) { const int rb = (i * G + vcu) >> 3; const int e = pg8::find_expert(lblk, rb);
                      const int r = (rb - lblk[e]) * 256 + tid; if (r < lcnt[e]) rv[i] = ROWL[(size_t)e * ROWCAP + r]; } }
#pragma unroll
                  for (int i = 0; i < 18; ++i) if (i * G + vcu < nU && tid < 256) idx[i * 256 + tid] = rv[i] >> 2; }
                __syncthreads();
                pg8::SchedMoe1 S{(const char*)XN2, (const char*)(W1T + (size_t)l * NEXP * 2048 * DM), lblk, idx, nU, G, vcu};
                pg8::EpiMoe1 E{HID, args.b1 + (size_t)l * NEXP * 2048, (LAS float*)(L + BIAS_OFF)};
                pg8::gemm_phase<pg8::EpiMoe1, pg8::SchedMoe1, true, true>(L, DM, S, E, tacc);
                } if (BOTH(pb + 4)) GRID_BAR(); TP_END(26)
            }
            if (ON(7) && IN(pb + 5)) { TP_BEGIN(27)
        for (int rep_ = 0; rep_ < NREP(7); ++rep_) {
                const int nU = nrb * 4;
                __syncthreads();
                { int rv[9];
#pragma unroll
                  for (int i = 0; i < 9; ++i) { rv[i] = NTOK * TOPK; if (i * G + vcu < nU && tid < 256) { const int rb = (i * G + vcu) >> 2; const int e = pg8::find_expert(lblk, rb);
                      const int r = (rb - lblk[e]) * 256 + tid; if (r < lcnt[e]) rv[i] = ROWL[(size_t)e * ROWCAP + r]; } }
#pragma unroll
                  for (int i = 0; i < 9; ++i) if (i * G + vcu < nU && tid < 256) idx[i * 256 + tid] = rv[i]; }
                __syncthreads();
                pg8::SchedMoe2 S{(const char*)HID, (const char*)(W2T + (size_t)l * NEXP * DM * DM), lblk, nU, G, vcu};
                pg8::EpiMoe2 E{Y, args.b2 + (size_t)l * NEXP * DM, idx, (LAS float*)(L + BIAS_OFF)};
                pg8::gemm_phase<pg8::EpiMoe2, pg8::SchedMoe2, true, true>(L, DM, S, E, tacc);
                } if (BOTH(pb + 5)) GRID_BAR(); TP_END(27)
            }
        }
        if (ON(8) && IN(pb + 6)) { TP_BEGIN(28)
            FRESH_IDS(); WSPTRS();
        for (int rep_ = 0; rep_ < NREP(8); ++rep_) {
            LAS float* wft = (LAS float*)L;
            if (l + 1 < DEPTH) { float t_[16];
#pragma unroll
                for (int i = 0; i < 16; ++i) t_[i] = WFT[(size_t)(l + 1) * 8 * DM + i * NTHR + tid];
#pragma unroll
                for (int i = 0; i < 16; ++i) wft[i * NTHR + tid] = t_[i]; }
            __syncthreads();
            const float bfv = (l + 1 < DEPTH) ? args.b_forget[(l + 1) * 8 + (lane >> 3)] : 0.f;
            for (int ch = gw; ch < NTOK / 16; ch += NGW) {
                const int b = ch >> 8; const float* mod = modl + (size_t)b * 6144;
                f32x4 g2[4], gm[4], sh[4];
#pragma unroll
                for (int j = 0; j < 4; ++j) { const int c0 = CB(j); g2[j] = *(const f32x4*)(mod + 5 * 1024 + c0);
                    if (l + 1 < DEPTH) { const float* mod2 = MOD + ((size_t)(l + 1) * 8 + b) * 6144; const f32x4 g = *(const f32x4*)(args.norm_mix + (l + 1) * DM + c0), sc = *(const f32x4*)(mod2 + 1024 + c0); gm[j] = g * (sc + 1.0f); sh[j] = *(const f32x4*)(mod2 + c0); }
                    else { gm[j] = *(const f32x4*)(args.final_norm + c0); sh[j] = (f32x4){0.f, 0.f, 0.f, 0.f}; } }
                struct RowIn { u32x2 y[2][4]; u32x4 x[2]; f32x4 g; };
#define H_LOAD(r_, mrow_) do { const int mr_ = (mrow_); (r_).g = *(const f32x4*)(GATES + (size_t)mr_ * 4); \
                    _Pragma("unroll") for (int jj = 0; jj < 2; ++jj) { const int c0 = 512 * jj + 8 * lane; \
                        _Pragma("unroll") for (int k = 0; k < 4; ++k) (r_).y[jj][k] = *(const u32x2*)(Y + ((size_t)mr_ * 4 + k) * DM + c0); \
                        (r_).x[jj] = *(const u32x4*)(X1 + (size_t)mr_ * DM + c0); } } while (0)
#define H_PIN(r_) asm volatile("" : "+v"((r_).y[0][0]), "+v"((r_).y[0][1]), "+v"((r_).y[0][2]), "+v"((r_).y[0][3]), "+v"((r_).y[1][0]), "+v"((r_).y[1][1]), "+v"((r_).y[1][2]), "+v"((r_).y[1][3]), "+v"((r_).x[0]), "+v"((r_).x[1]), "+v"((r_).g))
                auto h_row = [&](const RowIn& r, const int mrow) {
                    const f32x4 gt = r.g * (1.0f / YSCALE);
                    f32x4 v[4];
#pragma unroll
                    for (int jj = 0; jj < 2; ++jj) {
                        f32x4 a = {0.f, 0.f, 0.f, 0.f}, c = a;
#pragma unroll
                        for (int k = 0; k < 4; ++k) { const u32x2 yw = r.y[jj][k]; const float gk = gt[k];
                            const f32x2 y0 = __builtin_amdgcn_cvt_pk_f32_fp8((int)yw.x, false), y1 = __builtin_amdgcn_cvt_pk_f32_fp8((int)yw.x, true);
                            const f32x2 y2 = __builtin_amdgcn_cvt_pk_f32_fp8((int)yw.y, false), y3 = __builtin_amdgcn_cvt_pk_f32_fp8((int)yw.y, true);
                            a[0] += gk * y0[0]; a[1] += gk * y0[1]; a[2] += gk * y1[0]; a[3] += gk * y1[1];
                            c[0] += gk * y2[0]; c[1] += gk * y2[1]; c[2] += gk * y3[0]; c[3] += gk * y3[1]; }
                        const u32x4 xw = r.x[jj];
                        v[2 * jj] = (f32x4){bf_lo(xw.x), bf_hi(xw.x), bf_lo(xw.y), bf_hi(xw.y)} + g2[2 * jj] * a; v[2 * jj + 1] = (f32x4){bf_lo(xw.z), bf_hi(xw.z), bf_lo(xw.w), bf_hi(xw.w)} + g2[2 * jj + 1] * c; }
                    if (l + 1 < DEPTH) {
#pragma unroll
                        for (int jj = 0; jj < 2; ++jj) { u32x4 w; w.x = cvt_pk_bf16(v[2 * jj][0], v[2 * jj][1]); w.y = cvt_pk_bf16(v[2 * jj][2], v[2 * jj][3]); w.z = cvt_pk_bf16(v[2 * jj + 1][0], v[2 * jj + 1][1]); w.w = cvt_pk_bf16(v[2 * jj + 1][2], v[2 * jj + 1][3]);
                            *(u32x4*)(X2 + (size_t)mrow * DM + 512 * jj + 8 * lane) = w; }
                        norm1_row<true>(v, gm, sh, wft, bfv, (bf16_t*)((unsigned char*)XN + (size_t)mrow * DM), LF, b, mrow & (SEQ - 1), lane);
                    } else {
                        float ss = 0.f;
#pragma unroll
                        for (int j = 0; j < 4; ++j) ss += (v[j][0] * v[j][0] + v[j][1] * v[j][1]) + (v[j][2] * v[j][2] + v[j][3] * v[j][3]);
                        const float rstd = __builtin_amdgcn_rsqf(wave_sum(ss) * (1.0f / DM) + NORM_EPS);
#pragma unroll
                        for (int j = 0; j < 4; ++j) *(f32x4*)(args.out + (size_t)mrow * DM + CB(j)) = v[j] * rstd * gm[j];
                    }
                };
                RowIn ra0, rb0; const int row0 = ch * 16;
                H_LOAD(ra0, row0);
#pragma unroll 1
                for (int rr = 0; rr < 16; rr += 2) {
                    H_LOAD(rb0, row0 + rr + 1);
                    H_PIN(ra0); h_row(ra0, row0 + rr);
                    const int nx = (rr + 2 < 16) ? rr + 2 : rr;
                    H_LOAD(ra0, row0 + nx);
                    H_PIN(rb0); h_row(rb0, row0 + rr + 1);
                }
#undef H_LOAD
#undef H_PIN
            }
            __syncthreads();
            } if (BOTH(pb + 6)) GRID_BAR(); TP_END(28)
        }
    }
    TP_END(30)
    if (TPROBE != 0 && blockIdx.x == 0 && fresh_tid() == 0) { const long t0 = (long)__builtin_amdgcn_s_memtime(); while ((long)__builtin_amdgcn_s_memtime() - t0 < tacc * TP_MULT) __builtin_amdgcn_s_sleep(8); }
#undef IN
#undef BOTH
}

extern "C" void kernel_launch(void* const* d_in, const int* in_sizes, int n_in, void* d_out, int out_size, void* d_ws, size_t ws_size, hipStream_t stream) {
    static int grid = 0;
    if (grid == 0) {
        if (n_in != 22 || in_sizes[0] != NTOK * DM || out_size != NTOK * DM || ws_size < WS_END) {
            fprintf(stderr, "kernel_launch: unexpected shapes: n_in %d in0 %d out %d ws %zu (need %zu)\n", n_in, n_in > 0 ? in_sizes[0] : -1, out_size, ws_size, (size_t)WS_END); grid = -1; return; }
        int dev = 0, cus = 0, per_cu = 0;
        if (hipGetDevice(&dev) != hipSuccess || hipDeviceGetAttribute(&cus, hipDeviceAttributeMultiprocessorCount, dev) != hipSuccess) { grid = -1; return; }
        if (hipFuncSetAttribute((const void*)fwd_kernel, hipFuncAttributeMaxDynamicSharedMemorySize, LDS_BYTES) != hipSuccess) { fprintf(stderr, "kernel_launch: hipFuncSetAttribute failed\n"); grid = -1; return; }
        if (hipOccupancyMaxActiveBlocksPerMultiprocessor(&per_cu, (const void*)fwd_kernel, NTHR, LDS_BYTES) != hipSuccess || per_cu < 1)
            fprintf(stderr, "kernel_launch: occupancy query reports %d blocks per CU\n", per_cu);
        (void)hipGetLastError();
        grid = cus;
    }
    if (grid < 0) return;
    (void)hipMemsetAsync((char*)d_ws + WS_CTL, 0, CTL_ZERO_BYTES, stream);
    Args a{};
    a.x = (const float*)d_in[0]; a.c = (const float*)d_in[1]; a.pos = (const int*)d_in[2]; a.ada_w = (const float*)d_in[3]; a.ada_b = (const float*)d_in[4];
    a.norm_mix = (const float*)d_in[5]; a.norm_ffn = (const float*)d_in[6]; a.w_in = (const float*)d_in[7]; a.b_forget = (const float*)d_in[8];
    a.lq1 = (const float*)d_in[9]; a.lk1 = (const float*)d_in[10]; a.lq2 = (const float*)d_in[11]; a.lk2 = (const float*)d_in[12]; a.subln = (const float*)d_in[13];
    a.w_out = (const float*)d_in[14]; a.router_w = (const float*)d_in[15]; a.router_b = (const float*)d_in[16]; a.w1 = (const float*)d_in[17]; a.b1 = (const float*)d_in[18];
    a.w2 = (const float*)d_in[19]; a.b2 = (const float*)d_in[20]; a.final_norm = (const float*)d_in[21];
    a.out = (float*)d_out; a.ws = (unsigned char*)d_ws;
    constexpr int NPH = 2 + 7 * DEPTH;
#if MK_MULTI
    for (int p = 0; p < NPH; ++p) { a.ph_lo = p; a.ph_hi = p + 1; hipLaunchKernelGGL(fwd_kernel, dim3(grid), dim3(NTHR), LDS_BYTES, stream, a); }
#else
    a.ph_lo = 0; a.ph_hi = NPH;
    hipLaunchKernelGGL(fwd_kernel, dim3(grid), dim3(NTHR), LDS_BYTES, stream, a);
#endif
    const hipError_t le = hipPeekAtLastError();
    if (le != hipSuccess) fprintf(stderr, "kernel_launch: launch failed: %s\n", hipGetErrorName(le));
}
```
